# Optimizing an MI355X kernel written in HIP

```python
import math, functools
import jax, jax.numpy as jnp
from jax import lax
import numpy as np

D_MODEL = 2048
BATCH = 1
SEQ = 8192
DEPTH = 4

GRID_W = 64
CTX_LEN = 256
F32 = jnp.float32

D_MIX = D_MODEL
H_ATT = 6
DH_ATT = 64
DV_ATT = 2 * DH_ATT
W_ATT = H_ATT * DV_ATT
Q_BLOCK = 128
ROPE_THETA = 10000.0
H_RWKV = 10
N_RWKV = 64
W_RWKV = H_RWKV * N_RWKV
R_DECAY = 64
R_ICL = 64
R_GATE = 128
LN_X_EPS = 64e-5
H_SSM = 10
P_SSM = 64
W_SSM = H_SSM * P_SSM
G_SSM = 2
N_SSM = 128
CONV_W = 3
CHUNK = 128
CONV_CH = W_SSM + 2 * G_SSM * N_SSM
D_FF = -(-8 * D_MODEL // (3 * 256)) * 256
EPS = 1e-6

ATT_COLS = 3 * W_ATT
RWKV_COLS = 3 * W_RWKV + 2 * R_DECAY + 2 * R_ICL + R_GATE
SSM_COLS = W_SSM + CONV_CH + 2 * H_SSM
IN_COLS = ATT_COLS + RWKV_COLS + SSM_COLS

kernel_name = 'hybrid_diffattn_rwkv7_ssd_flow_block'


def split_cols(u, sizes):
    return jnp.split(u, np.cumsum(sizes)[:-1].tolist(), axis=-1)


def flip_t(a):
    return jnp.flip(a, axis=1)


def rms_norm(x, g, eps=EPS):
    xf = x.astype(F32)
    y = xf * lax.rsqrt(jnp.mean(xf * xf, axis=-1, keepdims=True) + eps)
    return (y * g.astype(F32)).astype(x.dtype)


def head_layer_norm(y, g, b, eps):
    yf = y.astype(F32)
    yc = yf - jnp.mean(yf, axis=-1, keepdims=True)
    yn = yc * lax.rsqrt(jnp.mean(yc * yc, axis=-1, keepdims=True) + eps)
    yn = yn.reshape(*y.shape[:-2], -1)
    return (yn * g.astype(F32) + b.astype(F32)).astype(y.dtype)


def l2_normalize(a, eps=1e-12):
    af = a.astype(F32)
    return (af * lax.rsqrt(jnp.sum(af * af, axis=-1, keepdims=True) + eps)).astype(a.dtype)


def modulate(h, shift, scale):
    return h * (1.0 + scale) + shift


def token_shift3(u, mu):
    prev = jnp.pad(u, ((0, 0), (1, 0), (0, 0)))[:, :-1]
    nxt = jnp.pad(u, ((0, 0), (0, 1), (0, 0)))[:, 1:]
    return u + mu[0] * (prev - u) + mu[1] * (nxt - u)


def centred_dwconv(u, w, b):
    y = lax.conv_general_dilated(u, w[:, None, :], window_strides=(1,),
                                 padding=[(CONV_W // 2, CONV_W // 2)],
                                 dimension_numbers=('NWC', 'WIO', 'NWC'),
                                 feature_group_count=u.shape[-1])
    return y + b


def axial_rope_tables(n_tokens):
    rows = n_tokens // GRID_W
    row = jnp.broadcast_to(jnp.arange(rows)[:, None], (rows, GRID_W)).reshape(-1).astype(F32)
    col = jnp.broadcast_to(jnp.arange(GRID_W)[None, :], (rows, GRID_W)).reshape(-1).astype(F32)
    n_freq = DH_ATT // 4
    inv = ROPE_THETA ** (-jnp.arange(n_freq, dtype=F32) / n_freq)
    ang = jnp.concatenate([row[:, None] * inv, col[:, None] * inv], axis=-1)
    return jnp.cos(ang), jnp.sin(ang)


def apply_rope(x, cos, sin):
    half = x.shape[-1] // 2
    x1, x2 = x[..., :half], x[..., half:]
    cs = cos[None, :, None, None, :].astype(x.dtype)
    sn = sin[None, :, None, None, :].astype(x.dtype)
    return jnp.concatenate([x1 * cs - x2 * sn, x2 * cs + x1 * sn], axis=-1)


def diff_attention(q, k, v, lam):
    b, tq = q.shape[:2]
    nb = tq // Q_BLOCK
    qb = jnp.moveaxis(q.reshape(b, nb, Q_BLOCK, *q.shape[2:]), 1, 0)
    scale = DH_ATT ** -0.5

    def one_block(qblk):
        s = jnp.einsum('bqhcd,bkhcd->bhcqk', qblk, k).astype(F32) * scale
        p = jax.nn.softmax(s, axis=-1)
        a = p[:, :, 0] - lam.astype(F32) * p[:, :, 1]
        return jnp.einsum('bhqk,bkhd->bqhd', a.astype(v.dtype), v)

    o = lax.map(one_block, qb)
    return jnp.moveaxis(o, 0, 1).reshape(b, tq, *v.shape[2:])


def wkv7_scan(r, decay, k, v, kk, bvec, s0):
    def step(S, inp):
        r_t, w_t, k_t, v_t, kk_t, b_t = inp
        sa = jnp.einsum('bhvk,bhk->bhv', S, kk_t)
        S = S * w_t[:, :, None, :] - sa[..., None] * b_t[:, :, None, :] + v_t[..., None] * k_t[:, :, None, :]
        return S, jnp.einsum('bhvk,bhk->bhv', S, r_t)

    xs = tuple(jnp.moveaxis(a.astype(F32), 1, 0) for a in (r, decay, k, v, kk, bvec))
    sT, ys = lax.scan(step, s0.astype(F32), xs)
    return jnp.moveaxis(ys, 0, 1).astype(r.dtype), sT


def ssd_chunked(x, dt, Bm, Cm, h0, A):
    b, T, H, P = x.shape
    nc = T // CHUNK
    rep = H // Bm.shape[2]
    chunked = lambda a: a.astype(F32).reshape(b, nc, CHUNK, *a.shape[2:])
    xc, dtc = chunked(x), chunked(dt)
    Bc = chunked(jnp.repeat(Bm, rep, axis=2))
    Cc = chunked(jnp.repeat(Cm, rep, axis=2))
    acum = jnp.cumsum(dtc * A.astype(F32), axis=2)
    lower = jnp.tril(jnp.ones((CHUNK, CHUNK), bool))[None, None, :, :, None]
    seg = acum[:, :, :, None, :] - acum[:, :, None, :, :]
    decay_ij = jnp.exp(jnp.where(lower, seg, -jnp.inf))
    cb = jnp.einsum('bcihn,bcjhn->bcijh', Cc, Bc)
    y_diag = jnp.einsum('bcijh,bcjhp->bcihp', cb * decay_ij * dtc[:, :, None, :, :], xc)
    to_end = jnp.exp(acum[:, :, -1:, :] - acum) * dtc
    states = jnp.einsum('bcjhn,bcjh,bcjhp->bchpn', Bc, to_end, xc)
    chunk_decay = jnp.exp(acum[:, :, -1, :])

    def step(h, inp):
        s, d = inp
        return h * d[:, :, None, None] + s, h

    hT, h_in = lax.scan(step, h0.astype(F32), (jnp.moveaxis(states, 1, 0), jnp.moveaxis(chunk_decay, 1, 0)))
    h_in = jnp.moveaxis(h_in, 0, 1)
    y_off = jnp.einsum('bcihn,bchpn->bcihp', Cc * jnp.exp(acum)[..., None], h_in)
    return (y_diag + y_off).reshape(b, T, H, P).astype(x.dtype), hT


def bidirectional_scan(scan_fwd, scan_bwd, ctx_fwd, lat_fwd, ctx_bwd, lat_bwd, state0):
    yc_f, sc_f = scan_fwd(*ctx_fwd, state0)
    yl_f, _ = scan_fwd(*lat_fwd, sc_f)
    yc_b, sc_b = scan_bwd(*[flip_t(a) for a in ctx_bwd], state0)
    yl_b, _ = scan_bwd(*[flip_t(a) for a in lat_bwd], sc_b)
    return yc_f + flip_t(yc_b), yl_f + flip_t(yl_b)


def swiglu(h, w_in, w_out):
    gate, up = jnp.split(h @ w_in, 2, axis=-1)
    return (jax.nn.silu(gate) * up) @ w_out


def hybrid_mixer(hl, hc, cos, sin, layer, need_ctx_out,
                 w_in, w_out, qk_gain, lam_q, lam_k, subln_g,
                 shift_mu, w0, w_up, a0, a_up, g_up, k_k, k_a, r_k, lnx_g, lnx_b,
                 conv_w, conv_b, dt_bias, a_log, d_skip, ssm_norm_g):
    bsz = hl.shape[0]
    ul = hl @ w_in
    uc = hc @ w_in
    att_l, rw_l, ssm_l = split_cols(ul, (ATT_COLS, RWKV_COLS, SSM_COLS))
    att_c, rw_c, ssm_c = split_cols(uc, (ATT_COLS, RWKV_COLS, SSM_COLS))

    def att_proj(u):
        q, k, v = split_cols(u, (W_ATT, W_ATT, W_ATT))
        k = rms_norm(k.reshape(*k.shape[:-1], H_ATT, 2, DH_ATT), qk_gain[1])
        return q, k, v.reshape(*v.shape[:-1], H_ATT, DV_ATT)

    q_norm = lambda q: rms_norm(q.reshape(*q.shape[:-1], H_ATT, 2, DH_ATT), qk_gain[0])
    ql_raw, kl, vl = att_proj(att_l)
    qc_raw, kc, vc = att_proj(att_c)
    ql = apply_rope(q_norm(ql_raw), cos, sin)
    kl = apply_rope(kl, cos, sin)
    lam_init = 0.8 - 0.6 * math.exp(-0.3 * layer)
    lam = jnp.exp(jnp.sum(lam_q[0] * lam_k[0])) - jnp.exp(jnp.sum(lam_q[1] * lam_k[1])) + lam_init

    def att_out(o):
        return (rms_norm(o, subln_g) * (1.0 - lam_init)).reshape(*o.shape[:2], W_ATT)

    a_lat = att_out(diff_attention(ql, jnp.concatenate([kc, kl], axis=1),
                                   jnp.concatenate([vc, vl], axis=1), lam))

    heads_r = lambda a: a.reshape(*a.shape[:-1], H_RWKV, N_RWKV)

    def rwkv_prep(u):
        u = token_shift3(u, shift_mu)
        r, k, v, wdf, wdb, adf, adb, gd = split_cols(
            u, (W_RWKV, W_RWKV, W_RWKV, R_DECAY, R_DECAY, R_ICL, R_ICL, R_GATE))
        kk = l2_normalize(heads_r(k * k_k))
        dirs = []
        for d, (wd, ad) in enumerate(((wdf, adf), (wdb, adb))):
            w_log = -jax.nn.softplus(-(w0[d] + jnp.tanh(wd) @ w_up[d])) - 0.5
            icl = jax.nn.sigmoid(a0[d] + ad @ a_up[d])
            k_d = k * (1.0 + (icl - 1.0) * k_a)
            dirs.append((heads_r(jnp.exp(-jnp.exp(w_log))), heads_r(k_d), kk * heads_r(icl)))
        return heads_r(r), heads_r(v), kk, gd, dirs

    rc, rvc, kkc, gdc, dirs_c = rwkv_prep(rw_c)
    rl, rvl, kkl, gdl, dirs_l = rwkv_prep(rw_l)
    s0 = jnp.zeros((bsz, H_RWKV, N_RWKV, N_RWKV), F32)
    ry_c, ry_l = bidirectional_scan(
        wkv7_scan, wkv7_scan,
        (rc, dirs_c[0][0], dirs_c[0][1], rvc, kkc, dirs_c[0][2]),
        (rl, dirs_l[0][0], dirs_l[0][1], rvl, kkl, dirs_l[0][2]),
        (rc, dirs_c[1][0], dirs_c[1][1], rvc, kkc, dirs_c[1][2]),
        (rl, dirs_l[1][0], dirs_l[1][1], rvl, kkl, dirs_l[1][2]), s0)

    def rwkv_out(r, v, gd, y, dirs):
        bonus = jnp.sum(r * (dirs[0][1] + dirs[1][1]) * r_k, axis=-1, keepdims=True) * v
        o = head_layer_norm(y, lnx_g, lnx_b, LN_X_EPS) + bonus.reshape(*r.shape[:2], W_RWKV)
        return o * (jax.nn.sigmoid(gd) @ g_up)

    r_lat = rwkv_out(rl, rvl, gdl, ry_l, dirs_l)

    def ssm_prep(u):
        z, xbc, dtf, dtb = split_cols(u, (W_SSM, CONV_CH, H_SSM, H_SSM))
        xbc = jax.nn.silu(centred_dwconv(xbc, conv_w, conv_b))
        xs, bm, cm = split_cols(xbc, (W_SSM, G_SSM * N_SSM, G_SSM * N_SSM))
        b, t = u.shape[:2]
        return (z, xs.reshape(b, t, H_SSM, P_SSM), bm.reshape(b, t, G_SSM, N_SSM),
                cm.reshape(b, t, G_SSM, N_SSM),
                jax.nn.softplus(dtf + dt_bias[0]), jax.nn.softplus(dtb + dt_bias[1]))

    zc, xsc, bmc, cmc, dtc_f, dtc_b = ssm_prep(ssm_c)
    zl, xsl, bml, cml, dtl_f, dtl_b = ssm_prep(ssm_l)
    h0 = jnp.zeros((bsz, H_SSM, P_SSM, N_SSM), F32)
    sy_c, sy_l = bidirectional_scan(
        functools.partial(ssd_chunked, A=-jnp.exp(a_log[0])),
        functools.partial(ssd_chunked, A=-jnp.exp(a_log[1])),
        (xsc, dtc_f, bmc, cmc), (xsl, dtl_f, bml, cml),
        (xsc, dtc_b, bmc, cmc), (xsl, dtl_b, bml, cml), h0)

    def ssm_out(z, xs, y):
        b, t = z.shape[:2]
        y = y + (d_skip[0] + d_skip[1])[:, None] * xs
        yg = (y.reshape(b, t, W_SSM) * jax.nn.silu(z)).reshape(b, t, G_SSM, W_SSM // G_SSM)
        return rms_norm(yg, ssm_norm_g.reshape(G_SSM, W_SSM // G_SSM)).reshape(b, t, W_SSM)

    s_lat = ssm_out(zl, xsl, sy_l)

    mix_l = jnp.concatenate([a_lat, r_lat, s_lat], axis=-1) @ w_out
    if not need_ctx_out:
        return mix_l, None
    a_ctx = att_out(diff_attention(q_norm(qc_raw), kc, vc, lam))
    r_ctx = rwkv_out(rc, rvc, gdc, ry_c, dirs_c)
    s_ctx = ssm_out(zc, xsc, sy_c)
    mix_c = jnp.concatenate([a_ctx, r_ctx, s_ctx], axis=-1) @ w_out
    return mix_l, mix_c


def setup_inputs(seed: int = 0) -> dict:
    key = jax.random.key(seed)
    ks = iter(jax.random.split(key, 40))
    nrm = lambda shape, s: s * jax.random.normal(next(ks), shape, F32)
    L = DEPTH
    dt0 = jnp.exp(jax.random.uniform(next(ks), (L, 2, H_SSM), F32, math.log(1e-3), math.log(1e-1)))
    return {
        'x': nrm((BATCH, SEQ, D_MODEL), 1.0),
        'c': nrm((BATCH, D_MODEL), 1.0),
        'ctx': nrm((BATCH, CTX_LEN, D_MODEL), 1.0),
        'c_ctx': nrm((D_MODEL,), 1.0),
        'ada_w': nrm((L, D_MODEL, 6 * D_MODEL), 0.5 * D_MODEL ** -0.5),
        'ada_b': nrm((L, 6 * D_MODEL), 0.02),
        'norm1_g': 1.0 + nrm((L, D_MODEL), 0.02),
        'norm2_g': 1.0 + nrm((L, D_MODEL), 0.02),
        'w_in': nrm((L, D_MODEL, IN_COLS), D_MODEL ** -0.5),
        'w_out': nrm((L, D_MIX, D_MODEL), D_MIX ** -0.5),
        'qk_gain': 1.0 + nrm((L, 2, DH_ATT), 0.02),
        'lam_q': nrm((L, 2, DH_ATT), 0.1),
        'lam_k': nrm((L, 2, DH_ATT), 0.1),
        'subln_g': 1.0 + nrm((L, DV_ATT), 0.02),
        'shift_mu': jax.random.uniform(next(ks), (L, 2, RWKV_COLS), F32, 0.0, 0.5),
        'w0': jax.random.uniform(next(ks), (L, 2, W_RWKV), F32, -6.0, -1.0),
        'w_up': nrm((L, 2, R_DECAY, W_RWKV), 0.5 * R_DECAY ** -0.5),
        'a0': nrm((L, 2, W_RWKV), 0.1),
        'a_up': nrm((L, 2, R_ICL, W_RWKV), 0.5 * R_ICL ** -0.5),
        'g_up': nrm((L, R_GATE, W_RWKV), R_GATE ** -0.5),
        'k_k': 0.85 + nrm((L, W_RWKV), 0.02),
        'k_a': 1.0 + nrm((L, W_RWKV), 0.02),
        'r_k': nrm((L, H_RWKV, N_RWKV), 0.1),
        'lnx_g': 1.0 + nrm((L, W_RWKV), 0.02),
        'lnx_b': nrm((L, W_RWKV), 0.02),
        'conv_w': nrm((L, CONV_W, CONV_CH), CONV_W ** -0.5),
        'conv_b': nrm((L, CONV_CH), 0.02),
        'dt_bias': dt0 + jnp.log(-jnp.expm1(-dt0)),
        'a_log': jnp.log(jax.random.uniform(next(ks), (L, 2, H_SSM), F32, 1.0, 16.0)),
        'd_skip': 1.0 + nrm((L, 2, H_SSM), 0.02),
        'ssm_norm_g': 1.0 + nrm((L, W_SSM), 0.02),
        'w_ffn_in': nrm((L, D_MODEL, 2 * D_FF), D_MODEL ** -0.5),
        'w_ffn_out': nrm((L, D_FF, D_MODEL), D_FF ** -0.5),
    }


def reference(x, c, ctx, c_ctx, ada_w, ada_b, norm1_g, norm2_g, w_in, w_out,
              qk_gain, lam_q, lam_k, subln_g,
              shift_mu, w0, w_up, a0, a_up, g_up, k_k, k_a, r_k, lnx_g, lnx_b,
              conv_w, conv_b, dt_bias, a_log, d_skip, ssm_norm_g,
              w_ffn_in, w_ffn_out):
    cos, sin = axial_rope_tables(x.shape[1])
    xl, xc = x, ctx
    for l in range(DEPTH):
        last = l == DEPTH - 1
        mod_l = jnp.split((jax.nn.silu(c) @ ada_w[l] + ada_b[l])[:, None, :], 6, axis=-1)
        mod_c = jnp.split(jax.nn.silu(c_ctx) @ ada_w[l] + ada_b[l], 6, axis=-1)
        hl = modulate(rms_norm(xl, norm1_g[l]), mod_l[0], mod_l[1])
        hc = modulate(rms_norm(xc, norm1_g[l]), mod_c[0], mod_c[1])
        mix_l, mix_c = hybrid_mixer(
            hl, hc, cos, sin, l, not last,
            w_in[l], w_out[l], qk_gain[l], lam_q[l], lam_k[l], subln_g[l],
            shift_mu[l], w0[l], w_up[l], a0[l], a_up[l], g_up[l], k_k[l], k_a[l], r_k[l],
            lnx_g[l], lnx_b[l], conv_w[l], conv_b[l], dt_bias[l], a_log[l], d_skip[l], ssm_norm_g[l])
        xl = xl + mod_l[2] * mix_l
        xl = xl + mod_l[5] * swiglu(modulate(rms_norm(xl, norm2_g[l]), mod_l[3], mod_l[4]),
                                    w_ffn_in[l], w_ffn_out[l])
        if not last:
            xc = xc + mod_c[2] * mix_c
            xc = xc + mod_c[5] * swiglu(modulate(rms_norm(xc, norm2_g[l]), mod_c[3], mod_c[4]),
                                        w_ffn_in[l], w_ffn_out[l])
    return xl
```

```cpp
#include <hip/hip_runtime.h>
#include <hip/hip_bf16.h>
#include <cstdio>
#include <cstdint>
#include <cmath>
namespace pg8 {
#define PG8_LAS __attribute__((address_space(3)))
typedef unsigned short bf16_t;
typedef short bf16x8 __attribute__((ext_vector_type(8)));
typedef float f32x4 __attribute__((ext_vector_type(4)));
typedef unsigned u32x4 __attribute__((ext_vector_type(4)));
constexpr int BM = 256, BK = 64, HALF = 128, HTB = HALF * BK * 2  , STAGE_BYTES = 8 * HTB, NXCD = 8, WGM = 8;

__host__ __device__ __forceinline__ int lds_byte(int r, int c) { const int st = (r >> 4) * 2 + (c >> 5), rr = r & 15, cc = c & 31, ob = rr * 64 + cc * 2; return st * 1024 + (ob ^ (((ob >> 9) & 1) << 5)); }
__host__ __device__ __forceinline__ void stage_rc(int b, int& R, int& C) { const int st = b / 1024, sb = b % 1024, swz = sb ^ (((sb >> 9) & 1) << 5); R = (st >> 1) * 16 + swz / 64; C = (st & 1) * 32 + (swz % 64) / 2; }
__host__ __device__ __forceinline__ int perm32(int rho) { const int n = rho >> 4, i = rho & 15; return 8 * (i >> 2) + 4 * n + (i & 3); }

struct Unit { int pm, pn; };
struct Gemm { const bf16_t* A; const bf16_t* Bt; int M, N, K; };

struct StaticOrder {
    int nM, nN, nwg, G, c;
    __host__ __device__ void init(int M, int N, int G_, int c_) { nM = M / BM; nN = N / BM; nwg = nM * nN; G = G_; c = c_; }
    __host__ __device__ bool next(int i, Unit& u) const {
        const long L = (long)i * G + c; if (L >= nwg) return false;
        int wgid = (int)L; { const int q = nwg / NXCD, r = nwg % NXCD, xcd = wgid % NXCD, off = wgid / NXCD; wgid = (xcd < r ? xcd * (q + 1) : r * (q + 1) + (xcd - r) * q) + off; }
        const int nig = WGM * nN, gid = wgid / nig, fm = gid * WGM, gsz = (nM - fm) < WGM ? (nM - fm) : WGM;
        u.pm = fm + ((wgid % nig) % gsz); u.pn = (wgid % nig) / gsz; return true;
    }
    __device__ __forceinline__ void a_ready(const Unit&) const {}
    __device__ __forceinline__ void done(const Unit&) const {}
};

__device__ __forceinline__ unsigned cvt_pk_bf16(float lo, float hi) { unsigned r; asm volatile("v_cvt_pk_bf16_f32 %0, %1, %2" : "=v"(r) : "v"(lo), "v"(hi)); return r; }
typedef float f32x2 __attribute__((ext_vector_type(2)));
__device__ __forceinline__ f32x2 gelu_pk(f32x2 v) {
    const f32x2 av = __builtin_elementwise_abs(v), d = av * 0.2316418882f + 1.0f;
    f32x2 t; t.x = __builtin_amdgcn_rcpf(d.x); t.y = __builtin_amdgcn_rcpf(d.y);
    f32x2 q = t * 0.5307027145f + (-0.7265760135f); q = q * t + 0.7107068705f; q = q * t + (-0.142248368f); q = q * t + 0.127414796f; q = q * t;
    const f32x2 s = (v * v) * (-0.72134752044f);
    f32x2 e; e.x = __builtin_amdgcn_exp2f(s.x); e.y = __builtin_amdgcn_exp2f(s.y);
    const f32x2 m = v * (q * e), r = v - m;
    f32x2 o; o.x = v.x < 0.f ? m.x : r.x; o.y = v.y < 0.f ? m.y : r.y; return o;
}

template <int ACT  > struct EpiBf16 {
    static constexpr bool PERM = true, AFTER_DRAIN = false; static_assert(ACT == 0 || ACT == 1, "EpiBf16: ACT is 0 (none) or 1 (gelu_pk)");
    bf16_t* O; int ldc; const float* bias; int split_cols; size_t split_stride; float scale0;
    __device__ __forceinline__ void operator()(const f32x4 (&acc)[2][2][4][2], const Unit& u, int wr, int wc, int fr, int fq) const {
        const int row0 = u.pm * BM + wr * 64 + fr; int colt = u.pn * BM; bf16_t* base = O;
        float sc = 1.f; if (split_cols) { const int t = colt / split_cols; base += (size_t)t * split_stride; colt -= t * split_cols; if (t == 0) sc = scale0; }
        const int col0 = colt + wc * 32 + 8 * fq, bcol0 = u.pn * BM + wc * 32 + 8 * fq;
        f32x4 bv[2][2];
#pragma unroll
        for (int bj = 0; bj < 2; ++bj)
#pragma unroll
            for (int n = 0; n < 2; ++n) bv[bj][n] = bias ? *(const f32x4*)(bias + bcol0 + bj * HALF + 4 * n) : (f32x4){0.f, 0.f, 0.f, 0.f};
#pragma unroll
        for (int ai = 0; ai < 2; ++ai)
#pragma unroll
            for (int m = 0; m < 4; ++m) { bf16_t* rowp = base + (size_t)(row0 + ai * HALF + m * 16) * ldc + col0;
#pragma unroll
                for (int bj = 0; bj < 2; ++bj) { f32x4 v0 = acc[ai][bj][m][0] + bv[bj][0], v1 = acc[ai][bj][m][1] + bv[bj][1];
                    if (ACT == 1) { f32x2 a = gelu_pk((f32x2){v0[0], v0[1]}), b = gelu_pk((f32x2){v0[2], v0[3]}), c = gelu_pk((f32x2){v1[0], v1[1]}), d = gelu_pk((f32x2){v1[2], v1[3]});
                        v0 = (f32x4){a.x, a.y, b.x, b.y}; v1 = (f32x4){c.x, c.y, d.x, d.y}; }
                    v0 = v0 * sc; v1 = v1 * sc; u32x4 w; w.x = cvt_pk_bf16(v0[0], v0[1]); w.y = cvt_pk_bf16(v0[2], v0[3]); w.z = cvt_pk_bf16(v1[0], v1[1]); w.w = cvt_pk_bf16(v1[2], v1[3]);
                    *(u32x4*)(rowp + bj * HALF) = w; } }
    }
};

struct PanelStats {
    unsigned* xbuf;
    unsigned* cnt;
    unsigned* tmo;
    int ntn; float eps;
    unsigned code;
    __device__ __forceinline__ bool run(const f32x4 (&v)[2][2][4][2], const Unit& u, int wr, int wc, int fr, int fq, PG8_LAS unsigned char* lds, int wid, int lane) const {
        typedef float f32x2v __attribute__((ext_vector_type(2)));
        PG8_LAS f32x2v* P = (PG8_LAS f32x2v*)lds;
        PG8_LAS f32x2v* S = (PG8_LAS f32x2v*)(lds + 8192);
        PG8_LAS unsigned* flag = (PG8_LAS unsigned*)(lds + 8192 + 2048);
#pragma unroll
        for (int ai = 0; ai < 2; ++ai)
#pragma unroll
            for (int m = 0; m < 4; ++m) {
                float s = 0.f;
#pragma unroll
                for (int bj = 0; bj < 2; ++bj)
#pragma unroll
                    for (int n = 0; n < 2; ++n) { const f32x4 x = v[ai][bj][m][n]; s += (x[0] + x[1]) + (x[2] + x[3]); }
                s += __shfl_xor(s, 16); s += __shfl_xor(s, 32);
                const float mw = s * (1.0f / 64.0f); float q = 0.f;
#pragma unroll
                for (int bj = 0; bj < 2; ++bj)
#pragma unroll
                    for (int n = 0; n < 2; ++n) { const f32x4 d = v[ai][bj][m][n] - mw; q += (d[0] * d[0] + d[1] * d[1]) + (d[2] * d[2] + d[3] * d[3]); }
                q += __shfl_xor(q, 16); q += __shfl_xor(q, 32);
                if (fq == 0) P[(ai * HALF + wr * 64 + m * 16 + fr) * 4 + wc] = (f32x2v){mw, q};
            }
        asm volatile("s_waitcnt lgkmcnt(0)" ::: "memory"); __builtin_amdgcn_s_barrier(); asm volatile("" ::: "memory");
#if defined(BROKEN_EXCHANGE_NO_WAIT)
#warning BROKEN CONTROL BUILD: the row-statistics exchange does not wait; results are wrong by design
        if (blockIdx.x >= 64) { const long long t0_ = clock64(); while (clock64() - t0_ < 60000) __builtin_amdgcn_s_sleep(8); }
#endif
        const int row = wid * 32 + (lane & 31);
        if (lane < 32) {
            const f32x2v a = P[row * 4 + 0], b = P[row * 4 + 1], c = P[row * 4 + 2], d = P[row * 4 + 3];
            const float mt = (a.x + b.x + c.x + d.x) * 0.25f;
            const float da = a.x - mt, db = b.x - mt, dc = c.x - mt, dd = d.x - mt;
            const float m2 = (a.y + b.y) + (c.y + d.y) + 64.0f * ((da * da + db * db) + (dc * dc + dd * dd));
            unsigned long long* slot = (unsigned long long*)xbuf + ((size_t)(u.pm * BM + row) * 4 + u.pn);
            __hip_atomic_store(slot, ((unsigned long long)__float_as_uint(m2) << 32) | __float_as_uint(mt), __ATOMIC_RELAXED, __HIP_MEMORY_SCOPE_AGENT);
        }
        asm volatile("s_waitcnt vmcnt(0)" ::: "memory");
        if (lane == 0) __hip_atomic_fetch_add(cnt + 64 * u.pm, 1u, __ATOMIC_RELAXED, __HIP_MEMORY_SCOPE_AGENT);
        if (wid == 0) {
            bool dead = false; const unsigned long long t0 = __builtin_amdgcn_s_memrealtime(); const unsigned want = 8u * (unsigned)ntn;
            for (;;) {
#if defined(BROKEN_EXCHANGE_NO_WAIT)
                break;
#endif
                if ((unsigned)__builtin_amdgcn_readfirstlane(__hip_atomic_load(cnt + 64 * u.pm, __ATOMIC_RELAXED, __HIP_MEMORY_SCOPE_AGENT)) >= want) break;
                if (__builtin_amdgcn_s_memrealtime() - t0 > 2000000ull) {
                    if (lane == 0) { unsigned expect = 0u; __hip_atomic_compare_exchange_strong(tmo + 1, &expect, code | (unsigned)(u.pm & 0xff), __ATOMIC_RELAXED, __ATOMIC_RELAXED, __HIP_MEMORY_SCOPE_AGENT);
                                     __hip_atomic_store(tmo, 1u, __ATOMIC_RELAXED, __HIP_MEMORY_SCOPE_AGENT); }
                    dead = true; break; }
                __builtin_amdgcn_s_sleep(2);
            }
            __builtin_amdgcn_fence(__ATOMIC_ACQUIRE, "agent");
            if (lane == 0) flag[0] = dead ? 1u : 0u;
        }
        asm volatile("s_waitcnt vmcnt(0) lgkmcnt(0)" ::: "memory"); __builtin_amdgcn_s_barrier(); asm volatile("" ::: "memory");
        const bool bad = flag[0] != 0u;
        if (lane < 32) {
            const unsigned long long* slot = (const unsigned long long*)xbuf + (size_t)(u.pm * BM + row) * 4; float mt[4], m2[4]; float ms = 0.f;
#pragma unroll
            for (int t = 0; t < 4; ++t) { if (t < ntn) { const unsigned long long w = __hip_atomic_load(slot + t, __ATOMIC_RELAXED, __HIP_MEMORY_SCOPE_AGENT); mt[t] = __uint_as_float((unsigned)w); m2[t] = __uint_as_float((unsigned)(w >> 32)); } else { mt[t] = 0.f; m2[t] = 0.f; } ms += mt[t]; }
            const float mean = ms / (float)ntn; float q = 0.f;
#pragma unroll
            for (int t = 0; t < 4; ++t) if (t < ntn) { const float dm = mt[t] - mean; q += m2[t] + 256.0f * dm * dm; }
            S[row] = (f32x2v){mean, 1.0f / sqrtf(q / (256.0f * (float)ntn) + eps)};
        }
        asm volatile("s_waitcnt lgkmcnt(0)" ::: "memory"); __builtin_amdgcn_s_barrier(); asm volatile("" ::: "memory");
        return bad;
    }
};
struct EpiLnRes {
    static constexpr bool PERM = false, AFTER_DRAIN = true;
    const float* base; float* out; int ldc; const float* bias; PanelStats st; unsigned poison;
    __device__ __forceinline__ void fused(f32x4 (&acc)[2][2][4][2], const Unit& u, int wr, int wc, int fr, int fq, PG8_LAS unsigned char* lds, int wid, int lane) const {
        typedef float f32x2v __attribute__((ext_vector_type(2)));
        const PG8_LAS f32x2v* S = (const PG8_LAS f32x2v*)(lds + 8192);
        const int col0 = u.pn * BM + wc * 32 + 4 * fq;
#pragma unroll
        for (int bj = 0; bj < 2; ++bj)
#pragma unroll
            for (int n = 0; n < 2; ++n) { const f32x4 bv = bias ? *(const f32x4*)(bias + col0 + bj * HALF + n * 16) : (f32x4){0.f, 0.f, 0.f, 0.f};
#pragma unroll
                for (int ai = 0; ai < 2; ++ai)
#pragma unroll
                    for (int m = 0; m < 4; ++m) acc[ai][bj][m][n] += bv; }
        f32x4 pre[4][2][2];
#pragma unroll
        for (int m = 0; m < 4; ++m) { const size_t off = (size_t)(u.pm * BM + wr * 64 + m * 16 + fr) * ldc + col0;
#pragma unroll
            for (int bj = 0; bj < 2; ++bj)
#pragma unroll
                for (int n = 0; n < 2; ++n) pre[m][bj][n] = *(const f32x4*)(base + off + bj * HALF + n * 16); }
        const bool bad = st.run(acc, u, wr, wc, fr, fq, lds, wid, lane) || poison != 0u;
        const float qnan = __builtin_nanf("");
#pragma unroll
        for (int ai = 0; ai < 2; ++ai)
#pragma unroll
            for (int m = 0; m < 4; ++m) { const int r = ai * HALF + wr * 64 + m * 16 + fr; const f32x2v sr = S[r]; const size_t off = (size_t)(u.pm * BM + r) * ldc + col0;
#pragma unroll
                for (int bj = 0; bj < 2; ++bj)
#pragma unroll
                    for (int n = 0; n < 2; ++n) { const f32x4 bs = ai == 0 ? pre[m][bj][n] : *(const f32x4*)(base + off + bj * HALF + n * 16); f32x4 o = bs + (acc[ai][bj][m][n] - sr.x) * sr.y;
                        if (bad) o = (f32x4){qnan, qnan, qnan, qnan}; *(f32x4*)(out + off + bj * HALF + n * 16) = o; }
                if (m & 1) asm volatile("" ::: "memory"); }
    }
};
struct EpiLnResLn {
    static constexpr bool PERM = false, AFTER_DRAIN = true;
    const float* base; float* out; bf16_t* xn; int ldc; const float* bias; PanelStats st1, st2; unsigned poison;
    __device__ __forceinline__ void fused(f32x4 (&acc)[2][2][4][2], const Unit& u, int wr, int wc, int fr, int fq, PG8_LAS unsigned char* lds, int wid, int lane) const {
        typedef float f32x2v __attribute__((ext_vector_type(2))); typedef unsigned u32x2v __attribute__((ext_vector_type(2)));
        const PG8_LAS f32x2v* S = (const PG8_LAS f32x2v*)(lds + 8192);
        const int col0 = u.pn * BM + wc * 32 + 4 * fq;
#pragma unroll
        for (int bj = 0; bj < 2; ++bj)
#pragma unroll
            for (int n = 0; n < 2; ++n) { const f32x4 bv = bias ? *(const f32x4*)(bias + col0 + bj * HALF + n * 16) : (f32x4){0.f, 0.f, 0.f, 0.f};
#pragma unroll
                for (int ai = 0; ai < 2; ++ai)
#pragma unroll
                    for (int m = 0; m < 4; ++m) acc[ai][bj][m][n] += bv; }
        bool bad = st1.run(acc, u, wr, wc, fr, fq, lds, wid, lane) || poison != 0u;
        const float qnan = __builtin_nanf("");
#pragma unroll
        for (int ai = 0; ai < 2; ++ai)
#pragma unroll
            for (int m = 0; m < 4; ++m) { const int r = ai * HALF + wr * 64 + m * 16 + fr; const f32x2v sr = S[r]; const size_t off = (size_t)(u.pm * BM + r) * ldc + col0;
#pragma unroll
                for (int bj = 0; bj < 2; ++bj)
#pragma unroll
                    for (int n = 0; n < 2; ++n) { const f32x4 bs = *(const f32x4*)(base + off + bj * HALF + n * 16); acc[ai][bj][m][n] = bs + (acc[ai][bj][m][n] - sr.x) * sr.y; }
                asm volatile("" : "+v"(acc[ai][0][m][0]), "+v"(acc[ai][0][m][1]), "+v"(acc[ai][1][m][0]), "+v"(acc[ai][1][m][1]));
                if (m & 1) asm volatile("" ::: "memory"); }
        const bool bad1 = bad;
        bad = st2.run(acc, u, wr, wc, fr, fq, lds, wid, lane) || bad;
#pragma unroll
        for (int ai = 0; ai < 2; ++ai)
#pragma unroll
            for (int m = 0; m < 4; ++m) { const int r = ai * HALF + wr * 64 + m * 16 + fr; const f32x2v sr = S[r]; const size_t off = (size_t)(u.pm * BM + r) * ldc + col0;
#pragma unroll
                for (int bj = 0; bj < 2; ++bj)
#pragma unroll
                    for (int n = 0; n < 2; ++n) { const f32x4 x1 = acc[ai][bj][m][n]; *(f32x4*)(out + off + bj * HALF + n * 16) = bad1 ? (f32x4){qnan, qnan, qnan, qnan} : x1;
                        const f32x4 o = (x1 - sr.x) * sr.y; u32x2v w; w.x = cvt_pk_bf16(o[0], o[1]); w.y = cvt_pk_bf16(o[2], o[3]);
                        if (bad) { w.x = 0x7fc07fc0u; w.y = 0x7fc07fc0u; } *(u32x2v*)(xn + off + bj * HALF + n * 16) = w; }
                asm volatile("" ::: "memory"); }
    }
};

template <class Epi, class Sched, bool ALIGN_EPI = false, bool SP2 = false>
__device__ __forceinline__ void gemm_phase(PG8_LAS unsigned char* lds, const Gemm g, const Sched& S, const Epi& E) {
    int tid_l = threadIdx.x; asm volatile("" : "+v"(tid_l));
    const int tid = tid_l, wid = __builtin_amdgcn_readfirstlane(tid >> 6), lane = tid & 63, wr = wid >> 2, wc = wid & 3, fr = lane & 15, fq = lane >> 4;
    const int K = g.K, nt = K / BK;
    unsigned voffA[2], voffB[2];
#pragma unroll
    for (int i = 0; i < 2; ++i) { int R, C; stage_rc(tid * 16 + i * 8192, R, C); const int Rb = Epi::PERM ? ((R & ~31) + perm32(R & 31)) : R;
        voffA[i] = (unsigned)(R * K + C) * 2u; voffB[i] = (unsigned)(Rb * K + C) * 2u; }
    const size_t kstep = (size_t)(BK * 2);
    const size_t hstep = (size_t)HALF * K * 2;
    const size_t tstep = 2 * hstep;
    const unsigned ldsw = (unsigned)wid * 1024u;
    const int aoff = lds_byte(wr * 64 + fr, fq * 8), boff = lds_byte(wc * 32 + fr, fq * 8);
#define PG8_SA(b, h) (((b) * 2 + (h)) * HTB)
#define PG8_SB(b, h) ((4 + (b) * 2 + (h)) * HTB)
#define PG8_STAGE(bufoff, gbase, voff) do { _Pragma("unroll") for (int _i = 0; _i < 2; ++_i) \
        __builtin_amdgcn_global_load_lds((const unsigned*)((const char*)(gbase) + (voff)[_i]), (PG8_LAS unsigned*)(lds + (bufoff) + ldsw + _i * 8192), 16, 0, 0); } while (0)
#define PG8_LDA(dst, b, h) do { _Pragma("unroll") for (int m = 0; m < 4; ++m) _Pragma("unroll") for (int k = 0; k < 2; ++k) dst[m][k] = *(const PG8_LAS bf16x8*)(lds + PG8_SA(b, h) + aoff + m * 2048 + k * 1024); } while (0)
#define PG8_LDB(dst, b, h) do { _Pragma("unroll") for (int n = 0; n < 2; ++n) _Pragma("unroll") for (int k = 0; k < 2; ++k) dst[n][k] = *(const PG8_LAS bf16x8*)(lds + PG8_SB(b, h) + boff + n * 2048 + k * 1024); } while (0)
#define PG8_MMA(ai, bj, At, Bt) do { __builtin_amdgcn_s_setprio(1); _Pragma("unroll") for (int m = 0; m < 4; ++m) _Pragma("unroll") for (int n = 0; n < 2; ++n) _Pragma("unroll") for (int k = 0; k < 2; ++k) \
        acc[ai][bj][m][n] = __builtin_amdgcn_mfma_f32_16x16x32_bf16(Bt[n][k], At[m][k], acc[ai][bj][m][n], 0, 0, 0); __builtin_amdgcn_s_setprio(0); } while (0)
#define PG8_WAIT_V(n) asm volatile("s_waitcnt vmcnt(" #n ")" ::: "memory")
#define PG8_WAIT_L(n) asm volatile("s_waitcnt lgkmcnt(" #n ")" ::: "memory")
#define PG8_BAR __builtin_amdgcn_s_barrier()
#define PG8_SCHED __builtin_amdgcn_sched_barrier(0)
    Unit cur, nxt; int ui = 0;
    if (!S.next(0, cur)) return;
    f32x4 acc[2][2][4][2];
#pragma unroll
    for (int a = 0; a < 2; ++a)
#pragma unroll
        for (int b = 0; b < 2; ++b)
#pragma unroll
            for (int m = 0; m < 4; ++m)
#pragma unroll
                for (int n = 0; n < 2; ++n) acc[a][b][m][n] = (f32x4){0.f, 0.f, 0.f, 0.f};
    bf16x8 At[4][2], B0[2][2], B1[2][2];
    const char* cA = (const char*)g.A + (size_t)cur.pm * tstep; const char* cB = (const char*)g.Bt + (size_t)cur.pn * tstep;
    S.a_ready(cur);
    if constexpr (SP2) {
        PG8_STAGE(PG8_SB(0, 0), cB, voffB); PG8_STAGE(PG8_SB(0, 1), cB + hstep, voffB); PG8_STAGE(PG8_SA(0, 0), cA, voffA); PG8_STAGE(PG8_SA(0, 1), cA + hstep, voffA);
        if (wr == 1) PG8_BAR;
        PG8_WAIT_V(2); PG8_BAR;
        PG8_STAGE(PG8_SB(1, 0), cB + kstep, voffB); PG8_STAGE(PG8_SA(1, 0), cA + kstep, voffA); PG8_STAGE(PG8_SB(1, 1), cB + hstep + kstep, voffB);
        PG8_WAIT_V(6); PG8_BAR;
    } else {
        PG8_STAGE(PG8_SB(0, 0), cB, voffB); PG8_STAGE(PG8_SA(0, 0), cA, voffA); PG8_STAGE(PG8_SB(0, 1), cB + hstep, voffB); PG8_STAGE(PG8_SA(0, 1), cA + hstep, voffA);
        if (wr == 1) PG8_BAR;
        PG8_WAIT_V(4); PG8_BAR;
        PG8_STAGE(PG8_SB(1, 0), cB + kstep, voffB); PG8_STAGE(PG8_SA(1, 0), cA + kstep, voffA); PG8_STAGE(PG8_SB(1, 1), cB + hstep + kstep, voffB);
        PG8_WAIT_V(6); PG8_BAR;
    }
    for (;;) {
        const bool has_next = S.next(ui + 1, nxt);
        const char* nA = has_next ? (const char*)g.A + (size_t)nxt.pm * tstep : cA; const char* nB = has_next ? (const char*)g.Bt + (size_t)nxt.pn * tstep : cB;
        for (int t = 0; t < nt; t += 2) {
            const bool last = (t == nt - 2);
            const char* a1 = cA + (size_t)(t + 1) * kstep;
            const char* a2 = last ? nA : cA + (size_t)(t + 2) * kstep; const char* b2 = last ? nB : cB + (size_t)(t + 2) * kstep;
            const char* a3 = a2 + kstep; const char* b3 = b2 + kstep;
            if (last && has_next) S.a_ready(nxt);
            if constexpr (SP2) {
            PG8_LDB(B0, 0, 0); PG8_LDB(B1, 0, 1); PG8_SCHED; PG8_LDA(At, 0, 0); PG8_STAGE(PG8_SA(1, 1), a1 + hstep, voffA);
            PG8_WAIT_V(8); PG8_WAIT_L(0); PG8_BAR; PG8_MMA(0, 0, At, B0); PG8_MMA(0, 1, At, B1); PG8_BAR; PG8_SCHED;
            PG8_LDA(At, 0, 1); PG8_STAGE(PG8_SB(0, 0), b2, voffB); PG8_STAGE(PG8_SB(0, 1), b2 + hstep, voffB); PG8_STAGE(PG8_SA(0, 0), a2, voffA);
            PG8_WAIT_V(8); PG8_WAIT_L(0); PG8_BAR; PG8_MMA(1, 0, At, B0); PG8_MMA(1, 1, At, B1); PG8_BAR; PG8_SCHED;
            PG8_LDB(B0, 1, 0); PG8_LDB(B1, 1, 1); PG8_SCHED; PG8_LDA(At, 1, 0); PG8_STAGE(PG8_SA(0, 1), a2 + hstep, voffA);
            PG8_WAIT_V(8); PG8_WAIT_L(0); PG8_BAR; PG8_MMA(0, 0, At, B0); PG8_MMA(0, 1, At, B1); PG8_BAR; PG8_SCHED;
            PG8_LDA(At, 1, 1); PG8_STAGE(PG8_SB(1, 0), b3, voffB); PG8_STAGE(PG8_SB(1, 1), b3 + hstep, voffB); PG8_STAGE(PG8_SA(1, 0), a3, voffA);
            PG8_WAIT_V(8); PG8_WAIT_L(0); PG8_BAR; PG8_MMA(1, 0, At, B0); PG8_MMA(1, 1, At, B1); PG8_BAR; PG8_SCHED;
            } else {
            PG8_LDB(B0, 0, 0); PG8_SCHED; PG8_LDA(At, 0, 0); PG8_STAGE(PG8_SA(1, 1), a1 + hstep, voffA);
            PG8_WAIT_L(8); PG8_BAR; PG8_WAIT_L(0); PG8_MMA(0, 0, At, B0); PG8_BAR; PG8_SCHED;
            PG8_LDB(B1, 0, 1); PG8_STAGE(PG8_SB(0, 0), b2, voffB);
            PG8_BAR; PG8_WAIT_L(0); PG8_MMA(0, 1, At, B1); PG8_BAR;
            PG8_LDA(At, 0, 1); PG8_STAGE(PG8_SA(0, 0), a2, voffA);
            PG8_BAR; PG8_WAIT_L(0); PG8_MMA(1, 0, At, B0); PG8_BAR; PG8_SCHED;
            PG8_STAGE(PG8_SB(0, 1), b2 + hstep, voffB);
            PG8_WAIT_V(6); PG8_BAR; PG8_MMA(1, 1, At, B1); PG8_BAR;
            PG8_LDB(B0, 1, 0); PG8_SCHED; PG8_LDA(At, 1, 0); PG8_STAGE(PG8_SA(0, 1), a2 + hstep, voffA);
            PG8_WAIT_L(8); PG8_BAR; PG8_WAIT_L(0); PG8_MMA(0, 0, At, B0); PG8_BAR; PG8_SCHED;
            PG8_LDB(B1, 1, 1); PG8_STAGE(PG8_SB(1, 0), b3, voffB);
            PG8_BAR; PG8_WAIT_L(0); PG8_MMA(0, 1, At, B1); PG8_BAR;
            PG8_LDA(At, 1, 1); PG8_STAGE(PG8_SA(1, 0), a3, voffA);
            PG8_BAR; PG8_WAIT_L(0); PG8_MMA(1, 0, At, B0); PG8_BAR; PG8_SCHED;
            PG8_STAGE(PG8_SB(1, 1), b3 + hstep, voffB);
            PG8_WAIT_V(6); PG8_BAR; PG8_MMA(1, 1, At, B1); PG8_BAR;
            }
        }
        if constexpr (ALIGN_EPI) { if (wr == 0) PG8_BAR; }
        if constexpr (!Epi::AFTER_DRAIN) { E(acc, cur, wr, wc, fr, fq); S.done(cur); }
        if (!has_next) break;
#pragma unroll
        for (int a = 0; a < 2; ++a)
#pragma unroll
            for (int b = 0; b < 2; ++b)
#pragma unroll
                for (int m = 0; m < 4; ++m)
#pragma unroll
                    for (int n = 0; n < 2; ++n) acc[a][b][m][n] = (f32x4){0.f, 0.f, 0.f, 0.f};
        cur = nxt; cA = nA; cB = nB; ++ui;
        if constexpr (ALIGN_EPI) { if (wr == 1) PG8_BAR; }
    }
    PG8_WAIT_V(0);
    if constexpr (!ALIGN_EPI) { if (wr == 0) PG8_BAR; }
    PG8_BAR;
    if constexpr (Epi::AFTER_DRAIN) { E.fused(acc, cur, wr, wc, fr, fq, lds, wid, lane); S.done(cur); }
#undef PG8_SA
#undef PG8_SB
#undef PG8_STAGE
#undef PG8_LDA
#undef PG8_LDB
#undef PG8_MMA
#undef PG8_WAIT_V
#undef PG8_WAIT_L
#undef PG8_BAR
#undef PG8_SCHED
}
}
#define GAS __attribute__((address_space(1)))
#define LAS __attribute__((address_space(3)))
typedef unsigned short bf16;
typedef unsigned v4u __attribute__((ext_vector_type(4)));
typedef float f32x4 __attribute__((ext_vector_type(4)));
typedef short bf16x8 __attribute__((ext_vector_type(8)));
typedef GAS unsigned gu32;
typedef GAS unsigned long long gu64;
#define RLX_AGENT __ATOMIC_RELAXED, __HIP_MEMORY_SCOPE_AGENT
#define LDS_WAIT() asm volatile("s_waitcnt lgkmcnt(0)" ::: "memory")
#define VM_WAIT() asm volatile("s_waitcnt vmcnt(0)" ::: "memory")
__device__ __forceinline__ unsigned long long rt() { return __builtin_amdgcn_s_memrealtime(); }
__device__ __forceinline__ unsigned f2bf(float f) { unsigned u = __builtin_bit_cast(unsigned, f); return (u + 0x7fffu + ((u >> 16) & 1u)) >> 16; }
__device__ __forceinline__ unsigned pk2(float lo, float hi) { return f2bf(lo) | (f2bf(hi) << 16); }

#define XB_TMO      128
#define XB_XCNT(j)  (256  + 64 * (j))
#define XB_XSUB(j)  (1280 + 64 * (j))
#define XB_XGEN(j)  (2304 + 64 * (j))
#define XB_TOP      3328
#define XB_TOPGEN   3392
#define XCD_BAR_WORDS 3456
#define XB_SPIN_CAP (1u << 18)

__device__ __forceinline__ unsigned xb_ld(unsigned* p)              { return __hip_atomic_load(p, __ATOMIC_RELAXED, __HIP_MEMORY_SCOPE_AGENT); }
__device__ __forceinline__ unsigned xb_add(unsigned* p, unsigned v) { return __hip_atomic_fetch_add(p, v, __ATOMIC_RELAXED, __HIP_MEMORY_SCOPE_AGENT); }
__device__ __forceinline__ unsigned xb_xcc_id() { return (unsigned)__builtin_amdgcn_s_getreg((3 << 11) | 20) & 0xFu; }
#define XB_SPIN(cond, bar) do { unsigned _sp = 0; while (cond) { __builtin_amdgcn_s_sleep(1); \
    if ((++_sp & 255u) == 0u) { if (xb_ld(&(bar)[XB_TMO])) break; if (_sp > XB_SPIN_CAP) { atomicAdd(&(bar)[XB_TMO], 1u); break; } } } } while (0)

struct XcdBarrier {
    unsigned* bar; unsigned x;
    volatile LAS unsigned* st;
};

__device__ __forceinline__ XcdBarrier xcd_barrier_post(unsigned* bar, volatile LAS unsigned* st) {
    XcdBarrier b; b.bar = bar; b.x = xb_xcc_id(); b.st = st;
    if (threadIdx.x == 0) (void)xb_add(&bar[XB_XCNT(b.x)], 1u);
    return b;
}
__device__ __forceinline__ void xcd_barrier_complete(unsigned* bar, unsigned x, unsigned& nloc, unsigned& nx) {
    const unsigned G = gridDim.x * gridDim.y * gridDim.z;
    unsigned sum, cnt, mine, sp = 0u;
    for (;;) {
        sum = 0u; cnt = 0u; mine = 0u;
#pragma unroll
        for (unsigned j = 0; j < 16; ++j) { const unsigned c = xb_ld(&bar[XB_XCNT(j)]); sum += c; cnt += (c > 0u) ? 1u : 0u; mine = (j == x) ? c : mine; }
        if (sum == G) break;
        __builtin_amdgcn_s_sleep(1);
        if ((++sp & 255u) == 0u) { if (xb_ld(&bar[XB_TMO])) break; if (sp > XB_SPIN_CAP) { atomicAdd(&bar[XB_TMO], 1u); break; } }
    }
    nloc = mine > 0u ? mine : 1u; nx = cnt > 0u ? cnt : 1u;
}

__device__ __forceinline__ void xcd_barrier(const XcdBarrier& b) {
    asm volatile("s_waitcnt vmcnt(0)" ::: "memory");
    __syncthreads();
    if (threadIdx.x == 0) {
        unsigned* bar = b.bar;
        __builtin_amdgcn_s_waitcnt(0);
        unsigned nloc = b.st[0], nx = b.st[1];
        if (nloc == 0u) { xcd_barrier_complete(bar, b.x, nloc, nx); b.st[0] = nloc; b.st[1] = nx; }
        const unsigned old = xb_add(&bar[XB_XSUB(b.x)], 1u);
        const unsigned gen = old / nloc;
        if (old + 1u == (gen + 1u) * nloc) {
            __builtin_amdgcn_fence(__ATOMIC_RELEASE, "agent");
            asm volatile("s_waitcnt vmcnt(0)" ::: "memory");
            const unsigned og = xb_add(&bar[XB_TOP], 1u);
            const unsigned tg = og / nx;
            if (og + 1u == (tg + 1u) * nx) xb_add(&bar[XB_TOPGEN], 1u);
            else XB_SPIN(xb_ld(&bar[XB_TOPGEN]) == tg, bar);
            __builtin_amdgcn_fence(__ATOMIC_ACQUIRE, "agent");
            xb_add(&bar[XB_XGEN(b.x)], 1u);
            asm volatile("s_waitcnt vmcnt(0)" ::: "memory");
        } else {
            XB_SPIN(xb_ld(&bar[XB_XGEN(b.x)]) == gen, bar);
            __builtin_amdgcn_fence(__ATOMIC_ACQUIRE, "agent");
            asm volatile("s_waitcnt vmcnt(0)" ::: "memory");
        }
    }
    __syncthreads();
}
constexpr int DM = 2048, SEQ = 8192, CTX = 256, MT = SEQ + CTX, DEPTH = 4;
constexpr int INC = 6420, INP = 6656, DFF = 5632;
constexpr int W_ATT = 768, W_RW = 640, W_SSM = 640;
constexpr int C_RW = 2304, C_SSM = 4608;
constexpr float EPS = 1e-6f, LN_X_EPS = 64e-5f;
constexpr int NWAVES = 8, NTHR = 512;

constexpr size_t al256(size_t x) { return (x + 255) / 256 * 256; }
constexpr size_t WS_CTL = 0, CTL_ZERO_BYTES = 1u << 20;
constexpr size_t WS_MOD = CTL_ZERO_BYTES;
constexpr size_t WS_LAM = WS_MOD + al256((size_t)DEPTH * 2 * 12288 * 4);
constexpr size_t WS_WIN = WS_LAM + 256;
constexpr size_t SZ_WIN = (size_t)INP * DM * 2;
constexpr size_t WS_WOUT = WS_WIN + DEPTH * SZ_WIN;
constexpr size_t SZ_WOUT = (size_t)DM * DM * 2;
constexpr size_t WS_WF1 = WS_WOUT + DEPTH * SZ_WOUT;
constexpr size_t SZ_WF1 = (size_t)2 * DFF * DM * 2;
constexpr size_t WS_WF2 = WS_WF1 + DEPTH * SZ_WF1;
constexpr size_t SZ_WF2 = (size_t)DM * DFF * 2;
constexpr size_t WS_XC = WS_WF2 + DEPTH * SZ_WF2;
constexpr size_t WS_H = WS_XC + (size_t)CTX * DM * 4;
constexpr size_t WS_U = WS_H + (size_t)MT * DM * 2;
constexpr size_t WS_Q = WS_U + (size_t)MT * INP * 4;
constexpr size_t WS_K = WS_Q + (size_t)MT * 768 * 2;
constexpr size_t WS_V = WS_K + (size_t)MT * 768 * 2;
constexpr size_t WS_AO = WS_V + (size_t)MT * 768 * 2;
constexpr size_t SZ_RW = (size_t)MT * 640 * 4;
constexpr size_t WS_RW = WS_AO + (size_t)MT * 1536 * 4;
constexpr size_t WS_BONUS = WS_RW + 10 * SZ_RW;
constexpr size_t WS_RY = WS_BONUS + (size_t)MT * 16 * 4;
constexpr size_t WS_SX = WS_RY + 2 * SZ_RW;
constexpr size_t WS_SB = WS_SX + SZ_RW;
constexpr size_t WS_SC = WS_SB + (size_t)MT * 256 * 4;
constexpr size_t WS_SDT = WS_SC + (size_t)MT * 256 * 4;
constexpr size_t WS_SY = WS_SDT + (size_t)MT * 32 * 4;
constexpr size_t WS_MIX = WS_SY + 2 * SZ_RW;
constexpr size_t WS_G = WS_MIX + (size_t)MT * DM * 2;
constexpr size_t WS_END = WS_G + (size_t)MT * DFF * 2;

constexpr int CW_BAR = 4096;

constexpr int RING_BYTES = 131072;
constexpr int MISC_OFF = RING_BYTES;
constexpr int LDS_BYTES = 147456;

typedef float f32x2 __attribute__((ext_vector_type(2)));
typedef unsigned u32x2 __attribute__((ext_vector_type(2)));

__device__ __forceinline__ float wave_sum(float v) {
#pragma unroll
    for (int o = 1; o < 64; o <<= 1) v += __shfl_xor(v, o);
    return v;
}
__device__ __forceinline__ float sigmoidf_(float x) { return 1.f / (1.f + __expf(-x)); }
__device__ __forceinline__ float siluf_(float x) { return x / (1.f + __expf(-x)); }
__device__ __forceinline__ float softplusf_(float x) { return x > 20.f ? x : log1pf(expf(x)); }

struct Args { const float* in[33]; float* out; unsigned char* ws; int single, layer, phase, pad; };
enum In { I_X = 0, I_C, I_CTX, I_CCTX, I_ADAW, I_ADAB, I_N1G, I_N2G, I_WIN, I_WOUT, I_QKG, I_LAMQ, I_LAMK, I_SUBLN, I_MU, I_W0, I_WUP, I_A0, I_AUP, I_GUP, I_KK, I_KA, I_RK,
          I_LNG, I_LNB, I_CONVW, I_CONVB, I_DTB, I_ALOG, I_DSKIP, I_SSMG, I_WF1, I_WF2 };

__device__ __forceinline__ void transpose_item(const float* W, int K, int N, bf16* WT, int dst_row0, LAS float* scr, int k0, int n0, int lane) {
    const int nn = n0 + (lane & 31);
#pragma unroll 8
    for (int i = 0; i < 32; ++i) { const int kk = 2 * i + (lane >> 5); scr[kk * 33 + (lane & 31)] = nn < N ? W[(size_t)(k0 + kk) * N + nn] : 0.f; }
    LDS_WAIT(); asm volatile("" ::: "memory");
    const int c = lane & 7;
#pragma unroll
    for (int j = 0; j < 4; ++j) { const int n = (lane >> 3) + 8 * j; const LAS float* s = scr + (8 * c) * 33 + n;
        v4u o; o.x = pk2(s[0 * 33], s[1 * 33]); o.y = pk2(s[2 * 33], s[3 * 33]); o.z = pk2(s[4 * 33], s[5 * 33]); o.w = pk2(s[6 * 33], s[7 * 33]);
        *(GAS v4u*)(WT + (size_t)(dst_row0 + n) * K + k0 + 8 * c) = o; }
    LDS_WAIT(); asm volatile("" ::: "memory");
}
__device__ __forceinline__ void pre_phase(const Args& a, LAS unsigned char* lds, int tid, int lane, int wave, int bid, int G) {
    unsigned char* ws = a.ws;
    LAS float* scr = (LAS float*)(lds + wave * 16384);
    const int gw = bid * NWAVES + wave, NGW = G * NWAVES;
    constexpr int NB_IN = (INC + 31) / 32;
    constexpr int IT_IN = 32 * NB_IN, IT_OUT = 32 * 64, IT_F1 = 32 * 352, IT_F2 = 88 * 64, IT_L = IT_IN + IT_OUT + IT_F1 + IT_F2;
    for (int it = gw; it < DEPTH * IT_L; it += NGW) {
        const int l = it / IT_L; int r = it % IT_L;
        if (r < IT_IN) { const int kb = r / NB_IN, nb = r % NB_IN;
            transpose_item(a.in[I_WIN] + (size_t)l * DM * INC, DM, INC, (bf16*)(ws + WS_WIN + l * SZ_WIN), 32 * nb, scr, 64 * kb, 32 * nb, lane); continue; }
        r -= IT_IN;
        if (r < IT_OUT) { const int kb = r / 64, nb = r % 64;
            transpose_item(a.in[I_WOUT] + (size_t)l * DM * DM, DM, DM, (bf16*)(ws + WS_WOUT + l * SZ_WOUT), 32 * nb, scr, 64 * kb, 32 * nb, lane); continue; }
        r -= IT_OUT;
        if (r < IT_F1) { const int kb = r / 352, nb = r % 352; const int n0 = 32 * nb; const int j0 = n0 < DFF ? n0 : n0 - DFF;
            const int dst = 256 * (j0 / 128) + (n0 < DFF ? 0 : 128) + (j0 % 128);
            transpose_item(a.in[I_WF1] + (size_t)l * DM * 2 * DFF, DM, 2 * DFF, (bf16*)(ws + WS_WF1 + l * SZ_WF1), dst, scr, 64 * kb, n0, lane); continue; }
        r -= IT_F1;
        { const int kb = r / 64, nb = r % 64;
            transpose_item(a.in[I_WF2] + (size_t)l * DFF * DM, DFF, DM, (bf16*)(ws + WS_WF2 + l * SZ_WF2), 32 * nb, scr, 64 * kb, 32 * nb, lane); }
    }
    __syncthreads();
    LAS float* sv = (LAS float*)lds;
    LAS float* red = (LAS float*)(lds + 16384);
    for (int i = tid; i < 2 * DM; i += NTHR) { const float x = i < DM ? a.in[I_C][i] : a.in[I_CCTX][i - DM]; sv[i] = siluf_(x); }
    __syncthreads();
    float* mod = (float*)(ws + WS_MOD);
    for (int it = bid; it < DEPTH * 48; it += G) {
        const int l = it / 48, cb = it % 48;
        const float* Wp = a.in[I_ADAW] + ((size_t)l * DM + 256 * wave) * 12288 + 256 * cb + 4 * lane;
        f32x4 a0 = {0.f, 0.f, 0.f, 0.f}, a1 = {0.f, 0.f, 0.f, 0.f};
#pragma unroll 8
        for (int kk = 0; kk < 256; ++kk) { const f32x4 wv = *(const f32x4*)(Wp + (size_t)kk * 12288); const float s0 = sv[256 * wave + kk], s1 = sv[DM + 256 * wave + kk]; a0 += wv * s0; a1 += wv * s1; }
        *(LAS f32x4*)(red + (wave * 2 + 0) * 256 + 4 * lane) = a0; *(LAS f32x4*)(red + (wave * 2 + 1) * 256 + 4 * lane) = a1;
        __syncthreads();
        { const int v = tid >> 8, col = tid & 255; float s = a.in[I_ADAB][(size_t)l * 12288 + 256 * cb + col];
#pragma unroll
          for (int w = 0; w < 8; ++w) s += red[(w * 2 + v) * 256 + col];
          mod[(size_t)(l * 2 + v) * 12288 + 256 * cb + col] = s; }
        __syncthreads();
    }
    if (bid == 0 && tid < DEPTH) {
        const int l = tid; float s0 = 0.f, s1 = 0.f;
        for (int i = 0; i < 64; ++i) { s0 += a.in[I_LAMQ][l * 128 + i] * a.in[I_LAMK][l * 128 + i]; s1 += a.in[I_LAMQ][l * 128 + 64 + i] * a.in[I_LAMK][l * 128 + 64 + i]; }
        const float lam_init = 0.8f - 0.6f * expf(-0.3f * (float)l);
        ((float*)(ws + WS_LAM))[l] = expf(s0) - expf(s1) + lam_init;
    }
}

__device__ __forceinline__ void norm_phase(const float* xl, const float* xc, const float* g, const float* modl  , int shift_idx, bf16* H, int gw, int NGW, int lane) {
    for (int row = gw; row < MT; row += NGW) {
        const float* xr = row < CTX ? xc + (size_t)row * DM : xl + (size_t)(row - CTX) * DM;
        const float* md = modl + (row < CTX ? 12288 : 0);
        f32x4 v[8]; float ss = 0.f;
#pragma unroll
        for (int j = 0; j < 8; ++j) { v[j] = *(const f32x4*)(xr + 4 * lane + 256 * j); ss += (v[j].x * v[j].x + v[j].y * v[j].y) + (v[j].z * v[j].z + v[j].w * v[j].w); }
        const float rs = 1.f / sqrtf(wave_sum(ss) * (1.f / DM) + EPS);
#pragma unroll
        for (int j = 0; j < 8; ++j) { const int col = 4 * lane + 256 * j;
            const f32x4 gg = *(const f32x4*)(g + col), sh = *(const f32x4*)(md + shift_idx * DM + col), sc = *(const f32x4*)(md + (shift_idx + 1) * DM + col);
            const f32x4 y = (v[j] * rs) * gg, h = y * (1.f + sc) + sh;
            u32x2 w; w.x = pk2(h.x, h.y); w.y = pk2(h.z, h.w);
            *(u32x2*)(H + (size_t)row * DM + col) = w; }
    }
}

struct EpiStoreF32 {
    static constexpr bool PERM = false, AFTER_DRAIN = false;
    float* O; int ldc;
    __device__ __forceinline__ void operator()(const pg8::f32x4 (&acc)[2][2][4][2], const pg8::Unit& u, int wr, int wc, int fr, int fq) const {
        const int row0 = u.pm * 256 + wr * 64 + fr, col0 = u.pn * 256 + wc * 32 + 4 * fq;
#pragma unroll
        for (int ai = 0; ai < 2; ++ai)
#pragma unroll
            for (int m = 0; m < 4; ++m) { float* rowp = O + (size_t)(row0 + ai * 128 + m * 16) * ldc + col0;
#pragma unroll
                for (int bj = 0; bj < 2; ++bj)
#pragma unroll
                    for (int n = 0; n < 2; ++n) *(pg8::f32x4*)(rowp + bj * 128 + n * 16) = acc[ai][bj][m][n]; }
    }
};
struct EpiResid {
    static constexpr bool PERM = false, AFTER_DRAIN = false;
    const float* xl_in; const float* xc_in; float* xl_out; float* xc_out; const float* gate_l; const float* gate_c;
    __device__ __forceinline__ void operator()(const pg8::f32x4 (&acc)[2][2][4][2], const pg8::Unit& u, int wr, int wc, int fr, int fq) const {
        const bool isc = (u.pm == 0);
        const int row0 = (isc ? 0 : (u.pm - 1) * 256) + wr * 64 + fr, col0 = u.pn * 256 + wc * 32 + 4 * fq;
        const float* bin = isc ? xc_in : xl_in; float* bout = isc ? xc_out : xl_out; const float* gt = isc ? gate_c : gate_l;
        pg8::f32x4 gv[2][2];
#pragma unroll
        for (int bj = 0; bj < 2; ++bj)
#pragma unroll
            for (int n = 0; n < 2; ++n) gv[bj][n] = *(const pg8::f32x4*)(gt + col0 + bj * 128 + n * 16);
#pragma unroll
        for (int ai = 0; ai < 2; ++ai)
#pragma unroll
            for (int m = 0; m < 4; ++m) { const size_t off = (size_t)(row0 + ai * 128 + m * 16) * DM + col0;
#pragma unroll
                for (int bj = 0; bj < 2; ++bj)
#pragma unroll
                    for (int n = 0; n < 2; ++n) { const pg8::f32x4 b = *(const pg8::f32x4*)(bin + off + bj * 128 + n * 16);
                        *(pg8::f32x4*)(bout + off + bj * 128 + n * 16) = b + gv[bj][n] * acc[ai][bj][m][n]; } }
    }
};
struct EpiSwiglu {
    static constexpr bool PERM = true, AFTER_DRAIN = false;
    bf16* O;
    __device__ __forceinline__ void operator()(const pg8::f32x4 (&acc)[2][2][4][2], const pg8::Unit& u, int wr, int wc, int fr, int fq) const {
        const int row0 = u.pm * 256 + wr * 64 + fr, col0 = u.pn * 128 + wc * 32 + 8 * fq;
#pragma unroll
        for (int ai = 0; ai < 2; ++ai)
#pragma unroll
            for (int m = 0; m < 4; ++m) { bf16* rowp = O + (size_t)(row0 + ai * 128 + m * 16) * DFF + col0;
                float o[8];
#pragma unroll
                for (int n = 0; n < 2; ++n)
#pragma unroll
                    for (int i = 0; i < 4; ++i) { const float gt = acc[ai][0][m][n][i], up = acc[ai][1][m][n][i]; o[4 * n + i] = gt * __builtin_amdgcn_rcpf(1.f + __expf(-gt)) * up; }
                pg8::u32x4 w; w.x = pg8::cvt_pk_bf16(o[0], o[1]); w.y = pg8::cvt_pk_bf16(o[2], o[3]); w.z = pg8::cvt_pk_bf16(o[4], o[5]); w.w = pg8::cvt_pk_bf16(o[6], o[7]);
                *(pg8::u32x4*)rowp = w; }
    }
};

__device__ __forceinline__ void prep_rows(const Args& a, int l, int gw, int NGW, int lane) {
    unsigned char* ws = a.ws;
    const float* U = (const float*)(ws + WS_U);
    bf16* Qb = (bf16*)(ws + WS_Q); bf16* Kb = (bf16*)(ws + WS_K); bf16* Vb = (bf16*)(ws + WS_V);
    float* SX = (float*)(ws + WS_SX); float* SB = (float*)(ws + WS_SB); float* SC = (float*)(ws + WS_SC); float* SDT = (float*)(ws + WS_SDT);
    const float* qkg = a.in[I_QKG] + l * 128; const float* cw = a.in[I_CONVW] + (size_t)l * 3 * 1152; const float* cb = a.in[I_CONVB] + l * 1152; const float* dtb = a.in[I_DTB] + l * 20;
    const float gq = qkg[lane], gk = qkg[64 + lane];
    const float inv = powf(10000.f, -(float)(lane & 15) * (1.f / 16.f));
    for (int row = gw; row < MT; row += NGW) {
        const bool lat = row >= CTX; const int t = row - CTX;
        const float* ur = U + (size_t)row * INP;
        float cs = 1.f, sn = 0.f;
        if (lat) { const float pos = (float)(((lane & 31) < 16) ? (t >> 6) : (t & 63)); const float ang = pos * inv; cs = cosf(ang); sn = sinf(ang); }
#pragma unroll 4
        for (int s = 0; s < 24; ++s) {
            const int isk = s >= 12, sh = isk ? s - 12 : s;
            const float val = ur[isk * 768 + sh * 64 + lane];
            const float ss = wave_sum(val * val);
            float y = val * (1.f / sqrtf(ss * (1.f / 64.f) + EPS)) * (isk ? gk : gq);
            const float partner = __shfl_xor(y, 32);
            if (lat) y = lane < 32 ? y * cs - partner * sn : y * cs + partner * sn;
            (isk ? Kb : Qb)[(size_t)row * 768 + sh * 64 + lane] = (bf16)f2bf(y);
        }
#pragma unroll
        for (int i = 0; i < 12; ++i) Vb[(size_t)row * 768 + lane + 64 * i] = (bf16)f2bf(ur[1536 + lane + 64 * i]);
        const bool hp = (row != 0 && row != CTX), hn = (row != CTX - 1 && row != MT - 1);
#pragma unroll 6
        for (int i = 0; i < 18; ++i) { const int ch = lane + 64 * i; const float* p = ur + C_SSM + 640 + ch;
            const float x0 = p[0], xm = hp ? *(p - INP) : 0.f, xp = hn ? p[INP] : 0.f;
            const float y = siluf_(cw[ch] * xm + cw[1152 + ch] * x0 + cw[2304 + ch] * xp + cb[ch]);
            if (ch < 640) SX[(size_t)row * 640 + ch] = y; else if (ch < 896) SB[(size_t)row * 256 + ch - 640] = y; else SC[(size_t)row * 256 + ch - 896] = y; }
        if (lane < 20) { const int d = lane / 10, hh = lane % 10; SDT[(size_t)row * 32 + d * 16 + hh] = softplusf_(ur[C_SSM + 1792 + lane] + dtb[lane]); }
    }
}
__device__ __forceinline__ void prep_rwkv(const Args& a, int l, LAS unsigned char* lds, int tid, int lane, int wave, int bid, int G) {
    unsigned char* ws = a.ws;
    const float* U = (const float*)(ws + WS_U);
    float* RW = (float*)(ws + WS_RW); constexpr size_t S = (size_t)MT * 640;
    float* BON = (float*)(ws + WS_BONUS);
    LAS float* us = (LAS float*)lds;
    const float* mu = a.in[I_MU] + (size_t)l * 2 * 2304;
    const float* w0 = a.in[I_W0] + (size_t)l * 2 * 640; const float* wup = a.in[I_WUP] + (size_t)l * 2 * 64 * 640;
    const float* a0 = a.in[I_A0] + (size_t)l * 2 * 640; const float* aup = a.in[I_AUP] + (size_t)l * 2 * 64 * 640;
    const float* gup = a.in[I_GUP] + (size_t)l * 128 * 640;
    const float* kkw = a.in[I_KK] + l * 640; const float* kaw = a.in[I_KA] + l * 640; const float* rkw = a.in[I_RK] + l * 640;
    for (int it = bid; it < MT / 8; it += G) {
        const int row0 = it * 8;
        __syncthreads();
        for (int i = tid; i < 8 * 2304; i += NTHR) { const int r = i / 2304, c = i % 2304; const int row = row0 + r;
            const float* p = U + (size_t)row * INP + C_RW + c;
            const bool hp = (row != 0 && row != CTX), hn = (row != CTX - 1 && row != MT - 1);
            const float x0 = p[0], xm = hp ? *(p - INP) : 0.f, xp = hn ? p[INP] : 0.f;
            float y = x0 + mu[c] * (xm - x0) + mu[2304 + c] * (xp - x0);
            if (c >= 1920 && c < 2048) y = tanhf(y); else if (c >= 2176) y = sigmoidf_(y);
            us[i] = y; }
        __syncthreads();
        for (int cpass = 0; cpass < 2; ++cpass) {
            const int c = tid + 512 * cpass;
            if (c < 640) {
                float wlf[8], wlb[8], icf[8], icb[8], gt[8];
#pragma unroll
                for (int r = 0; r < 8; ++r) { wlf[r] = w0[c]; wlb[r] = w0[640 + c]; icf[r] = a0[c]; icb[r] = a0[640 + c]; gt[r] = 0.f; }
                for (int j = 0; j < 64; ++j) { const float m0 = wup[(size_t)j * 640 + c], m1 = wup[(size_t)(64 + j) * 640 + c], m2 = aup[(size_t)j * 640 + c], m3 = aup[(size_t)(64 + j) * 640 + c];
#pragma unroll
                    for (int r = 0; r < 8; ++r) { const LAS float* ur = us + r * 2304;
                        wlf[r] += ur[1920 + j] * m0; wlb[r] += ur[1984 + j] * m1; icf[r] += ur[2048 + j] * m2; icb[r] += ur[2112 + j] * m3; } }
                for (int j = 0; j < 128; ++j) { const float m4 = gup[(size_t)j * 640 + c];
#pragma unroll
                    for (int r = 0; r < 8; ++r) gt[r] += us[r * 2304 + 2176 + j] * m4; }
                const float kkc = kkw[c], kac = kaw[c], rkc = rkw[c]; const int head = c >> 6;
#pragma unroll
                for (int r = 0; r < 8; ++r) { const int row = row0 + r; const LAS float* ur = us + r * 2304; const size_t o = (size_t)row * 640 + c;
                    const float rr = ur[c], kx = ur[640 + c], vv = ur[1280 + c];
                    const float kraw = kx * kkc; const float kk = kraw * (1.f / sqrtf(wave_sum(kraw * kraw) + 1e-12f));
                    const float df = expf(-expf(-softplusf_(-wlf[r]) - 0.5f)), db = expf(-expf(-softplusf_(-wlb[r]) - 0.5f));
                    const float if_ = sigmoidf_(icf[r]), ib_ = sigmoidf_(icb[r]);
                    const float kf = kx * (1.f + (if_ - 1.f) * kac), kb = kx * (1.f + (ib_ - 1.f) * kac);
                    const float bs = wave_sum(rr * (kf + kb) * rkc);
                    RW[0 * S + o] = rr; RW[1 * S + o] = vv; RW[2 * S + o] = kk; RW[3 * S + o] = df; RW[4 * S + o] = db; RW[5 * S + o] = kf; RW[6 * S + o] = kb;
                    RW[7 * S + o] = kk * if_; RW[8 * S + o] = kk * ib_; RW[9 * S + o] = gt[r];
                    if (lane == 0) BON[(size_t)row * 16 + head] = bs; }
            }
        }
    }
    __syncthreads();
}

__device__ __forceinline__ int seq_row(int p, int dir) { return dir == 0 ? p : (p < CTX ? CTX - 1 - p : MT - 1 - (p - CTX)); }
__device__ __forceinline__ float quad_sum(float v) { v += __shfl_xor(v, 1); v += __shfl_xor(v, 2); return v; }

__device__ __forceinline__ void rwkv_scan_task(const Args& a, int h, int dir, LAS unsigned char* lds, int tid, int lane, int wave) {
    unsigned char* ws = a.ws; constexpr size_t S = (size_t)MT * 640;
    const float* RW = (const float*)(ws + WS_RW);
    const float* arr[6] = { RW + 2 * S  , RW + (7 + dir) * S  , RW + (3 + dir) * S  , RW + (5 + dir) * S  , RW + 0 * S  , RW + 1 * S   };
    float* Y = (float*)(ws + WS_RY) + dir * S;
    LAS float* tile = (LAS float*)lds;
    const int rr = lane >> 2, kq = lane & 3, vrow = wave * 16 + rr;
    float st[16];
#pragma unroll
    for (int j = 0; j < 16; ++j) st[j] = 0.f;
    for (int p0 = 0; p0 < MT; p0 += 32) {
        __syncthreads();
        { const int s = tid >> 4, q4 = tid & 15; const int row = seq_row(p0 + s, dir);
#pragma unroll
          for (int i = 0; i < 6; ++i) *(LAS f32x4*)(tile + (i * 32 + s) * 64 + 4 * q4) = *(const f32x4*)(arr[i] + (size_t)row * 640 + h * 64 + 4 * q4); }
        __syncthreads();
        if (wave < 4) {
            for (int s = 0; s < 32; ++s) {
                const LAS float* tk = tile + (0 * 32 + s) * 64 + 16 * kq; const LAS float* tb = tile + (1 * 32 + s) * 64 + 16 * kq; const LAS float* tw = tile + (2 * 32 + s) * 64 + 16 * kq;
                const LAS float* tkk = tile + (3 * 32 + s) * 64 + 16 * kq; const LAS float* tr = tile + (4 * 32 + s) * 64 + 16 * kq;
                const float vv = tile[(5 * 32 + s) * 64 + vrow];
                float sa = 0.f;
#pragma unroll
                for (int j = 0; j < 16; ++j) sa += st[j] * tk[j];
                sa = quad_sum(sa);
                float y = 0.f;
#pragma unroll
                for (int j = 0; j < 16; ++j) { st[j] = st[j] * tw[j] - sa * tb[j] + vv * tkk[j]; y += st[j] * tr[j]; }
                y = quad_sum(y);
                if (kq == 0) Y[(size_t)seq_row(p0 + s, dir) * 640 + h * 64 + vrow] = y;
            }
        }
    }
    __syncthreads();
}
__device__ __forceinline__ void ssd_scan_task(const Args& a, int l, int h, int dir, LAS unsigned char* lds, int tid, int lane, int wave) {
    unsigned char* ws = a.ws; constexpr size_t S = (size_t)MT * 640;
    const float* SX = (const float*)(ws + WS_SX); const float* SB = (const float*)(ws + WS_SB); const float* SC = (const float*)(ws + WS_SC); const float* SDT = (const float*)(ws + WS_SDT);
    float* Y = (float*)(ws + WS_SY) + dir * S;
    const float A = -expf(a.in[I_ALOG][l * 20 + dir * 10 + h]);
    const int grp = h / 5;
    LAS float* tB = (LAS float*)lds;
    LAS float* tC = tB + 32 * 128;
    LAS float* tX = tC + 32 * 128;
    LAS float* tD = tX + 32 * 64;
    const int rr = lane >> 2, kq = lane & 3, prow = wave * 16 + rr;
    float st[32];
#pragma unroll
    for (int j = 0; j < 32; ++j) st[j] = 0.f;
    for (int p0 = 0; p0 < MT; p0 += 32) {
        __syncthreads();
#pragma unroll
        for (int i = 0; i < 2; ++i) { const int idx = tid + 512 * i, s = idx >> 5, q4 = idx & 31; const int row = seq_row(p0 + s, dir);
            *(LAS f32x4*)(tB + s * 128 + 4 * q4) = *(const f32x4*)(SB + (size_t)row * 256 + grp * 128 + 4 * q4);
            *(LAS f32x4*)(tC + s * 128 + 4 * q4) = *(const f32x4*)(SC + (size_t)row * 256 + grp * 128 + 4 * q4); }
        { const int s = tid >> 4, q4 = tid & 15; const int row = seq_row(p0 + s, dir);
          *(LAS f32x4*)(tX + s * 64 + 4 * q4) = *(const f32x4*)(SX + (size_t)row * 640 + h * 64 + 4 * q4); }
        if (tid < 32) tD[tid] = SDT[(size_t)seq_row(p0 + tid, dir) * 32 + dir * 16 + h];
        __syncthreads();
        if (wave < 4) {
            for (int s = 0; s < 32; ++s) {
                const float dt = tD[s]; const float dA = expf(dt * A); const float cf = dt * tX[s * 64 + prow];
                const LAS float* pb = tB + s * 128 + 32 * kq; const LAS float* pc = tC + s * 128 + 32 * kq;
                float y = 0.f;
#pragma unroll
                for (int j = 0; j < 32; ++j) { st[j] = st[j] * dA + cf * pb[j]; y += st[j] * pc[j]; }
                y = quad_sum(y);
                if (kq == 0) Y[(size_t)seq_row(p0 + s, dir) * 640 + h * 64 + prow] = y;
            }
        }
    }
    __syncthreads();
}

__device__ __forceinline__ void mixfin_phase(const Args& a, int l, int gw, int NGW, int lane) {
    unsigned char* ws = a.ws; constexpr size_t S = (size_t)MT * 640;
    const float* AO = (const float*)(ws + WS_AO); const float* RW = (const float*)(ws + WS_RW); const float* BON = (const float*)(ws + WS_BONUS);
    const float* RY = (const float*)(ws + WS_RY); const float* SY = (const float*)(ws + WS_SY); const float* SX = (const float*)(ws + WS_SX); const float* U = (const float*)(ws + WS_U);
    bf16* MIX = (bf16*)(ws + WS_MIX);
    const float lam = ((const float*)(ws + WS_LAM))[l]; const float lam_init = 0.8f - 0.6f * expf(-0.3f * (float)l);
    const float* subg = a.in[I_SUBLN] + l * 128; const float* lng = a.in[I_LNG] + l * 640; const float* lnb = a.in[I_LNB] + l * 640;
    const float* dsk = a.in[I_DSKIP] + l * 20; const float* sng = a.in[I_SSMG] + l * 640;
    for (int row = gw; row < MT; row += NGW) {
        bf16* mr = MIX + (size_t)row * DM;
#pragma unroll 2
        for (int h = 0; h < 6; ++h) { const float* p0 = AO + (size_t)row * 1536 + (2 * h) * 128 + 2 * lane; const f32x2 x0 = *(const f32x2*)p0, x1 = *(const f32x2*)(p0 + 128);
            const f32x2 o = x0 - lam * x1; const float rs = 1.f / sqrtf(wave_sum(o.x * o.x + o.y * o.y) * (1.f / 128.f) + EPS);
            const f32x2 gg = *(const f32x2*)(subg + 2 * lane); const float sc = rs * (1.f - lam_init);
            *(unsigned*)(mr + h * 128 + 2 * lane) = pk2(o.x * sc * gg.x, o.y * sc * gg.y); }
#pragma unroll 2
        for (int h = 0; h < 10; ++h) { const size_t o = (size_t)row * 640 + h * 64 + lane; const int c = h * 64 + lane;
            const float y = RY[o] + RY[S + o]; const float mean = wave_sum(y) * (1.f / 64.f); const float yc = y - mean; const float var = wave_sum(yc * yc) * (1.f / 64.f);
            const float yn = yc * (1.f / sqrtf(var + LN_X_EPS));
            const float out = (yn * lng[c] + lnb[c] + BON[(size_t)row * 16 + h] * RW[1 * S + o]) * RW[9 * S + o];
            mr[768 + c] = (bf16)f2bf(out); }
#pragma unroll
        for (int g = 0; g < 2; ++g) { float yg[5]; float ss = 0.f;
#pragma unroll
            for (int i = 0; i < 5; ++i) { const int c = g * 320 + i * 64 + lane; const int h = c >> 6; const size_t o = (size_t)row * 640 + c;
                const float y = SY[o] + SY[S + o] + (dsk[h] + dsk[10 + h]) * SX[o]; const float z = U[(size_t)row * INP + C_SSM + c];
                yg[i] = y * siluf_(z); ss += yg[i] * yg[i]; }
            const float rs = 1.f / sqrtf(wave_sum(ss) * (1.f / 320.f) + EPS);
#pragma unroll
            for (int i = 0; i < 5; ++i) { const int c = g * 320 + i * 64 + lane; mr[1408 + c] = (bf16)f2bf(yg[i] * rs * sng[c]); } }
    }
}
namespace att {
using bf16x8 = __attribute__((ext_vector_type(8))) short;
using s16x4  = __attribute__((ext_vector_type(4))) short;
using f32x16 = __attribute__((ext_vector_type(16))) float;
using u32x4  = __attribute__((ext_vector_type(4))) unsigned;
constexpr int NW = 8, QBLK = 32, KVBLK = 64, LD = 768, LDO = 1536;
constexpr float SCALE = 0.125f, THR = 8.f;
constexpr size_t SHM_V = KVBLK * 128 * 2, SHM_K = KVBLK * 64 * 2, SHM_ATTN = 2 * SHM_V + 2 * SHM_K + NW * 64 * 4;
#define KSWZ64(row, colB) ((row) * 128 + ((colB) ^ ((((row) >> 1) & 7) << 4)))
#define SBAR() __builtin_amdgcn_sched_barrier(0)
__device__ __forceinline__ int crow(int r, int hi) { return (r & 3) + 8 * (r >> 2) + 4 * hi; }
__device__ __forceinline__ unsigned cvtpk(float lo, float hi) { unsigned r; asm volatile("v_cvt_pk_bf16_f32 %0, %1, %2" : "=v"(r) : "v"(lo), "v"(hi)); return r; }

__device__ __forceinline__ void partialSM(f32x16& p0, f32x16& p1, float& m_reg, float& mn, float& alpha) {
  constexpr float C = SCALE * 1.4426950408889634f;
  float pmax = p0[0];
#pragma unroll
  for (int r = 1; r < 16; ++r) pmax = fmaxf(pmax, p0[r]);
#pragma unroll
  for (int r = 0; r < 16; ++r) pmax = fmaxf(pmax, p1[r]);
  { auto rr = __builtin_amdgcn_permlane32_swap(__float_as_uint(pmax), __float_as_uint(pmax), false, false);
    pmax = fmaxf(__uint_as_float(rr[0]), __uint_as_float(rr[1])); }
  if (__builtin_expect(__all(pmax - m_reg <= THR / SCALE), 1)) { mn = m_reg; alpha = 1.f; }
  else { mn = fmaxf(m_reg, pmax); alpha = __builtin_amdgcn_exp2f((m_reg - mn) * C); m_reg = mn; }
  float mnC = -mn * C;
#pragma unroll
  for (int r = 0; r < 16; ++r) p0[r] = fmaf(p0[r], C, mnC);
#pragma unroll
  for (int r = 0; r < 16; ++r) p1[r] = fmaf(p1[r], C, mnC);
#pragma unroll
  for (int r = 0; r < 16; ++r) p0[r] = __builtin_amdgcn_exp2f(p0[r]);
}
__device__ __forceinline__ void finishSM(f32x16& p0, f32x16& p1, float alpha, float& l_reg, bf16x8& pa0, bf16x8& pa1, bf16x8& pa2, bf16x8& pa3) {
#pragma unroll
  for (int r = 0; r < 16; ++r) p1[r] = __builtin_amdgcn_exp2f(p1[r]);
  float ps = 0;
#pragma unroll
  for (int r = 0; r < 16; ++r) ps += p0[r];
#pragma unroll
  for (int r = 0; r < 16; ++r) ps += p1[r];
  { auto rr = __builtin_amdgcn_permlane32_swap(__float_as_uint(ps), __float_as_uint(ps), false, false);
    ps = __uint_as_float(rr[0]) + __uint_as_float(rr[1]); }
  l_reg = l_reg * alpha + ps;
#define PK4(P, BASE, OUT) do { unsigned a0 = cvtpk(P[BASE + 0], P[BASE + 1]), a1 = cvtpk(P[BASE + 2], P[BASE + 3]);   \
    unsigned b0 = cvtpk(P[BASE + 4], P[BASE + 5]), b1 = cvtpk(P[BASE + 6], P[BASE + 7]);                              \
    auto r0 = __builtin_amdgcn_permlane32_swap(a0, b0, false, false); auto r1 = __builtin_amdgcn_permlane32_swap(a1, b1, false, false); \
    u32x4 w = {r0[0], r1[0], r0[1], r1[1]}; OUT = *reinterpret_cast<bf16x8*>(&w); } while (0)
  PK4(p0, 0, pa0); PK4(p0, 8, pa1); PK4(p1, 0, pa2); PK4(p1, 8, pa3);
#undef PK4
}
__device__ __forceinline__ void qkt(f32x16& p0, f32x16& p1, const char* Ks, const bf16x8* qr, int r32, int hi) {
  p0 = f32x16{}; p1 = f32x16{};
#pragma unroll
  for (int d0 = 0; d0 < 4; ++d0) { const int cb = (d0 * 16 + hi * 8) * 2;
    bf16x8 b0 = *reinterpret_cast<const bf16x8*>(Ks + KSWZ64(r32, cb));
    bf16x8 b1 = *reinterpret_cast<const bf16x8*>(Ks + KSWZ64(32 + r32, cb));
    p0 = __builtin_amdgcn_mfma_f32_32x32x16_bf16(b0, qr[d0], p0, 0, 0, 0);
    p1 = __builtin_amdgcn_mfma_f32_32x32x16_bf16(b1, qr[d0], p1, 0, 0, 0); }
}
__device__ __forceinline__ int v_st(int k, int c) { const int kk = (k & ~0xC) | ((k & 4) << 1) | ((k & 8) >> 1); return ((kk >> 3) * 4 + (c >> 5)) * 512 + ((kk & 7) * 32 + (c & 31)) * 2; }
__device__ __forceinline__ int v_rd_base(int lane) { return ((lane & 3) << 3) | (((lane >> 2) & 3) << 6) | (((lane >> 4) & 1) << 5) | (((lane >> 5) & 1) << 8); }
constexpr int v_rd_off(int d0, int ks, int half) { return d0 * 512 + ks * 4096 + half * 2048; }
template <int OFF> __device__ __forceinline__ s16x4 tr_read(int vb) {
  s16x4 r; asm volatile("ds_read_b64_tr_b16 %0, %1 offset:%2" : "=&v"(r) : "v"(vb), "i"(OFF) : "memory"); return r;
}
template <int D0> __device__ __forceinline__ void pv_one(f32x16& od, int vb, bf16x8 pa0, bf16x8 pa1, bf16x8 pa2, bf16x8 pa3) {
  const s16x4 l0 = tr_read<v_rd_off(D0, 0, 0)>(vb), h0 = tr_read<v_rd_off(D0, 0, 1)>(vb), l1 = tr_read<v_rd_off(D0, 1, 0)>(vb), h1 = tr_read<v_rd_off(D0, 1, 1)>(vb);
  const s16x4 l2 = tr_read<v_rd_off(D0, 2, 0)>(vb), h2 = tr_read<v_rd_off(D0, 2, 1)>(vb), l3 = tr_read<v_rd_off(D0, 3, 0)>(vb), h3 = tr_read<v_rd_off(D0, 3, 1)>(vb);
  asm volatile("s_waitcnt lgkmcnt(0)" ::: "memory"); SBAR();
#define PK(L, H) (bf16x8){L[0], L[1], L[2], L[3], H[0], H[1], H[2], H[3]}
  od = __builtin_amdgcn_mfma_f32_32x32x16_bf16(pa0, PK(l0, h0), od, 0, 0, 0);
  od = __builtin_amdgcn_mfma_f32_32x32x16_bf16(pa1, PK(l1, h1), od, 0, 0, 0);
  od = __builtin_amdgcn_mfma_f32_32x32x16_bf16(pa2, PK(l2, h2), od, 0, 0, 0);
  od = __builtin_amdgcn_mfma_f32_32x32x16_bf16(pa3, PK(l3, h3), od, 0, 0, 0);
#undef PK
}
__device__ __forceinline__ void pv_d0(f32x16* o, int vb, bf16x8 pa0, bf16x8 pa1, bf16x8 pa2, bf16x8 pa3) {
  pv_one<0>(o[0], vb, pa0, pa1, pa2, pa3); pv_one<1>(o[1], vb, pa0, pa1, pa2, pa3); pv_one<2>(o[2], vb, pa0, pa1, pa2, pa3); pv_one<3>(o[3], vb, pa0, pa1, pa2, pa3);
}
__device__ __forceinline__ void attn_unit(const unsigned short* Qb, const unsigned short* Kh, const unsigned short* Vh, float* Ob, int seq, char* lds) {
  int tid_l = threadIdx.x; asm volatile("" : "+v"(tid_l));
  const int tid = tid_l, wid = tid >> 6, lane = tid & 63, r32 = lane & 31, hi = lane >> 5;
  char* V_lds = lds; char* K_lds = lds + 2 * SHM_V;
  float* wsf = (float*)(lds + 2 * SHM_V + 2 * SHM_K) + wid * 64; float* li_l = wsf; float* al_l = wsf + 32;
  float m_reg = -1e30f, l_reg = 0; f32x16 o[4] = {}; bf16x8 qr[4];
  const unsigned short* Qw = Qb + (long)(wid * QBLK + r32) * LD + hi * 8;
#pragma unroll
  for (int d0 = 0; d0 < 4; ++d0) qr[d0] = *reinterpret_cast<const bf16x8*>(Qw + d0 * 16);
  const int sr = tid >> 4, sc = (tid & 15) * 8, vst0 = v_st(sr, sc), vst1 = v_st(32 + sr, sc);
  const int kr = tid >> 3, kc = (tid & 7) * 8, kst = KSWZ64(kr, kc * 2);
  const int vb0 = (int)(uintptr_t)V_lds + v_rd_base(lane);
  struct { bf16x8 vs0, vs1, ks0; } sr_[2];
#define SLOAD(i, k0) do { sr_[i].vs0 = *reinterpret_cast<const bf16x8*>(&Vh[(long)((k0) + sr) * LD + sc]); sr_[i].vs1 = *reinterpret_cast<const bf16x8*>(&Vh[(long)((k0) + 32 + sr) * LD + sc]); \
    sr_[i].ks0 = *reinterpret_cast<const bf16x8*>(&Kh[(long)((k0) + kr) * LD + kc]); } while (0)
#define SWRITE(b, i) do { *(bf16x8*)(V_lds + (b) * SHM_V + vst0) = sr_[i].vs0; *(bf16x8*)(V_lds + (b) * SHM_V + vst1) = sr_[i].vs1; \
    *(bf16x8*)(K_lds + (b) * SHM_K + kst) = sr_[i].ks0; } while (0)
#define SWAIT() asm volatile("s_waitcnt vmcnt(3)" ::: "memory")
#define RESC(a) do { if (__any((a) < 1.f)) { if (hi == 0) al_l[r32] = (a); asm volatile("s_waitcnt lgkmcnt(0)" ::: "memory"); \
    _Pragma("unroll") for (int d = 0; d < 4; ++d) _Pragma("unroll") for (int r = 0; r < 16; ++r) o[d][r] *= al_l[crow(r, hi)]; } } while (0)
  f32x16 pA0, pA1, pB0, pB1; float mnA, mnB, alA, alB; bf16x8 pa0, pa1, pa2, pa3; const int NT = seq / KVBLK;
  constexpr int SE = 0, SO = 1;
  SLOAD(SE, 0); asm volatile("s_waitcnt vmcnt(0)" ::: "memory"); SWRITE(0, SE); __syncthreads();
  qkt(pA0, pA1, K_lds, qr, r32, hi); partialSM(pA0, pA1, m_reg, mnA, alA);
  SLOAD(SO, KVBLK); if (2 < NT) SLOAD(SE, 2 * KVBLK);
  SWAIT(); SWRITE(1, SO); __syncthreads();
  for (int j = 1; j + 1 < NT; j += 2) {
    SBAR(); qkt(pB0, pB1, K_lds + SHM_K, qr, r32, hi);
    finishSM(pA0, pA1, alA, l_reg, pa0, pa1, pa2, pa3); SBAR();
    SLOAD(SO, (j + 2) * KVBLK); SBAR();
    pv_d0(o, vb0, pa0, pa1, pa2, pa3); partialSM(pB0, pB1, m_reg, mnB, alB);
    __syncthreads(); SWAIT(); SWRITE(0, SE);
    RESC(alB); __syncthreads();
    SBAR(); qkt(pA0, pA1, K_lds, qr, r32, hi);
    finishSM(pB0, pB1, alB, l_reg, pa0, pa1, pa2, pa3); SBAR();
    if (j + 3 < NT) SLOAD(SE, (j + 3) * KVBLK); SBAR();
    pv_d0(o, vb0 + (int)SHM_V, pa0, pa1, pa2, pa3); partialSM(pA0, pA1, m_reg, mnA, alA);
    __syncthreads(); SWAIT(); SWRITE(1, SO);
    RESC(alA); __syncthreads();
  }
  SBAR(); qkt(pB0, pB1, K_lds + SHM_K, qr, r32, hi);
  finishSM(pA0, pA1, alA, l_reg, pa0, pa1, pa2, pa3); SBAR();
  pv_d0(o, vb0, pa0, pa1, pa2, pa3); partialSM(pB0, pB1, m_reg, mnB, alB);
  __syncthreads(); RESC(alB);
  finishSM(pB0, pB1, alB, l_reg, pa0, pa1, pa2, pa3); SBAR();
  pv_d0(o, vb0 + (int)SHM_V, pa0, pa1, pa2, pa3);
  if (hi == 0) li_l[r32] = l_reg; asm volatile("s_waitcnt lgkmcnt(0)" ::: "memory");
  float rli[16];
#pragma unroll
  for (int r = 0; r < 16; ++r) rli[r] = __builtin_amdgcn_rcpf(li_l[crow(r, hi)]);
  float* Ow = Ob + (long)(wid * QBLK) * LDO;
#pragma unroll
  for (int r = 0; r < 16; ++r) { const int orow = crow(r, hi);
#pragma unroll
    for (int d0 = 0; d0 < 4; ++d0) Ow[(long)orow * LDO + d0 * 32 + r32] = o[d0][r] * rli[r]; }
#undef SLOAD
#undef SWRITE
#undef SWAIT
#undef RESC
}
#undef SBAR
}
enum Phase { PH_PRE = 0, PH_NORM1, PH_INPROJ, PH_PREP, PH_ATTN, PH_SCAN, PH_MIXFIN, PH_OUTPROJ, PH_NORM2, PH_FFN1, PH_FFN2, PH_COUNT };

__global__ void __launch_bounds__(NTHR, 2) fwd_kernel(Args a) {
    extern __shared__ __attribute__((aligned(16))) unsigned char lds_raw[];
    LAS unsigned char* lds = (LAS unsigned char*)lds_raw;
    const int G = gridDim.x, bid = blockIdx.x, NGW = G * NWAVES;
    int tid = threadIdx.x, lane = tid & 63, wave = __builtin_amdgcn_readfirstlane(tid >> 6), gw = bid * NWAVES + wave;
#define FRESH() do { tid = threadIdx.x; asm volatile("" : "+v"(tid)); lane = tid & 63; wave = __builtin_amdgcn_readfirstlane(tid >> 6); gw = bid * NWAVES + wave; } while (0)
    unsigned char* ws = a.ws;
    volatile LAS unsigned* MISC = (volatile LAS unsigned*)(lds + MISC_OFF);
    if (tid < 64) MISC[tid] = 0u;
    __syncthreads();
    XcdBarrier bar; bar.bar = (unsigned*)(ws + WS_CTL) + CW_BAR; bar.x = 0; bar.st = nullptr;
    if (a.single) bar = xcd_barrier_post((unsigned*)(ws + WS_CTL) + CW_BAR, MISC + 8);
#ifndef PHMASK
#define PHMASK 0xFFFF
#endif
#define RUN(l_, k_) (((PHMASK >> (k_)) & 1) && (a.single || (a.layer == (l_) && a.phase == (k_))))
#define SEAM() do { if (a.single) xcd_barrier(bar); } while (0)

    if (RUN(0, PH_PRE)) { FRESH(); pre_phase(a, lds, tid, lane, wave, bid, G); SEAM(); }

    const int l_lo = a.single ? 0 : a.layer, l_hi = a.single ? DEPTH : a.layer + 1;
    for (int l = l_lo; l < l_hi; ++l) {
        const float* xl_in = (l == 0) ? a.in[I_X] : a.out;
        const float* xc_in = (l == 0) ? a.in[I_CTX] : (const float*)(ws + WS_XC);
        float* xl_out = a.out; float* xc_out = (float*)(ws + WS_XC);
        const float* modl = (const float*)(ws + WS_MOD) + (size_t)l * 2 * 12288;
        bf16* H = (bf16*)(ws + WS_H);

        if (RUN(l, PH_NORM1)) { FRESH(); norm_phase(xl_in, xc_in, a.in[I_N1G] + l * DM, modl, 0, H, gw, NGW, lane); SEAM(); }

        if (RUN(l, PH_INPROJ)) {
            pg8::Gemm g{(const pg8::bf16_t*)H, (const pg8::bf16_t*)(ws + WS_WIN + l * SZ_WIN), MT, INP, DM}; pg8::StaticOrder S; S.init(MT, INP, G, bid);
            EpiStoreF32 E{(float*)(ws + WS_U), INP};
            pg8::gemm_phase<EpiStoreF32, pg8::StaticOrder, true, true>(lds, g, S, E);
            SEAM();
        }

        if (RUN(l, PH_PREP)) { FRESH(); prep_rows(a, l, gw, NGW, lane); prep_rwkv(a, l, lds, tid, lane, wave, bid, G); SEAM(); }

        if (RUN(l, PH_ATTN)) {
            const unsigned short* Qb = (const unsigned short*)(ws + WS_Q); const unsigned short* Kb = (const unsigned short*)(ws + WS_K); const unsigned short* Vb = (const unsigned short*)(ws + WS_V);
            float* AO = (float*)(ws + WS_AO);
            for (int u = bid; u < 12 * 32 + 12; u += G) {
                __syncthreads();
                if (u < 384) { const int vh = u >> 5, qb = u & 31;
                    att::attn_unit(Qb + (size_t)(CTX + 256 * qb) * 768 + vh * 64, Kb + vh * 64, Vb + (vh >> 1) * 128, AO + (size_t)(CTX + 256 * qb) * 1536 + vh * 128, MT, (char*)lds_raw);
                } else { const int vh = u - 384;
                    att::attn_unit(Qb + vh * 64, Kb + vh * 64, Vb + (vh >> 1) * 128, AO + vh * 128, CTX, (char*)lds_raw); }
            }
            __syncthreads();
            SEAM();
        }

        if (RUN(l, PH_SCAN)) {
            FRESH();
            for (int t = bid; t < 40; t += G) {
                if (t < 20) rwkv_scan_task(a, t >> 1, t & 1, lds, tid, lane, wave);
                else ssd_scan_task(a, l, (t - 20) >> 1, (t - 20) & 1, lds, tid, lane, wave);
            }
            SEAM();
        }

        if (RUN(l, PH_MIXFIN)) { FRESH(); mixfin_phase(a, l, gw, NGW, lane); SEAM(); }

        if (RUN(l, PH_OUTPROJ)) {
            pg8::Gemm g{(const pg8::bf16_t*)(ws + WS_MIX), (const pg8::bf16_t*)(ws + WS_WOUT + l * SZ_WOUT), MT, DM, DM}; pg8::StaticOrder S; S.init(MT, DM, G, bid);
            EpiResid E{xl_in, xc_in, xl_out, xc_out, modl + 2 * DM, modl + 12288 + 2 * DM};
            pg8::gemm_phase<EpiResid, pg8::StaticOrder, true, true>(lds, g, S, E);
            SEAM();
        }

        if (RUN(l, PH_NORM2)) { FRESH(); norm_phase(xl_out, xc_out, a.in[I_N2G] + l * DM, modl, 3, H, gw, NGW, lane); SEAM(); }

        if (RUN(l, PH_FFN1)) {
            pg8::Gemm g{(const pg8::bf16_t*)H, (const pg8::bf16_t*)(ws + WS_WF1 + l * SZ_WF1), MT, 2 * DFF, DM}; pg8::StaticOrder S; S.init(MT, 2 * DFF, G, bid);
            EpiSwiglu E{(bf16*)(ws + WS_G)};
            pg8::gemm_phase<EpiSwiglu, pg8::StaticOrder, true, true>(lds, g, S, E);
            SEAM();
        }

        if (RUN(l, PH_FFN2)) {
            pg8::Gemm g{(const pg8::bf16_t*)(ws + WS_G), (const pg8::bf16_t*)(ws + WS_WF2 + l * SZ_WF2), MT, DM, DFF}; pg8::StaticOrder S; S.init(MT, DM, G, bid);
            EpiResid E{xl_out, xc_out, xl_out, xc_out, modl + 5 * DM, modl + 12288 + 5 * DM};
            pg8::gemm_phase<EpiResid, pg8::StaticOrder, true, true>(lds, g, S, E);
            SEAM();
        }
    }
#undef RUN
#undef SEAM
}

#ifndef MK_SINGLE
#define MK_SINGLE 0
#endif
extern "C" void kernel_launch(void* const* d_in, const int* in_sizes, int n_in, void* d_out, int out_size, void* d_ws, size_t ws_size, hipStream_t stream) {
    static int grid = 0;
    if (grid == 0) {
        if (n_in != 33 || out_size != SEQ * DM || ws_size < WS_END) { fprintf(stderr, "kernel_launch: unexpected shapes: n_in %d out %d ws %zu (need %zu)\n", n_in, out_size, ws_size, (size_t)WS_END); grid = -1; return; }
        int dev = 0, cus = 0, per_cu = 0;
        if (hipGetDevice(&dev) != hipSuccess || hipDeviceGetAttribute(&cus, hipDeviceAttributeMultiprocessorCount, dev) != hipSuccess) { grid = -1; return; }
        if (hipFuncSetAttribute((const void*)fwd_kernel, hipFuncAttributeMaxDynamicSharedMemorySize, LDS_BYTES) != hipSuccess) { fprintf(stderr, "kernel_launch: hipFuncSetAttribute failed\n"); grid = -1; return; }
        if (hipOccupancyMaxActiveBlocksPerMultiprocessor(&per_cu, (const void*)fwd_kernel, NTHR, LDS_BYTES) != hipSuccess || per_cu < 1) { fprintf(stderr, "kernel_launch: occupancy query says %d\n", per_cu); }
        (void)hipGetLastError();
        grid = cus;
    }
    if (grid < 0) return;
    (void)hipMemsetAsync((char*)d_ws + WS_CTL, 0, CTL_ZERO_BYTES, stream);
    Args a{};
    for (int i = 0; i < 33; ++i) a.in[i] = (const float*)d_in[i];
    a.out = (float*)d_out; a.ws = (unsigned char*)d_ws;
#if MK_SINGLE
    a.single = 1; a.layer = 0; a.phase = 0;
    hipLaunchKernelGGL(fwd_kernel, dim3(grid), dim3(NTHR), LDS_BYTES, stream, a);
#else
    a.single = 0;
    a.layer = 0; a.phase = PH_PRE; hipLaunchKernelGGL(fwd_kernel, dim3(grid), dim3(NTHR), LDS_BYTES, stream, a);
    for (int l = 0; l < DEPTH; ++l)
        for (int k = PH_NORM1; k < PH_COUNT; ++k) { a.layer = l; a.phase = k; hipLaunchKernelGGL(fwd_kernel, dim3(grid), dim3(NTHR), LDS_BYTES, stream, a); }
#endif
    const hipError_t le = hipPeekAtLastError();
    if (le != hipSuccess) fprintf(stderr, "kernel_launch: launch failed: %s\n", hipGetErrorName(le));
}
```

```cpp
#include <hip/hip_runtime.h>
#include <hip/hip_bf16.h>
#include <cstdio>
#include <cstdint>
#include <cmath>
__device__ __forceinline__ int lane_id_() { return (int)__builtin_amdgcn_mbcnt_hi(~0u, __builtin_amdgcn_mbcnt_lo(~0u, 0u)); }

namespace pg8 {
#define PG8_LAS __attribute__((address_space(3)))
typedef unsigned short bf16_t;
typedef short bf16x8 __attribute__((ext_vector_type(8)));
typedef float f32x4 __attribute__((ext_vector_type(4)));
typedef unsigned u32x4 __attribute__((ext_vector_type(4)));
constexpr int BM = 256, BK = 64, HALF = 128, HTB = HALF * BK * 2  , STAGE_BYTES = 8 * HTB, NXCD = 8, WGM = 8;

__host__ __device__ __forceinline__ int lds_byte(int r, int c) { const int st = (r >> 4) * 2 + (c >> 5), rr = r & 15, cc = c & 31, ob = rr * 64 + cc * 2; return st * 1024 + (ob ^ (((ob >> 9) & 1) << 5)); }
__host__ __device__ __forceinline__ void stage_rc(int b, int& R, int& C) { const int st = b / 1024, sb = b % 1024, swz = sb ^ (((sb >> 9) & 1) << 5); R = (st >> 1) * 16 + swz / 64; C = (st & 1) * 32 + (swz % 64) / 2; }
__host__ __device__ __forceinline__ int perm32(int rho) { const int n = rho >> 4, i = rho & 15; return 8 * (i >> 2) + 4 * n + (i & 3); }

struct Unit { int pm, pn, k0, nt, kp; };
struct Gemm { const bf16_t* A; const bf16_t* Bt; int M, N, K; };

struct StaticOrder {
    int nM, nN, nwg, G, c;
    __host__ __device__ void init(int M, int N, int G_, int c_) { nM = M / BM; nN = N / BM; nwg = nM * nN; G = G_; c = c_; }
    __host__ __device__ bool next(int i, Unit& u) const {
        const long L = (long)i * G + c; if (L >= nwg) return false;
        int wgid = (int)L; { const int q = nwg / NXCD, r = nwg % NXCD, xcd = wgid % NXCD, off = wgid / NXCD; wgid = (xcd < r ? xcd * (q + 1) : r * (q + 1) + (xcd - r) * q) + off; }
        const int nig = WGM * nN, gid = wgid / nig, fm = gid * WGM, gsz = (nM - fm) < WGM ? (nM - fm) : WGM;
        u.pm = fm + ((wgid % nig) % gsz); u.pn = (wgid % nig) / gsz; u.k0 = 0; u.nt = 0; u.kp = -1; return true;
    }
    __device__ __forceinline__ void a_ready(const Unit&) const {}
    __device__ __forceinline__ void done(const Unit&) const {}
};

__device__ __forceinline__ unsigned cvt_pk_bf16(float lo, float hi) { unsigned r; asm volatile("v_cvt_pk_bf16_f32 %0, %1, %2" : "=v"(r) : "v"(lo), "v"(hi)); return r; }
typedef float f32x2 __attribute__((ext_vector_type(2)));
__device__ __forceinline__ f32x2 gelu_pk(f32x2 v) {
    const f32x2 av = __builtin_elementwise_abs(v), d = av * 0.2316418882f + 1.0f;
    f32x2 t; t.x = __builtin_amdgcn_rcpf(d.x); t.y = __builtin_amdgcn_rcpf(d.y);
    f32x2 q = t * 0.5307027145f + (-0.7265760135f); q = q * t + 0.7107068705f; q = q * t + (-0.142248368f); q = q * t + 0.127414796f; q = q * t;
    const f32x2 s = (v * v) * (-0.72134752044f);
    f32x2 e; e.x = __builtin_amdgcn_exp2f(s.x); e.y = __builtin_amdgcn_exp2f(s.y);
    const f32x2 m = v * (q * e), r = v - m;
    f32x2 o; o.x = v.x < 0.f ? m.x : r.x; o.y = v.y < 0.f ? m.y : r.y; return o;
}

template <int ACT  > struct EpiBf16 {
    static constexpr bool PERM = true, AFTER_DRAIN = false; static_assert(ACT == 0 || ACT == 1, "EpiBf16: ACT is 0 (none) or 1 (gelu_pk)");
    bf16_t* O; int ldc; const float* bias; int split_cols; size_t split_stride; float scale0;
    __device__ __forceinline__ void operator()(const f32x4 (&acc)[2][2][4][2], const Unit& u, int wr, int wc, int fr, int fq) const {
        const int row0 = u.pm * BM + wr * 64 + fr; int colt = u.pn * BM; bf16_t* base = O;
        float sc = 1.f; if (split_cols) { const int t = colt / split_cols; base += (size_t)t * split_stride; colt -= t * split_cols; if (t == 0) sc = scale0; }
        const int col0 = colt + wc * 32 + 8 * fq, bcol0 = u.pn * BM + wc * 32 + 8 * fq;
        f32x4 bv[2][2];
#pragma unroll
        for (int bj = 0; bj < 2; ++bj)
#pragma unroll
            for (int n = 0; n < 2; ++n) bv[bj][n] = bias ? *(const f32x4*)(bias + bcol0 + bj * HALF + 4 * n) : (f32x4){0.f, 0.f, 0.f, 0.f};
#pragma unroll
        for (int ai = 0; ai < 2; ++ai)
#pragma unroll
            for (int m = 0; m < 4; ++m) { bf16_t* rowp = base + (size_t)(row0 + ai * HALF + m * 16) * ldc + col0;
#pragma unroll
                for (int bj = 0; bj < 2; ++bj) { f32x4 v0 = acc[ai][bj][m][0] + bv[bj][0], v1 = acc[ai][bj][m][1] + bv[bj][1];
                    if (ACT == 1) { f32x2 a = gelu_pk((f32x2){v0[0], v0[1]}), b = gelu_pk((f32x2){v0[2], v0[3]}), c = gelu_pk((f32x2){v1[0], v1[1]}), d = gelu_pk((f32x2){v1[2], v1[3]});
                        v0 = (f32x4){a.x, a.y, b.x, b.y}; v1 = (f32x4){c.x, c.y, d.x, d.y}; }
                    v0 = v0 * sc; v1 = v1 * sc; u32x4 w; w.x = cvt_pk_bf16(v0[0], v0[1]); w.y = cvt_pk_bf16(v0[2], v0[3]); w.z = cvt_pk_bf16(v1[0], v1[1]); w.w = cvt_pk_bf16(v1[2], v1[3]);
                    *(u32x4*)(rowp + bj * HALF) = w; } }
    }
};

struct PanelStats {
    unsigned* xbuf;
    unsigned* cnt;
    unsigned* tmo;
    int ntn; float eps;
    unsigned code;
    __device__ __forceinline__ bool run(const f32x4 (&v)[2][2][4][2], const Unit& u, int wr, int wc, int fr, int fq, PG8_LAS unsigned char* lds, int wid, int lane) const {
        typedef float f32x2v __attribute__((ext_vector_type(2)));
        PG8_LAS f32x2v* P = (PG8_LAS f32x2v*)lds;
        PG8_LAS f32x2v* S = (PG8_LAS f32x2v*)(lds + 8192);
        PG8_LAS unsigned* flag = (PG8_LAS unsigned*)(lds + 8192 + 2048);
#pragma unroll
        for (int ai = 0; ai < 2; ++ai)
#pragma unroll
            for (int m = 0; m < 4; ++m) {
                float s = 0.f;
#pragma unroll
                for (int bj = 0; bj < 2; ++bj)
#pragma unroll
                    for (int n = 0; n < 2; ++n) { const f32x4 x = v[ai][bj][m][n]; s += (x[0] + x[1]) + (x[2] + x[3]); }
                s += __shfl_xor(s, 16); s += __shfl_xor(s, 32);
                const float mw = s * (1.0f / 64.0f); float q = 0.f;
#pragma unroll
                for (int bj = 0; bj < 2; ++bj)
#pragma unroll
                    for (int n = 0; n < 2; ++n) { const f32x4 d = v[ai][bj][m][n] - mw; q += (d[0] * d[0] + d[1] * d[1]) + (d[2] * d[2] + d[3] * d[3]); }
                q += __shfl_xor(q, 16); q += __shfl_xor(q, 32);
                if (fq == 0) P[(ai * HALF + wr * 64 + m * 16 + fr) * 4 + wc] = (f32x2v){mw, q};
            }
        asm volatile("s_waitcnt lgkmcnt(0)" ::: "memory"); __builtin_amdgcn_s_barrier(); asm volatile("" ::: "memory");
#if defined(BROKEN_EXCHANGE_NO_WAIT)
#warning BROKEN CONTROL BUILD: the row-statistics exchange does not wait; results are wrong by design
        if (blockIdx.x >= 64) { const long long t0_ = clock64(); while (clock64() - t0_ < 60000) __builtin_amdgcn_s_sleep(8); }
#endif
        const int row = wid * 32 + (lane & 31);
        if (lane < 32) {
            const f32x2v a = P[row * 4 + 0], b = P[row * 4 + 1], c = P[row * 4 + 2], d = P[row * 4 + 3];
            const float mt = (a.x + b.x + c.x + d.x) * 0.25f;
            const float da = a.x - mt, db = b.x - mt, dc = c.x - mt, dd = d.x - mt;
            const float m2 = (a.y + b.y) + (c.y + d.y) + 64.0f * ((da * da + db * db) + (dc * dc + dd * dd));
            unsigned long long* slot = (unsigned long long*)xbuf + ((size_t)(u.pm * BM + row) * 4 + u.pn);
            __hip_atomic_store(slot, ((unsigned long long)__float_as_uint(m2) << 32) | __float_as_uint(mt), __ATOMIC_RELAXED, __HIP_MEMORY_SCOPE_AGENT);
        }
        asm volatile("s_waitcnt vmcnt(0)" ::: "memory");
        if (lane == 0) __hip_atomic_fetch_add(cnt + 64 * u.pm, 1u, __ATOMIC_RELAXED, __HIP_MEMORY_SCOPE_AGENT);
        if (wid == 0) {
            bool dead = false; const unsigned long long t0 = __builtin_amdgcn_s_memrealtime(); const unsigned want = 8u * (unsigned)ntn;
            for (;;) {
#if defined(BROKEN_EXCHANGE_NO_WAIT)
                break;
#endif
                if ((unsigned)__builtin_amdgcn_readfirstlane(__hip_atomic_load(cnt + 64 * u.pm, __ATOMIC_RELAXED, __HIP_MEMORY_SCOPE_AGENT)) >= want) break;
                if (__builtin_amdgcn_s_memrealtime() - t0 > 2000000ull) {
                    if (lane == 0) { unsigned expect = 0u; __hip_atomic_compare_exchange_strong(tmo + 1, &expect, code | (unsigned)(u.pm & 0xff), __ATOMIC_RELAXED, __ATOMIC_RELAXED, __HIP_MEMORY_SCOPE_AGENT);
                                     __hip_atomic_store(tmo, 1u, __ATOMIC_RELAXED, __HIP_MEMORY_SCOPE_AGENT); }
                    dead = true; break; }
                __builtin_amdgcn_s_sleep(2);
            }
            __builtin_amdgcn_fence(__ATOMIC_ACQUIRE, "agent");
            if (lane == 0) flag[0] = dead ? 1u : 0u;
        }
        asm volatile("s_waitcnt vmcnt(0) lgkmcnt(0)" ::: "memory"); __builtin_amdgcn_s_barrier(); asm volatile("" ::: "memory");
        const bool bad = flag[0] != 0u;
        if (lane < 32) {
            const unsigned long long* slot = (const unsigned long long*)xbuf + (size_t)(u.pm * BM + row) * 4; float mt[4], m2[4]; float ms = 0.f;
#pragma unroll
            for (int t = 0; t < 4; ++t) { if (t < ntn) { const unsigned long long w = __hip_atomic_load(slot + t, __ATOMIC_RELAXED, __HIP_MEMORY_SCOPE_AGENT); mt[t] = __uint_as_float((unsigned)w); m2[t] = __uint_as_float((unsigned)(w >> 32)); } else { mt[t] = 0.f; m2[t] = 0.f; } ms += mt[t]; }
            const float mean = ms / (float)ntn; float q = 0.f;
#pragma unroll
            for (int t = 0; t < 4; ++t) if (t < ntn) { const float dm = mt[t] - mean; q += m2[t] + 256.0f * dm * dm; }
            S[row] = (f32x2v){mean, 1.0f / sqrtf(q / (256.0f * (float)ntn) + eps)};
        }
        asm volatile("s_waitcnt lgkmcnt(0)" ::: "memory"); __builtin_amdgcn_s_barrier(); asm volatile("" ::: "memory");
        return bad;
    }
};
struct EpiLnRes {
    static constexpr bool PERM = false, AFTER_DRAIN = true;
    const float* base; float* out; int ldc; const float* bias; PanelStats st; unsigned poison;
    __device__ __forceinline__ void fused(f32x4 (&acc)[2][2][4][2], const Unit& u, int wr, int wc, int fr, int fq, PG8_LAS unsigned char* lds, int wid, int lane) const {
        typedef float f32x2v __attribute__((ext_vector_type(2)));
        const PG8_LAS f32x2v* S = (const PG8_LAS f32x2v*)(lds + 8192);
        const int col0 = u.pn * BM + wc * 32 + 4 * fq;
#pragma unroll
        for (int bj = 0; bj < 2; ++bj)
#pragma unroll
            for (int n = 0; n < 2; ++n) { const f32x4 bv = bias ? *(const f32x4*)(bias + col0 + bj * HALF + n * 16) : (f32x4){0.f, 0.f, 0.f, 0.f};
#pragma unroll
                for (int ai = 0; ai < 2; ++ai)
#pragma unroll
                    for (int m = 0; m < 4; ++m) acc[ai][bj][m][n] += bv; }
        f32x4 pre[4][2][2];
#pragma unroll
        for (int m = 0; m < 4; ++m) { const size_t off = (size_t)(u.pm * BM + wr * 64 + m * 16 + fr) * ldc + col0;
#pragma unroll
            for (int bj = 0; bj < 2; ++bj)
#pragma unroll
                for (int n = 0; n < 2; ++n) pre[m][bj][n] = *(const f32x4*)(base + off + bj * HALF + n * 16); }
        const bool bad = st.run(acc, u, wr, wc, fr, fq, lds, wid, lane) || poison != 0u;
        const float qnan = __builtin_nanf("");
#pragma unroll
        for (int ai = 0; ai < 2; ++ai)
#pragma unroll
            for (int m = 0; m < 4; ++m) { const int r = ai * HALF + wr * 64 + m * 16 + fr; const f32x2v sr = S[r]; const size_t off = (size_t)(u.pm * BM + r) * ldc + col0;
#pragma unroll
                for (int bj = 0; bj < 2; ++bj)
#pragma unroll
                    for (int n = 0; n < 2; ++n) { const f32x4 bs = ai == 0 ? pre[m][bj][n] : *(const f32x4*)(base + off + bj * HALF + n * 16); f32x4 o = bs + (acc[ai][bj][m][n] - sr.x) * sr.y;
                        if (bad) o = (f32x4){qnan, qnan, qnan, qnan}; *(f32x4*)(out + off + bj * HALF + n * 16) = o; }
                if (m & 1) asm volatile("" ::: "memory"); }
    }
};
struct EpiLnResLn {
    static constexpr bool PERM = false, AFTER_DRAIN = true;
    const float* base; float* out; bf16_t* xn; int ldc; const float* bias; PanelStats st1, st2; unsigned poison;
    __device__ __forceinline__ void fused(f32x4 (&acc)[2][2][4][2], const Unit& u, int wr, int wc, int fr, int fq, PG8_LAS unsigned char* lds, int wid, int lane) const {
        typedef float f32x2v __attribute__((ext_vector_type(2))); typedef unsigned u32x2v __attribute__((ext_vector_type(2)));
        const PG8_LAS f32x2v* S = (const PG8_LAS f32x2v*)(lds + 8192);
        const int col0 = u.pn * BM + wc * 32 + 4 * fq;
#pragma unroll
        for (int bj = 0; bj < 2; ++bj)
#pragma unroll
            for (int n = 0; n < 2; ++n) { const f32x4 bv = bias ? *(const f32x4*)(bias + col0 + bj * HALF + n * 16) : (f32x4){0.f, 0.f, 0.f, 0.f};
#pragma unroll
                for (int ai = 0; ai < 2; ++ai)
#pragma unroll
                    for (int m = 0; m < 4; ++m) acc[ai][bj][m][n] += bv; }
        bool bad = st1.run(acc, u, wr, wc, fr, fq, lds, wid, lane) || poison != 0u;
        const float qnan = __builtin_nanf("");
#pragma unroll
        for (int ai = 0; ai < 2; ++ai)
#pragma unroll
            for (int m = 0; m < 4; ++m) { const int r = ai * HALF + wr * 64 + m * 16 + fr; const f32x2v sr = S[r]; const size_t off = (size_t)(u.pm * BM + r) * ldc + col0;
#pragma unroll
                for (int bj = 0; bj < 2; ++bj)
#pragma unroll
                    for (int n = 0; n < 2; ++n) { const f32x4 bs = *(const f32x4*)(base + off + bj * HALF + n * 16); acc[ai][bj][m][n] = bs + (acc[ai][bj][m][n] - sr.x) * sr.y; }
                asm volatile("" : "+v"(acc[ai][0][m][0]), "+v"(acc[ai][0][m][1]), "+v"(acc[ai][1][m][0]), "+v"(acc[ai][1][m][1]));
                if (m & 1) asm volatile("" ::: "memory"); }
        const bool bad1 = bad;
        bad = st2.run(acc, u, wr, wc, fr, fq, lds, wid, lane) || bad;
#pragma unroll
        for (int ai = 0; ai < 2; ++ai)
#pragma unroll
            for (int m = 0; m < 4; ++m) { const int r = ai * HALF + wr * 64 + m * 16 + fr; const f32x2v sr = S[r]; const size_t off = (size_t)(u.pm * BM + r) * ldc + col0;
#pragma unroll
                for (int bj = 0; bj < 2; ++bj)
#pragma unroll
                    for (int n = 0; n < 2; ++n) { const f32x4 x1 = acc[ai][bj][m][n]; *(f32x4*)(out + off + bj * HALF + n * 16) = bad1 ? (f32x4){qnan, qnan, qnan, qnan} : x1;
                        const f32x4 o = (x1 - sr.x) * sr.y; u32x2v w; w.x = cvt_pk_bf16(o[0], o[1]); w.y = cvt_pk_bf16(o[2], o[3]);
                        if (bad) { w.x = 0x7fc07fc0u; w.y = 0x7fc07fc0u; } *(u32x2v*)(xn + off + bj * HALF + n * 16) = w; }
                asm volatile("" ::: "memory"); }
    }
};

template <class Epi, class Sched, bool ALIGN_EPI = false, bool SP2 = false>
__device__ __forceinline__ void gemm_phase(PG8_LAS unsigned char* lds, const Gemm g, const Sched& S, const Epi& E, int wave_s) {
    int tid_l = wave_s * 64 + lane_id_(); asm volatile("" : "+v"(tid_l));
    const int tid = tid_l, wid = __builtin_amdgcn_readfirstlane(tid >> 6), lane = tid & 63, wr = wid >> 2, wc = wid & 3, fr = lane & 15, fq = lane >> 4;
    const int K = g.K, nt = K / BK;
    unsigned voffA[2], voffB[2];
#pragma unroll
    for (int i = 0; i < 2; ++i) { int R, C; stage_rc(tid * 16 + i * 8192, R, C); const int Rb = Epi::PERM ? ((R & ~31) + perm32(R & 31)) : R;
        voffA[i] = (unsigned)(R * K + C) * 2u; voffB[i] = (unsigned)(Rb * K + C) * 2u; }
    const size_t kstep = (size_t)(BK * 2);
    const size_t hstep = (size_t)HALF * K * 2;
    const size_t tstep = 2 * hstep;
    const unsigned ldsw = (unsigned)wid * 1024u;
    const int aoff = lds_byte(wr * 64 + fr, fq * 8), boff = lds_byte(wc * 32 + fr, fq * 8);
#define PG8_SA(b, h) (((b) * 2 + (h)) * HTB)
#define PG8_SB(b, h) ((4 + (b) * 2 + (h)) * HTB)
#define PG8_STAGE(bufoff, gbase, voff) do { _Pragma("unroll") for (int _i = 0; _i < 2; ++_i) \
        __builtin_amdgcn_global_load_lds((const unsigned*)((const char*)(gbase) + (voff)[_i]), (PG8_LAS unsigned*)(lds + (bufoff) + ldsw + _i * 8192), 16, 0, 0); } while (0)
#define PG8_LDA(dst, b, h) do { _Pragma("unroll") for (int m = 0; m < 4; ++m) _Pragma("unroll") for (int k = 0; k < 2; ++k) dst[m][k] = *(const PG8_LAS bf16x8*)(lds + PG8_SA(b, h) + aoff + m * 2048 + k * 1024); } while (0)
#define PG8_LDB(dst, b, h) do { _Pragma("unroll") for (int n = 0; n < 2; ++n) _Pragma("unroll") for (int k = 0; k < 2; ++k) dst[n][k] = *(const PG8_LAS bf16x8*)(lds + PG8_SB(b, h) + boff + n * 2048 + k * 1024); } while (0)
#define PG8_MMA(ai, bj, At, Bt) do { __builtin_amdgcn_s_setprio(1); _Pragma("unroll") for (int m = 0; m < 4; ++m) _Pragma("unroll") for (int n = 0; n < 2; ++n) _Pragma("unroll") for (int k = 0; k < 2; ++k) \
        acc[ai][bj][m][n] = __builtin_amdgcn_mfma_f32_16x16x32_bf16(Bt[n][k], At[m][k], acc[ai][bj][m][n], 0, 0, 0); __builtin_amdgcn_s_setprio(0); } while (0)
#define PG8_WAIT_V(n) asm volatile("s_waitcnt vmcnt(" #n ")" ::: "memory")
#define PG8_WAIT_L(n) asm volatile("s_waitcnt lgkmcnt(" #n ")" ::: "memory")
#define PG8_BAR __builtin_amdgcn_s_barrier()
#define PG8_SCHED __builtin_amdgcn_sched_barrier(0)
    Unit cur, nxt; int ui = 0;
    if (!S.next(0, cur)) return;
    f32x4 acc[2][2][4][2];
#pragma unroll
    for (int a = 0; a < 2; ++a)
#pragma unroll
        for (int b = 0; b < 2; ++b)
#pragma unroll
            for (int m = 0; m < 4; ++m)
#pragma unroll
                for (int n = 0; n < 2; ++n) acc[a][b][m][n] = (f32x4){0.f, 0.f, 0.f, 0.f};
    bf16x8 At[4][2], B0[2][2], B1[2][2];
    const char* cA = (const char*)g.A + (size_t)cur.pm * tstep + (size_t)cur.k0 * kstep; const char* cB = (const char*)g.Bt + (size_t)cur.pn * tstep + (size_t)cur.k0 * kstep;
    int cnt = cur.nt ? cur.nt : nt;
    S.a_ready(cur);
    if constexpr (SP2) {
        PG8_STAGE(PG8_SB(0, 0), cB, voffB); PG8_STAGE(PG8_SB(0, 1), cB + hstep, voffB); PG8_STAGE(PG8_SA(0, 0), cA, voffA); PG8_STAGE(PG8_SA(0, 1), cA + hstep, voffA);
        if (wr == 1) PG8_BAR;
        PG8_WAIT_V(2); PG8_BAR;
        PG8_STAGE(PG8_SB(1, 0), cB + kstep, voffB); PG8_STAGE(PG8_SA(1, 0), cA + kstep, voffA); PG8_STAGE(PG8_SB(1, 1), cB + hstep + kstep, voffB);
        PG8_WAIT_V(6); PG8_BAR;
    } else {
        PG8_STAGE(PG8_SB(0, 0), cB, voffB); PG8_STAGE(PG8_SA(0, 0), cA, voffA); PG8_STAGE(PG8_SB(0, 1), cB + hstep, voffB); PG8_STAGE(PG8_SA(0, 1), cA + hstep, voffA);
        if (wr == 1) PG8_BAR;
        PG8_WAIT_V(4); PG8_BAR;
        PG8_STAGE(PG8_SB(1, 0), cB + kstep, voffB); PG8_STAGE(PG8_SA(1, 0), cA + kstep, voffA); PG8_STAGE(PG8_SB(1, 1), cB + hstep + kstep, voffB);
        PG8_WAIT_V(6); PG8_BAR;
    }
    for (;;) {
        const bool has_next = S.next(ui + 1, nxt);
        const char* nA = has_next ? (const char*)g.A + (size_t)nxt.pm * tstep + (size_t)nxt.k0 * kstep : cA; const char* nB = has_next ? (const char*)g.Bt + (size_t)nxt.pn * tstep + (size_t)nxt.k0 * kstep : cB;
        for (int t = 0; t < cnt; t += 2) {
            const bool last = (t == cnt - 2);
            const char* a1 = cA + (size_t)(t + 1) * kstep;
            const char* a2 = last ? nA : cA + (size_t)(t + 2) * kstep; const char* b2 = last ? nB : cB + (size_t)(t + 2) * kstep;
            const char* a3 = a2 + kstep; const char* b3 = b2 + kstep;
            if (last && has_next) S.a_ready(nxt);
            if constexpr (SP2) {
            PG8_LDB(B0, 0, 0); PG8_LDB(B1, 0, 1); PG8_SCHED; PG8_LDA(At, 0, 0); PG8_STAGE(PG8_SA(1, 1), a1 + hstep, voffA);
            PG8_WAIT_V(8); PG8_WAIT_L(0); PG8_BAR; PG8_MMA(0, 0, At, B0); PG8_MMA(0, 1, At, B1); PG8_BAR; PG8_SCHED;
            PG8_LDA(At, 0, 1); PG8_STAGE(PG8_SB(0, 0), b2, voffB); PG8_STAGE(PG8_SB(0, 1), b2 + hstep, voffB); PG8_STAGE(PG8_SA(0, 0), a2, voffA);
            PG8_WAIT_V(8); PG8_WAIT_L(0); PG8_BAR; PG8_MMA(1, 0, At, B0); PG8_MMA(1, 1, At, B1); PG8_BAR; PG8_SCHED;
            PG8_LDB(B0, 1, 0); PG8_LDB(B1, 1, 1); PG8_SCHED; PG8_LDA(At, 1, 0); PG8_STAGE(PG8_SA(0, 1), a2 + hstep, voffA);
            PG8_WAIT_V(8); PG8_WAIT_L(0); PG8_BAR; PG8_MMA(0, 0, At, B0); PG8_MMA(0, 1, At, B1); PG8_BAR; PG8_SCHED;
            PG8_LDA(At, 1, 1); PG8_STAGE(PG8_SB(1, 0), b3, voffB); PG8_STAGE(PG8_SB(1, 1), b3 + hstep, voffB); PG8_STAGE(PG8_SA(1, 0), a3, voffA);
            PG8_WAIT_V(8); PG8_WAIT_L(0); PG8_BAR; PG8_MMA(1, 0, At, B0); PG8_MMA(1, 1, At, B1); PG8_BAR; PG8_SCHED;
            } else {
            PG8_LDB(B0, 0, 0); PG8_SCHED; PG8_LDA(At, 0, 0); PG8_STAGE(PG8_SA(1, 1), a1 + hstep, voffA);
            PG8_WAIT_L(8); PG8_BAR; PG8_WAIT_L(0); PG8_MMA(0, 0, At, B0); PG8_BAR; PG8_SCHED;
            PG8_LDB(B1, 0, 1); PG8_STAGE(PG8_SB(0, 0), b2, voffB);
            PG8_BAR; PG8_WAIT_L(0); PG8_MMA(0, 1, At, B1); PG8_BAR;
            PG8_LDA(At, 0, 1); PG8_STAGE(PG8_SA(0, 0), a2, voffA);
            PG8_BAR; PG8_WAIT_L(0); PG8_MMA(1, 0, At, B0); PG8_BAR; PG8_SCHED;
            PG8_STAGE(PG8_SB(0, 1), b2 + hstep, voffB);
            PG8_WAIT_V(6); PG8_BAR; PG8_MMA(1, 1, At, B1); PG8_BAR;
            PG8_LDB(B0, 1, 0); PG8_SCHED; PG8_LDA(At, 1, 0); PG8_STAGE(PG8_SA(0, 1), a2 + hstep, voffA);
            PG8_WAIT_L(8); PG8_BAR; PG8_WAIT_L(0); PG8_MMA(0, 0, At, B0); PG8_BAR; PG8_SCHED;
            PG8_LDB(B1, 1, 1); PG8_STAGE(PG8_SB(1, 0), b3, voffB);
            PG8_BAR; PG8_WAIT_L(0); PG8_MMA(0, 1, At, B1); PG8_BAR;
            PG8_LDA(At, 1, 1); PG8_STAGE(PG8_SA(1, 0), a3, voffA);
            PG8_BAR; PG8_WAIT_L(0); PG8_MMA(1, 0, At, B0); PG8_BAR; PG8_SCHED;
            PG8_STAGE(PG8_SB(1, 1), b3 + hstep, voffB);
            PG8_WAIT_V(6); PG8_BAR; PG8_MMA(1, 1, At, B1); PG8_BAR;
            }
        }
        if constexpr (ALIGN_EPI) { if (wr == 0) PG8_BAR; }
        if constexpr (!Epi::AFTER_DRAIN) { E(acc, cur, wr, wc, fr, fq); S.done(cur); }
        if (!has_next) break;
#pragma unroll
        for (int a = 0; a < 2; ++a)
#pragma unroll
            for (int b = 0; b < 2; ++b)
#pragma unroll
                for (int m = 0; m < 4; ++m)
#pragma unroll
                    for (int n = 0; n < 2; ++n) acc[a][b][m][n] = (f32x4){0.f, 0.f, 0.f, 0.f};
        cur = nxt; cA = nA; cB = nB; ++ui; cnt = cur.nt ? cur.nt : nt;
        if constexpr (ALIGN_EPI) { if (wr == 1) PG8_BAR; }
    }
    PG8_WAIT_V(0);
    if constexpr (!ALIGN_EPI) { if (wr == 0) PG8_BAR; }
    PG8_BAR;
    if constexpr (Epi::AFTER_DRAIN) { E.fused(acc, cur, wr, wc, fr, fq, lds, wid, lane); S.done(cur); }
#undef PG8_SA
#undef PG8_SB
#undef PG8_STAGE
#undef PG8_LDA
#undef PG8_LDB
#undef PG8_MMA
#undef PG8_WAIT_V
#undef PG8_WAIT_L
#undef PG8_BAR
#undef PG8_SCHED
}
}
#define GAS __attribute__((address_space(1)))
#define LAS __attribute__((address_space(3)))
typedef unsigned short bf16;
typedef unsigned v4u __attribute__((ext_vector_type(4)));
typedef float f32x4 __attribute__((ext_vector_type(4)));
typedef short bf16x8 __attribute__((ext_vector_type(8)));
typedef GAS unsigned gu32;
typedef GAS unsigned long long gu64;
#define RLX_AGENT __ATOMIC_RELAXED, __HIP_MEMORY_SCOPE_AGENT
#define LDS_WAIT() asm volatile("s_waitcnt lgkmcnt(0)" ::: "memory")
#define VM_WAIT() asm volatile("s_waitcnt vmcnt(0)" ::: "memory")
__device__ __forceinline__ unsigned long long rt() { return __builtin_amdgcn_s_memrealtime(); }
__device__ __forceinline__ unsigned f2bf(float f) { unsigned u = __builtin_bit_cast(unsigned, f); return (u + 0x7fffu + ((u >> 16) & 1u)) >> 16; }
__device__ __forceinline__ unsigned pk2(float lo, float hi) { return f2bf(lo) | (f2bf(hi) << 16); }

#define XB_TMO      128
#define XB_XCNT(j)  (256  + 64 * (j))
#define XB_XSUB(j)  (1280 + 64 * (j))
#define XB_XGEN(j)  (2304 + 64 * (j))
#define XB_TOP      3328
#define XB_TOPGEN   3392
#define XCD_BAR_WORDS 3456
#define XB_SPIN_CAP (1u << 18)

__device__ __forceinline__ unsigned xb_ld(unsigned* p)              { return __hip_atomic_load(p, __ATOMIC_RELAXED, __HIP_MEMORY_SCOPE_AGENT); }
__device__ __forceinline__ unsigned xb_add(unsigned* p, unsigned v) { return __hip_atomic_fetch_add(p, v, __ATOMIC_RELAXED, __HIP_MEMORY_SCOPE_AGENT); }
__device__ __forceinline__ unsigned xb_xcc_id() { return (unsigned)__builtin_amdgcn_s_getreg((3 << 11) | 20) & 0xFu; }
#define XB_SPIN(cond, bar) do { unsigned _sp = 0; while (cond) { __builtin_amdgcn_s_sleep(1); \
    if ((++_sp & 255u) == 0u) { if (xb_ld(&(bar)[XB_TMO])) break; if (_sp > XB_SPIN_CAP) { atomicAdd(&(bar)[XB_TMO], 1u); break; } } } } while (0)

struct XcdBarrier {
    unsigned* bar; unsigned x;
    volatile LAS unsigned* st;
};

__device__ __forceinline__ XcdBarrier xcd_barrier_post(unsigned* bar, volatile LAS unsigned* st, bool t0) {
    XcdBarrier b; b.bar = bar; b.x = xb_xcc_id(); b.st = st;
    if (t0) (void)xb_add(&bar[XB_XCNT(b.x)], 1u);
    return b;
}
__device__ __forceinline__ void xcd_barrier_complete(unsigned* bar, unsigned x, unsigned& nloc, unsigned& nx) {
    const unsigned G = gridDim.x * gridDim.y * gridDim.z;
    unsigned sum, cnt, mine, sp = 0u;
    for (;;) {
        sum = 0u; cnt = 0u; mine = 0u;
#pragma unroll
        for (unsigned j = 0; j < 16; ++j) { const unsigned c = xb_ld(&bar[XB_XCNT(j)]); sum += c; cnt += (c > 0u) ? 1u : 0u; }
        mine = xb_ld(&bar[XB_XCNT(x)]);
        if (sum == G) break;
        __builtin_amdgcn_s_sleep(1);
        if ((++sp & 255u) == 0u) { if (xb_ld(&bar[XB_TMO])) break; if (sp > XB_SPIN_CAP) { atomicAdd(&bar[XB_TMO], 1u); break; } }
    }
    nloc = mine > 0u ? mine : 1u; nx = cnt > 0u ? cnt : 1u;
}

__device__ __forceinline__ void xcd_barrier(const XcdBarrier& b, bool t0) {
    asm volatile("s_waitcnt vmcnt(0)" ::: "memory");
    __syncthreads();
    if (t0) {
        unsigned* bar = b.bar;
        __builtin_amdgcn_s_waitcnt(0);
        unsigned nloc = b.st[0], nx = b.st[1];
        if (nloc == 0u) { xcd_barrier_complete(bar, b.x, nloc, nx); b.st[0] = nloc; b.st[1] = nx; }
        const unsigned old = xb_add(&bar[XB_XSUB(b.x)], 1u);
        const unsigned gen = old / nloc;
        if (old + 1u == (gen + 1u) * nloc) {
            __builtin_amdgcn_fence(__ATOMIC_RELEASE, "agent");
            asm volatile("s_waitcnt vmcnt(0)" ::: "memory");
            const unsigned og = xb_add(&bar[XB_TOP], 1u);
            const unsigned tg = og / nx;
            if (og + 1u == (tg + 1u) * nx) xb_add(&bar[XB_TOPGEN], 1u);
            else XB_SPIN(xb_ld(&bar[XB_TOPGEN]) == tg, bar);
            __builtin_amdgcn_fence(__ATOMIC_ACQUIRE, "agent");
            xb_add(&bar[XB_XGEN(b.x)], 1u);
            asm volatile("s_waitcnt vmcnt(0)" ::: "memory");
        } else {
            XB_SPIN(xb_ld(&bar[XB_XGEN(b.x)]) == gen, bar);
            __builtin_amdgcn_fence(__ATOMIC_ACQUIRE, "agent");
            asm volatile("s_waitcnt vmcnt(0)" ::: "memory");
        }
    }
    __syncthreads();
}
namespace sc {
typedef short bf16x8 __attribute__((ext_vector_type(8)));
typedef short bf16x4 __attribute__((ext_vector_type(4)));
typedef float f32x4 __attribute__((ext_vector_type(4)));
typedef float f32x2_t __attribute__((ext_vector_type(2))); typedef __bf16 bf16x2_t __attribute__((ext_vector_type(2)));
__device__ __forceinline__ unsigned cvtpk(float lo, float hi) { f32x2_t v = {lo, hi}; bf16x2_t b = __builtin_convertvector(v, bf16x2_t); return __builtin_bit_cast(unsigned, b); }
__device__ __forceinline__ float bf2f(unsigned short b) { return __uint_as_float((unsigned)b << 16); }
template <int K, class PA, class PB> __device__ __forceinline__ f32x4 tile_nt(f32x4 acc, PA a_row, PB b_row, int fq) {
#pragma unroll
    for (int k0 = 0; k0 < K; k0 += 32) { const bf16x8 a = *(const bf16x8*)(a_row + k0 + 8 * fq); const bf16x8 b = *(const bf16x8*)(b_row + k0 + 8 * fq);
        acc = __builtin_amdgcn_mfma_f32_16x16x32_bf16(b, a, acc, 0, 0, 0); }
    return acc;
}
__device__ __forceinline__ f32x4 ldu4(const unsigned short* p) { const bf16x4 v = *(const bf16x4*)p; return (f32x4){bf2f((unsigned short)v[0]), bf2f((unsigned short)v[1]), bf2f((unsigned short)v[2]), bf2f((unsigned short)v[3])}; }
__device__ __forceinline__ float ldu1(const unsigned short* p) { return bf2f(*p); }
__device__ __forceinline__ f32x4 widen4(bf16x4 v) { return (f32x4){bf2f((unsigned short)v[0]), bf2f((unsigned short)v[1]), bf2f((unsigned short)v[2]), bf2f((unsigned short)v[3])}; }
}
constexpr int DM = 2048, SEQ = 8192, CTX = 256, MT = SEQ + CTX, DEPTH = 4;
constexpr int INC = 6420, INP = 6656, DFF = 5632;
constexpr int W_ATT = 768, W_RW = 640, W_SSM = 640;
constexpr int C_RW = 2304, C_SSM = 4608;
constexpr float EPS = 1e-6f, LN_X_EPS = 64e-5f;
constexpr int NWAVES = 8, NTHR = 512;

constexpr size_t al256(size_t x) { return (x + 255) / 256 * 256; }
constexpr size_t WS_CTL = 0, CTL_ZERO_BYTES = 1u << 20;
constexpr size_t WS_MOD = CTL_ZERO_BYTES;
constexpr size_t WS_LAM = WS_MOD + al256((size_t)DEPTH * 2 * 12288 * 4);
constexpr size_t WS_WIN = WS_LAM + 256;
constexpr size_t SZ_WIN = (size_t)INP * DM * 2;
constexpr size_t WS_WOUT = WS_WIN + DEPTH * SZ_WIN;
constexpr size_t SZ_WOUT = (size_t)DM * DM * 2;
constexpr size_t WS_WF1 = WS_WOUT + DEPTH * SZ_WOUT;
constexpr size_t SZ_WF1 = (size_t)2 * DFF * DM * 2;
constexpr size_t WS_WF2 = WS_WF1 + DEPTH * SZ_WF1;
constexpr size_t SZ_WF2 = (size_t)DM * DFF * 2;
constexpr size_t WS_XC = WS_WF2 + DEPTH * SZ_WF2;
constexpr size_t WS_H = WS_XC + (size_t)CTX * DM * 4;
constexpr size_t WS_U = WS_H + (size_t)MT * DM * 2;
constexpr size_t WS_Q = WS_U + (size_t)MT * INP * 4;
constexpr size_t WS_K = WS_Q + (size_t)MT * 768 * 2;
constexpr size_t WS_V = WS_K + (size_t)MT * 768 * 2;
constexpr size_t WS_AO = WS_V + (size_t)MT * 768 * 2;
constexpr size_t SZ_RW = (size_t)MT * 640 * 4;
constexpr size_t WS_RW = WS_AO + (size_t)MT * 1536 * 4;
constexpr size_t WS_BONUS = WS_RW + 10 * SZ_RW;
constexpr size_t WS_RY = WS_BONUS + (size_t)MT * 16 * 4;
constexpr size_t WS_SX = WS_RY + 2 * SZ_RW;
constexpr size_t WS_SB = WS_SX + SZ_RW;
constexpr size_t WS_SC = WS_SB + (size_t)MT * 256 * 4;
constexpr size_t WS_SDT = WS_SC + (size_t)MT * 256 * 4;
constexpr size_t WS_SY = WS_SDT + (size_t)MT * 32 * 4;
constexpr size_t WS_MIX = WS_SY + 2 * SZ_RW;
constexpr size_t WS_G = WS_MIX + (size_t)MT * DM * 2;
constexpr size_t WS_END = WS_G + (size_t)MT * DFF * 2;

constexpr int SSD_NB = MT / 128;
constexpr size_t WS2_SBB = WS_END;
constexpr size_t WS2_SCB = WS2_SBB + (size_t)MT * 256 * 2;
constexpr size_t WS2_SAF = WS2_SCB + (size_t)MT * 256 * 2;
constexpr size_t WS2_SS = WS2_SAF + (size_t)MT * 32 * 4;
constexpr size_t WS2_SDEC = WS2_SS + (size_t)2 * 10 * SSD_NB * 8192 * 4;
constexpr size_t WS2_SHIN = WS2_SDEC + (size_t)2 * 10 * SSD_NB * 128;
constexpr size_t WS2_RQ = WS2_SHIN + (size_t)2 * 10 * SSD_NB * 8192 * 2;
constexpr size_t WS2_TCT = WS2_RQ + (size_t)2 * MT * 640 * 2;
constexpr size_t WS2_DC = WS2_TCT + (size_t)2 * 10 * 132 * 4096 * 2;
constexpr size_t WS2_SIN = WS2_DC + (size_t)2 * 10 * 132 * 4096 * 4;
constexpr size_t WS2_END = WS2_SIN + (size_t)2 * 10 * 132 * 4096 * 2;

constexpr int RW_NC = MT / 64;
constexpr size_t WS3_LRW = WS2_END;
constexpr size_t SZ_LRW = (size_t)(4 * 640 * 64 + 640 * 128) * 2;
#ifndef KS_OUT
#define KS_OUT 8
#endif
#ifndef KS_F2
#define KS_F2 22
#endif
constexpr size_t WS3_SLAB = WS3_LRW + DEPTH * SZ_LRW;
constexpr size_t WS3_MODP = WS3_SLAB + (size_t)22 * CTX * DM * 4;
constexpr size_t WS3_RYALT = WS3_MODP + (size_t)32 * 2 * 12288 * 4;
#ifdef RWKV_DEBUG
#define RWKV_YBUF WS3_RYALT
#else
#define RWKV_YBUF WS_RY
#endif
constexpr int CW_QUEUE = 1024;
constexpr int CW_DBG = 64;
constexpr int CW_BAR = 4096;

constexpr int RING_BYTES = 131072;
constexpr int MISC_OFF = 147456 - 256;
constexpr int LDS_BYTES = 147456;

typedef float f32x2 __attribute__((ext_vector_type(2)));
typedef unsigned u32x2 __attribute__((ext_vector_type(2)));

__device__ __forceinline__ float wave_sum(float v) {
#pragma unroll
    for (int o = 1; o < 64; o <<= 1) v += __shfl_xor(v, o);
    return v;
}
template <int CTRL, int ROWMASK> __device__ __forceinline__ float dpp0_(float v) { return __int_as_float(__builtin_amdgcn_update_dpp(0, __float_as_int(v), CTRL, ROWMASK, 0xF, false)); }
__device__ __forceinline__ float wave_scan_(float v) {
    v += dpp0_<0x111, 0xF>(v); v += dpp0_<0x112, 0xF>(v); v += dpp0_<0x114, 0xF>(v); v += dpp0_<0x118, 0xF>(v);
    v += dpp0_<0x142, 0xA>(v);
    v += dpp0_<0x143, 0xC>(v);
    return v; }
__device__ __forceinline__ float rsq_(float x) { return __builtin_amdgcn_rsqf(x); }
__device__ __forceinline__ float sigmoidf_(float x) { return __builtin_amdgcn_rcpf(1.f + __expf(-x)); }
__device__ __forceinline__ float siluf_(float x) { return x * __builtin_amdgcn_rcpf(1.f + __expf(-x)); }
__device__ __forceinline__ float softplusf_(float x) { return fmaxf(x, 0.f) + __logf(1.f + __expf(-fabsf(x))); }

__device__ __forceinline__ int lidx_(int i) { asm volatile("" : "+s"(i)); return i; }
#define LIDX(i) (i)
struct Args { const float* in[33]; float* out; unsigned char* ws; int single, layer, phase, pad; };
enum In { I_X = 0, I_C, I_CTX, I_CCTX, I_ADAW, I_ADAB, I_N1G, I_N2G, I_WIN, I_WOUT, I_QKG, I_LAMQ, I_LAMK, I_SUBLN, I_MU, I_W0, I_WUP, I_A0, I_AUP, I_GUP, I_KK, I_KA, I_RK,
          I_LNG, I_LNB, I_CONVW, I_CONVB, I_DTB, I_ALOG, I_DSKIP, I_SSMG, I_WF1, I_WF2 };

__device__ __forceinline__ void transpose_item(const float* W, int K, int N, bf16* WT, int dst_row0, LAS float* scr, int k0, int n0, int lane) {
    const int nn = n0 + (lane & 31);
#pragma unroll 8
    for (int i = 0; i < 32; ++i) { const int kk = 2 * i + (lane >> 5); scr[kk * 33 + (lane & 31)] = nn < N ? W[(size_t)(k0 + kk) * N + nn] : 0.f; }
    LDS_WAIT(); asm volatile("" ::: "memory");
    const int c = lane & 7;
#pragma unroll
    for (int j = 0; j < 4; ++j) { const int n = (lane >> 3) + 8 * j; const LAS float* s = scr + (8 * c) * 33 + n;
        v4u o; o.x = pk2(s[0 * 33], s[1 * 33]); o.y = pk2(s[2 * 33], s[3 * 33]); o.z = pk2(s[4 * 33], s[5 * 33]); o.w = pk2(s[6 * 33], s[7 * 33]);
        *(GAS v4u*)(WT + (size_t)(dst_row0 + n) * K + k0 + 8 * c) = o; }
    LDS_WAIT(); asm volatile("" ::: "memory");
}
__device__ __forceinline__ void transpose_item64(const float* W, int K, int N, bf16* WT, int dst_row0, LAS float* scr, int k0, int n0, int lane) {
    const int q = lane & 15, rs = lane >> 4; const bool ok = (n0 + 4 * q) < N;
    f32x4 v[16];
#pragma unroll
    for (int i = 0; i < 16; ++i) v[i] = ok ? *(const f32x4*)(W + (size_t)(k0 + 4 * i + rs) * N + n0 + 4 * q) : (f32x4){0.f, 0.f, 0.f, 0.f};
#pragma unroll
    for (int i = 0; i < 16; ++i) *(LAS f32x4*)(scr + (4 * i + rs) * 68 + 4 * q) = v[i];
    LDS_WAIT(); asm volatile("" ::: "memory");
    const int c = lane & 7, ns = lane >> 3;
#pragma unroll
    for (int j = 0; j < 8; ++j) { const int n = ns + 8 * j; const LAS float* sp = scr + (8 * c) * 68 + n;
        v4u o; o.x = pk2(sp[0 * 68], sp[1 * 68]); o.y = pk2(sp[2 * 68], sp[3 * 68]); o.z = pk2(sp[4 * 68], sp[5 * 68]); o.w = pk2(sp[6 * 68], sp[7 * 68]);
        *(GAS v4u*)(WT + (size_t)(dst_row0 + n) * K + k0 + 8 * c) = o; }
    LDS_WAIT(); asm volatile("" ::: "memory");
}
__device__ __forceinline__ void convert_items(const Args& a, int l, LAS float* scr, int lane, int first, int stride) {
    GAS unsigned char* wsg_ = (GAS unsigned char*)a.ws; asm volatile("" : "+s"(wsg_)); unsigned char* ws = (unsigned char*)wsg_;
    constexpr int NB_IN = (INC + 63) / 64;
    constexpr int IT_IN = 32 * NB_IN, IT_OUT = 32 * 32, IT_F1 = 32 * 176, IT_F2 = 88 * 32, IT_L = IT_IN + IT_OUT + IT_F1 + IT_F2;
    for (int it = first; it < IT_L; it += stride) {
        int r = it;
        if (r < IT_IN) { const int kb = r / NB_IN, nb = r % NB_IN;
            transpose_item64(a.in[LIDX(I_WIN)] + (size_t)l * DM * INC, DM, INC, (bf16*)(ws + WS_WIN + l * SZ_WIN), 64 * nb, scr, 64 * kb, 64 * nb, lane); continue; }
        r -= IT_IN;
        if (r < IT_OUT) { const int kb = r / 32, nb = r % 32;
            transpose_item64(a.in[LIDX(I_WOUT)] + (size_t)l * DM * DM, DM, DM, (bf16*)(ws + WS_WOUT + l * SZ_WOUT), 64 * nb, scr, 64 * kb, 64 * nb, lane); continue; }
        r -= IT_OUT;
        if (r < IT_F1) { const int kb = r / 176, nb = r % 176; const int n0 = 64 * nb; const int j0 = n0 < DFF ? n0 : n0 - DFF;
            const int dst = 256 * (j0 / 128) + (n0 < DFF ? 0 : 128) + (j0 % 128);
            transpose_item64(a.in[LIDX(I_WF1)] + (size_t)l * DM * 2 * DFF, DM, 2 * DFF, (bf16*)(ws + WS_WF1 + l * SZ_WF1), dst, scr, 64 * kb, n0, lane); continue; }
        r -= IT_F1;
        { const int kb = r / 32, nb = r % 32;
            transpose_item64(a.in[LIDX(I_WF2)] + (size_t)l * DFF * DM, DFF, DM, (bf16*)(ws + WS_WF2 + l * SZ_WF2), 64 * nb, scr, 64 * kb, 64 * nb, lane); }
    }
}
__device__ __forceinline__ void mod_tasks(const Args& a, int l, int nks, int first, int stride, int lane) {
    GAS unsigned char* wsg_ = (GAS unsigned char*)a.ws; asm volatile("" : "+s"(wsg_)); unsigned char* ws = (unsigned char*)wsg_;
    float* part = (float*)(ws + WS3_MODP);
    const float* W = a.in[LIDX(I_ADAW)] + (size_t)l * DM * 12288; const float* c0 = a.in[LIDX(I_C)]; const float* c1 = a.in[LIDX(I_CCTX)];
    const int rows = (((DM + nks - 1) / nks) + 15) & ~15;
    for (int t = first; t < 48 * nks; t += stride) {
        const int cb = t % 48, ks = t / 48; const int r0 = ks * rows; const int r1 = (r0 + rows < DM) ? r0 + rows : DM;
        const float* Wp = W + (size_t)r0 * 12288 + 256 * cb + 4 * lane;
        f32x4 a0 = {0.f, 0.f, 0.f, 0.f}, a1 = {0.f, 0.f, 0.f, 0.f};
        int r = r0;
#pragma unroll 1
        for (; r + 16 <= r1; r += 16) { f32x4 w[16];
#pragma unroll
            for (int i = 0; i < 16; ++i) w[i] = __builtin_nontemporal_load((const f32x4*)(Wp + (size_t)i * 12288));
#pragma unroll
            for (int i = 0; i < 16; ++i) { const float s0 = siluf_(c0[r + i]), s1 = siluf_(c1[r + i]); a0 += w[i] * s0; a1 += w[i] * s1; }
            Wp += (size_t)16 * 12288; }
#pragma unroll 1
        for (; r < r1; ++r) { const f32x4 w = *(const f32x4*)Wp; const float s0 = siluf_(c0[r]), s1 = siluf_(c1[r]); a0 += w * s0; a1 += w * s1; Wp += 12288; }
        float* p0 = part + (size_t)ks * 2 * 12288 + 256 * cb + 4 * lane;
        *(f32x4*)p0 = a0; *(f32x4*)(p0 + 12288) = a1;
    }
}
__device__ __forceinline__ void mod_reduce(const Args& a, int l, int nks, int bid, int G, int tid) {
    GAS unsigned char* wsg_ = (GAS unsigned char*)a.ws; asm volatile("" : "+s"(wsg_)); unsigned char* ws = (unsigned char*)wsg_;
    const float* part = (const float*)(ws + WS3_MODP); float* mod = (float*)(ws + WS_MOD) + (size_t)l * 2 * 12288;
    const int per = (2 * 12288 + G - 1) / G;
    for (int i = tid; i < per; i += NTHR) { const int idx = bid * per + i; if (idx < 2 * 12288) {
        float sacc = a.in[LIDX(I_ADAB)][(size_t)l * 12288 + idx % 12288];
        for (int ks = 0; ks < nks; ++ks) sacc += part[(size_t)ks * 2 * 12288 + idx];
        mod[idx] = sacc; } }
}
__device__ __forceinline__ void pre_phase(const Args& a, LAS unsigned char* lds, int tid, int lane, int wave, int bid, int G) {
    GAS unsigned char* wsg_ = (GAS unsigned char*)a.ws; asm volatile("" : "+s"(wsg_)); unsigned char* ws = (unsigned char*)wsg_;
    LAS float* scr = (LAS float*)(lds + wave * 17408);
    const int gw = bid * NWAVES + wave, NGW = G * NWAVES;
    constexpr int NB_IN = (INC + 31) / 32;
    constexpr int IT_IN = 32 * NB_IN, IT_OUT = 32 * 64, IT_F1 = 32 * 352, IT_F2 = 88 * 64, IT_L = IT_IN + IT_OUT + IT_F1 + IT_F2;
    convert_items(a, 0, scr, lane, gw, NGW);
    __syncthreads();
    mod_tasks(a, 0, 32, gw, NGW, lane);
    for (int i = bid * NTHR + tid; i < DEPTH * 245760; i += G * NTHR) {
        const int l = i / 245760; int r = i % 245760; bf16* dst = (bf16*)(ws + WS3_LRW + l * SZ_LRW);
        if (r < 163840) { const int mtx = r / 40960, e = r % 40960, c = e / 64, j = e % 64;
            const float* src = (mtx < 2 ? a.in[I_WUP] : a.in[I_AUP]) + ((size_t)l * 2 + (mtx & 1)) * 64 * 640;
            dst[mtx * 40960 + c * 64 + j] = (bf16)f2bf(src[(size_t)j * 640 + c]); }
        else { const int e = r - 163840, c = e / 128, j = e % 128; dst[163840 + c * 128 + j] = (bf16)f2bf(a.in[I_GUP][(size_t)l * 128 * 640 + (size_t)j * 640 + c]); }
    }
    if (bid == G - 1 && wave < DEPTH) {
        const int l = wave;
        const float s0 = wave_sum(a.in[LIDX(I_LAMQ)][l * 128 + lane] * a.in[LIDX(I_LAMK)][l * 128 + lane]), s1 = wave_sum(a.in[LIDX(I_LAMQ)][l * 128 + 64 + lane] * a.in[LIDX(I_LAMK)][l * 128 + 64 + lane]);
        const float lam_init = 0.8f - 0.6f * __expf(-0.3f * (float)l);
        if (lane == 0) ((float*)(ws + WS_LAM))[l] = __expf(s0) - __expf(s1) + lam_init;
    }
}

__device__ __forceinline__ void norm_phase(const float* xl, const float* xc, const float* g, const float* modl  , int shift_idx, bf16* H, int gw, int NGW, int lane,
                                           int nsplit, const float* slab, const float* sgate, float* xc_wb, LAS unsigned char* lds, int wave, int bid, int G) {
    LAS float* red = (LAS float*)lds;
    for (int row = bid; row < CTX; row += G) {
        const int col = 256 * wave + 4 * lane;
        f32x4 v = *(const f32x4*)(xc + (size_t)row * DM + col);
        if (nsplit > 0) { f32x4 s = {0.f, 0.f, 0.f, 0.f}; const f32x4 sgj = *(const f32x4*)(sgate + col);
#pragma unroll 1
            for (int p0 = 0; p0 < nsplit; p0 += 8) { f32x4 t[8];
#pragma unroll
                for (int p = 0; p < 8; ++p) t[p] = *(const f32x4*)(slab + ((size_t)(p0 + p < nsplit ? p0 + p : 0) * CTX + row) * DM + col);
#pragma unroll
                for (int p = 0; p < 8; ++p) { const float m = p0 + p < nsplit ? 1.f : 0.f; s += m * t[p]; } }
            v += sgj * s; *(f32x4*)(xc_wb + (size_t)row * DM + col) = v; }
        const float ssw = wave_sum((v.x * v.x + v.y * v.y) + (v.z * v.z + v.w * v.w));
        __syncthreads();
        if (lane == 0) red[wave] = ssw;
        __syncthreads();
        float tot = 0.f;
#pragma unroll
        for (int w = 0; w < NWAVES; ++w) tot += red[w];
        const float rs = rsq_(tot * (1.f / DM) + EPS);
        const float* md = modl + 12288;
        const f32x4 gg = *(const f32x4*)(g + col), sh = *(const f32x4*)(md + shift_idx * DM + col), sc = *(const f32x4*)(md + (shift_idx + 1) * DM + col);
        const f32x4 h = (v * rs) * gg * (1.f + sc) + sh; u32x2 w; w.x = pk2(h.x, h.y); w.y = pk2(h.z, h.w); *(u32x2*)(H + (size_t)row * DM + col) = w;
    }
    f32x4 Al[8], Bl[8];
#pragma unroll
    for (int j = 0; j < 8; ++j) { const int col = 4 * lane + 256 * j; Al[j] = *(const f32x4*)(g + col) * (1.f + *(const f32x4*)(modl + (shift_idx + 1) * DM + col)); Bl[j] = *(const f32x4*)(modl + shift_idx * DM + col); }
    for (int row = CTX + gw; row < MT; row += NGW) {
        const float* xr = xl + (size_t)(row - CTX) * DM;
        f32x4 v[8]; float ss = 0.f;
#pragma unroll
        for (int j = 0; j < 8; ++j) v[j] = *(const f32x4*)(xr + 4 * lane + 256 * j);
#pragma unroll
        for (int j = 0; j < 8; ++j) ss += (v[j].x * v[j].x + v[j].y * v[j].y) + (v[j].z * v[j].z + v[j].w * v[j].w);
        const float rs = rsq_(wave_sum(ss) * (1.f / DM) + EPS);
#pragma unroll
        for (int j = 0; j < 8; ++j) { const int col = 4 * lane + 256 * j; const f32x4 h = (v[j] * rs) * Al[j] + Bl[j]; u32x2 w; w.x = pk2(h.x, h.y); w.y = pk2(h.z, h.w); *(u32x2*)(H + (size_t)row * DM + col) = w; }
    }
}

struct EpiStoreF32 {
    static constexpr bool PERM = false, AFTER_DRAIN = false;
    float* O; int ldc;
    __device__ __forceinline__ void operator()(const pg8::f32x4 (&acc)[2][2][4][2], const pg8::Unit& u, int wr, int wc, int fr, int fq) const {
        const int row0 = u.pm * 256 + wr * 64 + fr, col0 = u.pn * 256 + wc * 32 + 4 * fq;
#pragma unroll
        for (int ai = 0; ai < 2; ++ai)
#pragma unroll
            for (int m = 0; m < 4; ++m) { float* rowp = O + (size_t)(row0 + ai * 128 + m * 16) * ldc + col0;
#pragma unroll
                for (int bj = 0; bj < 2; ++bj)
#pragma unroll
                    for (int n = 0; n < 2; ++n) *(pg8::f32x4*)(rowp + bj * 128 + n * 16) = acc[ai][bj][m][n]; }
    }
};
struct EpiStoreBf16 {
    static constexpr bool PERM = true, AFTER_DRAIN = false;
    bf16* O; int ldc;
    __device__ __forceinline__ void operator()(const pg8::f32x4 (&acc)[2][2][4][2], const pg8::Unit& u, int wr, int wc, int fr, int fq) const {
        const int row0 = u.pm * 256 + wr * 64 + fr, col0 = u.pn * 256 + wc * 32 + 8 * fq;
#pragma unroll
        for (int ai = 0; ai < 2; ++ai)
#pragma unroll
            for (int m = 0; m < 4; ++m) { bf16* rowp = O + (size_t)(row0 + ai * 128 + m * 16) * ldc + col0;
#pragma unroll
                for (int bj = 0; bj < 2; ++bj) { const pg8::f32x4 v0 = acc[ai][bj][m][0], v1 = acc[ai][bj][m][1];
                    pg8::u32x4 w; w.x = sc::cvtpk(v0[0], v0[1]); w.y = sc::cvtpk(v0[2], v0[3]); w.z = sc::cvtpk(v1[0], v1[1]); w.w = sc::cvtpk(v1[2], v1[3]);
                    *(pg8::u32x4*)(rowp + bj * 128) = w; } }
    }
};
struct EpiResid {
    static constexpr bool PERM = false, AFTER_DRAIN = false;
    const float* xl_in; const float* xc_in; float* xl_out; float* xc_out; const float* gate_l; const float* gate_c; int pm_off; float* slab;
    __device__ __forceinline__ void operator()(const pg8::f32x4 (&acc)[2][2][4][2], const pg8::Unit& u, int wr, int wc, int fr, int fq) const {
        if (u.kp >= 0) {
            float* Sl = slab + (size_t)u.kp * CTX * DM; const int r0 = wr * 64 + fr, c0 = u.pn * 256 + wc * 32 + 4 * fq;
#pragma unroll
            for (int ai = 0; ai < 2; ++ai)
#pragma unroll
                for (int m = 0; m < 4; ++m)
#pragma unroll
                    for (int bj = 0; bj < 2; ++bj)
#pragma unroll
                        for (int n = 0; n < 2; ++n) *(pg8::f32x4*)(Sl + (size_t)(r0 + ai * 128 + m * 16) * DM + c0 + bj * 128 + n * 16) = acc[ai][bj][m][n];
            return; }
        const int pm = u.pm + pm_off; const bool isc = (pm == 0);
        const int row0 = (isc ? 0 : (pm - 1) * 256) + wr * 64 + fr, col0 = u.pn * 256 + wc * 32 + 4 * fq;
        const float* bin = isc ? xc_in : xl_in; float* bout = isc ? xc_out : xl_out; const float* gt = isc ? gate_c : gate_l;
        pg8::f32x4 gv[2][2];
#pragma unroll
        for (int bj = 0; bj < 2; ++bj)
#pragma unroll
            for (int n = 0; n < 2; ++n) gv[bj][n] = *(const pg8::f32x4*)(gt + col0 + bj * 128 + n * 16);
#pragma unroll
        for (int am = 0; am < 8; am += 2) { pg8::f32x4 b[2][2][2]; const int ai = am >> 2;
#pragma unroll
            for (int mm = 0; mm < 2; ++mm) { const int m = (am & 3) + mm; const size_t off = (size_t)(row0 + ai * 128 + m * 16) * DM + col0;
#pragma unroll
                for (int bj = 0; bj < 2; ++bj)
#pragma unroll
                    for (int n = 0; n < 2; ++n) b[mm][bj][n] = *(const pg8::f32x4*)(bin + off + bj * 128 + n * 16); }
#pragma unroll
            for (int mm = 0; mm < 2; ++mm) { const int m = (am & 3) + mm; const size_t off = (size_t)(row0 + ai * 128 + m * 16) * DM + col0;
#pragma unroll
                for (int bj = 0; bj < 2; ++bj)
#pragma unroll
                    for (int n = 0; n < 2; ++n) *(pg8::f32x4*)(bout + off + bj * 128 + n * 16) = b[mm][bj][n] + gv[bj][n] * acc[ai][bj][m][n]; } }
    }
};
struct EpiSwiglu {
    static constexpr bool PERM = true, AFTER_DRAIN = false;
    bf16* O;
    __device__ __forceinline__ void operator()(const pg8::f32x4 (&acc)[2][2][4][2], const pg8::Unit& u, int wr, int wc, int fr, int fq) const {
        const int row0 = u.pm * 256 + wr * 64 + fr, col0 = u.pn * 128 + wc * 32 + 8 * fq;
#pragma unroll
        for (int ai = 0; ai < 2; ++ai)
#pragma unroll
            for (int m = 0; m < 4; ++m) { bf16* rowp = O + (size_t)(row0 + ai * 128 + m * 16) * DFF + col0;
                float o[8];
#pragma unroll
                for (int n = 0; n < 2; ++n)
#pragma unroll
                    for (int i = 0; i < 4; ++i) { const float gt = acc[ai][0][m][n][i], up = acc[ai][1][m][n][i]; o[4 * n + i] = gt * __builtin_amdgcn_rcpf(1.f + __expf(-gt)) * up; }
                pg8::u32x4 w; w.x = pg8::cvt_pk_bf16(o[0], o[1]); w.y = pg8::cvt_pk_bf16(o[2], o[3]); w.z = pg8::cvt_pk_bf16(o[4], o[5]); w.w = pg8::cvt_pk_bf16(o[6], o[7]);
                *(pg8::u32x4*)rowp = w; }
    }
};

struct SplitOrder {
    pg8::StaticOrder lat; int nlr, G, c, npn, nsplit, ntp;
    __device__ void init(int Mlat, int N, int G_, int c_, int nsplit_, int ntp_) { lat.init(Mlat, N, G_, c_); nlr = (lat.nwg + G_ - 1) / G_; G = G_; c = c_; npn = N / 256; nsplit = nsplit_; ntp = ntp_; }
    __device__ bool next(int i, pg8::Unit& u) const {
        if (i < nlr) { if (lat.next(i, u)) { u.pm += 1; return true; } i = nlr; }
        const int j = (i - nlr) * G + c; if (j >= npn * nsplit) return false;
        u.pm = 0; u.pn = j % npn; u.kp = j / npn; u.k0 = u.kp * ntp; u.nt = ntp; return true;
    }
    __device__ __forceinline__ void a_ready(const pg8::Unit&) const {}
    __device__ __forceinline__ void done(const pg8::Unit&) const {}
};

__device__ __forceinline__ float sum16(float v) { v += __shfl_xor(v, 1); v += __shfl_xor(v, 2); v += __shfl_xor(v, 4); v += __shfl_xor(v, 8); return v; }
__device__ __forceinline__ u32x2 pk4(f32x4 v) { u32x2 w; w.x = sc::cvtpk(v.x, v.y); w.y = sc::cvtpk(v.z, v.w); return w; }
__device__ __forceinline__ void prep_rows(const Args& a, int l, int gw, int NGW, int lane) {
    GAS unsigned char* wsg_ = (GAS unsigned char*)a.ws; asm volatile("" : "+s"(wsg_)); unsigned char* ws = (unsigned char*)wsg_;
    const bf16* U = (const bf16*)(ws + WS_U);
    bf16* Qb = (bf16*)(ws + WS_Q); bf16* Kb = (bf16*)(ws + WS_K); bf16* Vb = (bf16*)(ws + WS_V);
    float* SX = (float*)(ws + WS_SX); bf16* SBb = (bf16*)(ws + WS2_SBB); bf16* SCb = (bf16*)(ws + WS2_SCB); float* SDT = (float*)(ws + WS_SDT);
    const float* qkg = a.in[I_QKG] + l * 128; const float* cw = a.in[I_CONVW] + (size_t)l * 3 * 1152; const float* cb = a.in[I_CONVB] + l * 1152; const float* dtb = a.in[I_DTB] + l * 20;
    const int g16 = lane >> 4, j16 = lane & 15;
    const f32x4 gq = *(const f32x4*)(qkg + 4 * j16), gk = *(const f32x4*)(qkg + 64 + 4 * j16);
    float inv[4];
#pragma unroll
    for (int e = 0; e < 4; ++e) inv[e] = __builtin_amdgcn_exp2f(-(float)((4 * j16 + e) & 15) * 0.83048202372184059f);
    f32x4 cw0[5], cw1[5], cw2[5], cbb[5];
#pragma unroll
    for (int i = 0; i < 5; ++i) { const int idx = lane + 64 * i; const int ch = idx < 288 ? 4 * idx : 0;
        cw0[i] = *(const f32x4*)(cw + ch); cw1[i] = *(const f32x4*)(cw + 1152 + ch); cw2[i] = *(const f32x4*)(cw + 2304 + ch); cbb[i] = *(const f32x4*)(cb + ch); }
    float dtbias = 0.f; if (lane < 20) dtbias = dtb[lane];
    for (int row = gw; row < MT; row += NGW) {
        const bool lat = row >= CTX; const int t = row - CTX;
        const bf16* ur = U + (size_t)row * INP;
        const bool hp = (row != 0 && row != CTX), hn = (row != CTX - 1 && row != MT - 1);
        f32x4 qk[6], vv[3], c0[5], cm[5], cp[5];
#pragma unroll
        for (int i = 0; i < 6; ++i) qk[i] = sc::ldu4(ur + (4 * i + g16) * 64 + 4 * j16);
#pragma unroll
        for (int i = 0; i < 3; ++i) vv[i] = sc::ldu4(ur + 1536 + 4 * (lane + 64 * i));
#pragma unroll
        for (int i = 0; i < 5; ++i) { const int idx = lane + 64 * i; const bf16* p = ur + C_SSM + 640 + 4 * (idx < 288 ? idx : 287); const f32x4 z4 = {0.f, 0.f, 0.f, 0.f};
            c0[i] = sc::ldu4(p); cm[i] = sc::ldu4(hp ? p - INP : p); cp[i] = sc::ldu4(hn ? p + INP : p);
            if (!hp) cm[i] = z4; if (!hn) cp[i] = z4; }
        float dtr = sc::ldu1(ur + C_SSM + 1792 + (lane < 20 ? lane : 0));
        float cs[4], sn[4];
#pragma unroll
        for (int e = 0; e < 4; ++e) { cs[e] = 1.f; sn[e] = 0.f;
            if (lat) { const int d32 = (4 * j16 + e) & 31; const float pos = (float)(d32 < 16 ? (t >> 6) : (t & 63)); const float ang = pos * inv[e]; cs[e] = __cosf(ang); sn[e] = __sinf(ang); } }
#pragma unroll
        for (int i = 0; i < 6; ++i) { const int s = 4 * i + g16;
            const f32x4 x = qk[i]; const float ss = sum16((x.x * x.x + x.y * x.y) + (x.z * x.z + x.w * x.w));
            const float rs = rsq_(ss * (1.f / 64.f) + EPS);
            f32x4 y = x * rs * (i < 3 ? gq : gk);
            f32x4 pt; pt.x = __shfl_xor(y.x, 8); pt.y = __shfl_xor(y.y, 8); pt.z = __shfl_xor(y.z, 8); pt.w = __shfl_xor(y.w, 8);
            if (lat) {
#pragma unroll
                for (int e = 0; e < 4; ++e) y[e] = (j16 < 8) ? y[e] * cs[e] - pt[e] * sn[e] : y[e] * cs[e] + pt[e] * sn[e]; }
            *(u32x2*)((i < 3 ? Qb : Kb) + (size_t)row * 768 + (s - (i < 3 ? 0 : 12)) * 64 + 4 * j16) = pk4(y); }
#pragma unroll
        for (int i = 0; i < 3; ++i) *(u32x2*)(Vb + (size_t)row * 768 + 4 * (lane + 64 * i)) = pk4(vv[i]);
#pragma unroll
        for (int i = 0; i < 5; ++i) { const int idx = lane + 64 * i; const int ch = 4 * idx;
            if (idx < 288) {
                f32x4 y = cw0[i] * cm[i] + cw1[i] * c0[i] + cw2[i] * cp[i] + cbb[i];
#pragma unroll
                for (int e = 0; e < 4; ++e) y[e] = siluf_(y[e]);
                if (ch < 640) *(f32x4*)(SX + (size_t)row * 640 + ch) = y; else if (ch < 896) *(u32x2*)(SBb + (size_t)row * 256 + ch - 640) = pk4(y); else *(u32x2*)(SCb + (size_t)row * 256 + ch - 896) = pk4(y); } }
        if (lane < 20) { const int d = lane / 10, hh = lane % 10; SDT[(size_t)row * 32 + d * 16 + hh] = softplusf_(dtr + dtbias); }
    }
}
#ifndef PREP_RI
#define PREP_RI 48
#endif
__device__ __forceinline__ void prep_rwkv(const Args& a, int l, LAS unsigned char* lds, int tid, int lane, int wave, int bid, int G) {
    GAS unsigned char* wsg_ = (GAS unsigned char*)a.ws; asm volatile("" : "+s"(wsg_)); unsigned char* ws = (unsigned char*)wsg_;
    const bf16* U = (const bf16*)(ws + WS_U);
    float* RW = (float*)(ws + WS_RW); constexpr size_t S = (size_t)MT * 640;
    float* BON = (float*)(ws + WS_BONUS);
    constexpr int RI = PREP_RI;
    constexpr int PA = 392;
    LAS bf16* act = (LAS bf16*)lds;
    LAS bf16* tmp = (LAS bf16*)(lds + 51200) + wave * 3072;
    const float* mu = a.in[I_MU] + (size_t)l * 2 * 2304;
    const float* w0 = a.in[I_W0] + (size_t)l * 2 * 640; const float* a0 = a.in[I_A0] + (size_t)l * 2 * 640;
    const float* kkw = a.in[I_KK] + l * 640; const float* kaw = a.in[I_KA] + l * 640; const float* rkw = a.in[I_RK] + l * 640;
    const bf16* LRW = (const bf16*)(ws + WS3_LRW + l * SZ_LRW);
    const int fr = lane & 15, fq = lane >> 4;
    LAS float* cv = (LAS float*)(lds + 102400);
    __syncthreads();
#ifndef PROBE_CV
#define PROBE_CV 1
#endif
#ifndef PROBE_S1
#define PROBE_S1 1
#endif
#ifndef PROBE_S2
#define PROBE_S2 1
#endif
    for (int pcv_ = 0; pcv_ < PROBE_CV; ++pcv_)
    { f32x4 v[5];
#pragma unroll
      for (int j = 0; j < 5; ++j) { const int i = 4 * (tid + NTHR * j); const float* p;
          if (i < 1920) p = mu + i; else if (i < 3840) p = mu + 2304 + (i - 1920); else if (i < 5120) p = w0 + (i - 3840); else if (i < 6400) p = a0 + (i - 5120);
          else if (i < 7040) p = kkw + (i - 6400); else if (i < 7680) p = kaw + (i - 7040); else p = rkw + (i < 8320 ? i - 7680 : 0);
          v[j] = *(const f32x4*)p; }
#pragma unroll
      for (int j = 0; j < 5; ++j) { const int i = 4 * (tid + NTHR * j); if (i < 8320) *(LAS f32x4*)(cv + i) = v[j]; } }
    for (int it = bid; it < MT / RI; it += G) {
        const int row0 = it * RI;
        __syncthreads();
        static_assert((RI * 384) % (NTHR * 6) == 0, "staging batches");
#pragma unroll 1
        for (int ps1_ = 0; ps1_ < PROBE_S1; ++ps1_)
#pragma unroll 1
        for (int i0 = tid; i0 < RI * 384; i0 += NTHR * 6) {
            float x0[6], xm[6], xp[6];
#pragma unroll
            for (int j = 0; j < 6; ++j) { const int i = i0 + j * NTHR; const int r = i / 384, cc = i % 384; const int row = row0 + r;
                const bf16* p = U + (size_t)row * INP + C_RW + 1920 + cc;
                const bool hp = (row != 0 && row != CTX), hn = (row != CTX - 1 && row != MT - 1);
                x0[j] = sc::ldu1(p); xm[j] = sc::ldu1(hp ? p - INP : p); xp[j] = sc::ldu1(hn ? p + INP : p); }
#pragma unroll
            for (int j = 0; j < 6; ++j) { const int i = i0 + j * NTHR; const int r = i / 384, cc = i % 384, c = 1920 + cc; const int row = row0 + r;
                const bool hp = (row != 0 && row != CTX), hn = (row != CTX - 1 && row != MT - 1);
                float y = x0[j] + mu[c] * ((hp ? xm[j] : 0.f) - x0[j]) + mu[2304 + c] * ((hn ? xp[j] : 0.f) - x0[j]);
                if (cc < 128) y = 1.f - 2.f * __builtin_amdgcn_rcpf(1.f + __expf(2.f * y)); else if (cc >= 256) y = sigmoidf_(y);
                act[r * PA + cc] = (bf16)f2bf(y); }
        }
        __syncthreads();
#pragma unroll 1
        for (int ps2_ = 0; ps2_ < PROBE_S2; ++ps2_)
        { constexpr int NP = (RI / 16) * 10;
          sc::bf16x8 wq[12]; sc::bf16x4 x0r[3], xmr[3], xpr[3];
#define TILE_LOAD_W(pr_, tc_) do { const int h_ = (pr_) % 10; const int wrow_ = 64 * h_ + 16 * (tc_) + fr; \
              _Pragma("unroll") for (int mtx = 0; mtx < 4; ++mtx) { wq[2 * mtx] = *(const sc::bf16x8*)(LRW + mtx * 40960 + wrow_ * 64 + 8 * fq); wq[2 * mtx + 1] = *(const sc::bf16x8*)(LRW + mtx * 40960 + wrow_ * 64 + 32 + 8 * fq); } \
              _Pragma("unroll") for (int ks = 0; ks < 4; ++ks) wq[8 + ks] = *(const sc::bf16x8*)(LRW + 163840 + wrow_ * 128 + 32 * ks + 8 * fq); } while (0)
#define TILE_LOAD_X(pr_, tc_) do { const int rt_ = (pr_) / 10, h_ = (pr_) % 10; const int row_ = row0 + 16 * rt_ + fr; const int c_ = 64 * h_ + 16 * (tc_) + 4 * fq; \
              const bool hp_ = (row_ != 0 && row_ != CTX), hn_ = (row_ != CTX - 1 && row_ != MT - 1); const bf16* ur_ = U + (size_t)row_ * INP + C_RW; \
              _Pragma("unroll") for (int q = 0; q < 3; ++q) { const bf16* p = ur_ + q * 640 + c_; x0r[q] = *(const sc::bf16x4*)p; xmr[q] = *(const sc::bf16x4*)(hp_ ? p - INP : p); xpr[q] = *(const sc::bf16x4*)(hn_ ? p + INP : p); } } while (0)
#define TILE_LOAD(pr_, tc_) do { TILE_LOAD_W(pr_, tc_); TILE_LOAD_X(pr_, tc_); } while (0)
          int pr = wave, tc = 0; float ssq = 0.f, bsum = 0.f, rn_prev = 0.f; size_t o_prev = (size_t)(row0 + 16 * (wave / 10) + fr) * 640 + 64 * (wave % 10) + 4 * fq;
          if (pr < NP) TILE_LOAD(pr, 0);
          u32x2 st_r = {0u, 0u}, st_v = {0u, 0u}, st_kf = {0u, 0u}, st_kb = {0u, 0u}, st_gt = {0u, 0u}, st_if = {0u, 0u}, st_ib = {0u, 0u}; f32x4 st_lwf = {0.f, 0.f, 0.f, 0.f}, st_lwb = {0.f, 0.f, 0.f, 0.f};
          size_t st_o = o_prev;
#pragma unroll 1
          while (pr < NP) {
              const int rt = pr / 10, h = pr % 10; const int row = row0 + 16 * rt + fr; const int c = 64 * h + 16 * tc + 4 * fq;
              const int pr2 = (tc < 3) ? pr : pr + 8, tc2 = (tc < 3) ? tc + 1 : 0; const int prl = pr2 < NP ? pr2 : pr;
              const LAS bf16* arow = act + (16 * rt + fr) * PA;
              f32x4 m0[3], m1[3], kc[3];
#pragma unroll
              for (int q = 0; q < 3; ++q) { m0[q] = *(const LAS f32x4*)(cv + q * 640 + c); m1[q] = *(const LAS f32x4*)(cv + 1920 + q * 640 + c); kc[q] = *(const LAS f32x4*)(cv + 6400 + q * 640 + c); }
              f32x4 wlf = *(const LAS f32x4*)(cv + 3840 + c), wlb = *(const LAS f32x4*)(cv + 4480 + c), icf = *(const LAS f32x4*)(cv + 5120 + c), icb = *(const LAS f32x4*)(cv + 5760 + c), gt = {0.f, 0.f, 0.f, 0.f};
#pragma unroll
              for (int ks = 0; ks < 2; ++ks) { const sc::bf16x8 a0_ = *(const LAS sc::bf16x8*)(arow + 32 * ks + 8 * fq), a1_ = *(const LAS sc::bf16x8*)(arow + 64 + 32 * ks + 8 * fq),
                      a2_ = *(const LAS sc::bf16x8*)(arow + 128 + 32 * ks + 8 * fq), a3_ = *(const LAS sc::bf16x8*)(arow + 192 + 32 * ks + 8 * fq);
                  wlf = __builtin_amdgcn_mfma_f32_16x16x32_bf16(wq[0 + ks], a0_, wlf, 0, 0, 0); wlb = __builtin_amdgcn_mfma_f32_16x16x32_bf16(wq[2 + ks], a1_, wlb, 0, 0, 0);
                  icf = __builtin_amdgcn_mfma_f32_16x16x32_bf16(wq[4 + ks], a2_, icf, 0, 0, 0); icb = __builtin_amdgcn_mfma_f32_16x16x32_bf16(wq[6 + ks], a3_, icb, 0, 0, 0); }
#pragma unroll
              for (int ks = 0; ks < 4; ++ks) { const sc::bf16x8 a4_ = *(const LAS sc::bf16x8*)(arow + 256 + 32 * ks + 8 * fq); gt = __builtin_amdgcn_mfma_f32_16x16x32_bf16(wq[8 + ks], a4_, gt, 0, 0, 0); }
              __builtin_amdgcn_sched_barrier(0);
              TILE_LOAD_W(prl, tc2);
              __builtin_amdgcn_sched_barrier(0);
              f32x4 sh[3];
              { const bool hp = (row != 0 && row != CTX), hn = (row != CTX - 1 && row != MT - 1); const f32x4 z4 = {0.f, 0.f, 0.f, 0.f};
#pragma unroll
                for (int q = 0; q < 3; ++q) { const f32x4 x0 = sc::widen4(x0r[q]), xm = sc::widen4(xmr[q]), xp = sc::widen4(xpr[q]); sh[q] = x0 + m0[q] * ((hp ? xm : z4) - x0) + m1[q] * ((hn ? xp : z4) - x0); } }
              asm volatile("" : "+v"(sh[0]), "+v"(sh[1]), "+v"(sh[2]));
              __builtin_amdgcn_sched_barrier(0);
              *(u32x2*)((bf16*)(RW + 0 * S) + st_o) = st_r; *(u32x2*)((bf16*)(RW + 1 * S) + st_o) = st_v; *(f32x4*)(RW + 3 * S + st_o) = st_lwf; *(f32x4*)(RW + 4 * S + st_o) = st_lwb;
              *(u32x2*)((bf16*)(RW + 5 * S) + st_o) = st_kf; *(u32x2*)((bf16*)(RW + 6 * S) + st_o) = st_kb; *(u32x2*)((bf16*)(RW + 9 * S) + st_o) = st_gt;
              *(u32x2*)((bf16*)(RW + 7 * S) + st_o) = st_if; *(u32x2*)((bf16*)(RW + 8 * S) + st_o) = st_ib;
              { const sc::bf16x4 k4 = *(const LAS sc::bf16x4*)(tmp + tc * 256 + 4 * lane);
                f32x4 kk;
#pragma unroll
                for (int i = 0; i < 4; ++i) kk[i] = sc::bf2f(k4[i]) * rn_prev;
                *(u32x2*)((bf16*)(RW + 2 * S) + o_prev + 16 * tc) = pk4((rn_prev != 0.f) ? kk : (f32x4){0.f, 0.f, 0.f, 0.f}); }
              __builtin_amdgcn_sched_barrier(0);
              TILE_LOAD_X(prl, tc2);
              __builtin_amdgcn_sched_barrier(0);
              f32x4 lwf, lwb, kf, kb, krv, ifv, ibv;
#pragma unroll
              for (int i = 0; i < 4; ++i) { const float kx = sh[1][i];
                  lwf[i] = -0.60653066f * sigmoidf_(wlf[i]); lwb[i] = -0.60653066f * sigmoidf_(wlb[i]);
                  const float if_ = sigmoidf_(icf[i]), ib_ = sigmoidf_(icb[i]);
                  kf[i] = kx * (1.f + (if_ - 1.f) * kc[1][i]); kb[i] = kx * (1.f + (ib_ - 1.f) * kc[1][i]);
                  const float kr = kx * kc[0][i]; krv[i] = kr; ifv[i] = if_; ibv[i] = ib_; ssq += kr * kr; bsum += sh[0][i] * (kf[i] + kb[i]) * kc[2][i]; }
              st_o = (size_t)row * 640 + c; st_r = pk4(sh[0]); st_v = pk4(sh[2]); st_lwf = lwf; st_lwb = lwb; st_kf = pk4(kf); st_kb = pk4(kb); st_gt = pk4(gt); st_if = pk4(ifv); st_ib = pk4(ibv);
              *(LAS u32x2*)(tmp + tc * 256 + 4 * lane) = pk4(krv);
              if (tc == 3) {
                  ssq += __shfl_xor(ssq, 16); ssq += __shfl_xor(ssq, 32); bsum += __shfl_xor(bsum, 16); bsum += __shfl_xor(bsum, 32);
                  rn_prev = rsq_(ssq + 1e-12f); o_prev = (size_t)row * 640 + 64 * h + 4 * fq;
                  if (fq == 0) BON[(size_t)row * 16 + h] = bsum;
                  ssq = 0.f; bsum = 0.f; }
              pr = pr2; tc = tc2;
          }
          if (rn_prev != 0.f) {
              *(u32x2*)((bf16*)(RW + 0 * S) + st_o) = st_r; *(u32x2*)((bf16*)(RW + 1 * S) + st_o) = st_v; *(f32x4*)(RW + 3 * S + st_o) = st_lwf; *(f32x4*)(RW + 4 * S + st_o) = st_lwb;
              *(u32x2*)((bf16*)(RW + 5 * S) + st_o) = st_kf; *(u32x2*)((bf16*)(RW + 6 * S) + st_o) = st_kb; *(u32x2*)((bf16*)(RW + 9 * S) + st_o) = st_gt;
              *(u32x2*)((bf16*)(RW + 7 * S) + st_o) = st_if; *(u32x2*)((bf16*)(RW + 8 * S) + st_o) = st_ib;
#pragma unroll
              for (int t4 = 0; t4 < 4; ++t4) { const sc::bf16x4 k4 = *(const LAS sc::bf16x4*)(tmp + t4 * 256 + 4 * lane); f32x4 kk;
#pragma unroll
                  for (int i = 0; i < 4; ++i) kk[i] = sc::bf2f(k4[i]) * rn_prev;
                  *(u32x2*)((bf16*)(RW + 2 * S) + o_prev + 16 * t4) = pk4(kk); } }
#undef TILE_LOAD
#undef TILE_LOAD_W
#undef TILE_LOAD_X
        }
    }
    __syncthreads();
}

__device__ __forceinline__ int seq_row(int p, int dir) { return dir == 0 ? p : (p < CTX ? CTX - 1 - p : MT - 1 - (p - CTX)); }
__device__ __forceinline__ float quad_sum(float v) { v += __shfl_xor(v, 1); v += __shfl_xor(v, 2); return v; }

#ifdef USE_NAIVE_SSD
#define NAIVE_SSD_EXTRA(x) (x)
#else
#define NAIVE_SSD_EXTRA(x) 0.f
#endif
__device__ __forceinline__ void mixfin_phase(const Args& a, int l, int gw, int NGW, int lane) {
    GAS unsigned char* wsg_ = (GAS unsigned char*)a.ws; asm volatile("" : "+s"(wsg_)); unsigned char* ws = (unsigned char*)wsg_;
    constexpr size_t S = (size_t)MT * 640;
    const float* AO = (const float*)(ws + WS_AO); const float* RW = (const float*)(ws + WS_RW); const float* BON = (const float*)(ws + WS_BONUS);
    const float* RY = (const float*)(ws + WS_RY); const float* SY = (const float*)(ws + WS_SY); const float* SX = (const float*)(ws + WS_SX); const bf16* U = (const bf16*)(ws + WS_U);
    bf16* MIX = (bf16*)(ws + WS_MIX);
    const float lam = ((const float*)(ws + WS_LAM))[l]; const float lam_init = 0.8f - 0.6f * __expf(-0.3f * (float)l);
    const float* subg = a.in[I_SUBLN] + l * 128; const float* lng = a.in[I_LNG] + l * 640; const float* lnb = a.in[I_LNB] + l * 640;
    const float* dsk = a.in[I_DSKIP] + l * 20; const float* sng = a.in[I_SSMG] + l * 640;
    const f32x4 sg4 = *(const f32x4*)(subg + 4 * (lane & 31));
    f32x4 lng4[3], lnb4[3], sng4[3]; float dd3[3];
#pragma unroll
    for (int i = 0; i < 3; ++i) { const int idx = lane + 64 * i; const int idc = idx < 160 ? idx : 159; const int h = idc >> 4;
        lng4[i] = *(const f32x4*)(lng + 4 * idc); lnb4[i] = *(const f32x4*)(lnb + 4 * idc); sng4[i] = *(const f32x4*)(sng + 4 * idc); dd3[i] = dsk[h] + dsk[10 + h]; }
    for (int row = gw; row < MT; row += NGW) {
        bf16* mr = MIX + (size_t)row * DM;
        f32x4 a0[3], a1[3], ry0[3], ry1[3], rv[3], rg[3], sy[3], sx[3], sz[3]; float bon[3]; const f32x4 z4 = {0.f, 0.f, 0.f, 0.f};
#pragma unroll
        for (int i = 0; i < 3; ++i) { const int idx = lane + 64 * i; const int h = idx >> 5, d = 4 * (idx & 31);
            a0[i] = *(const f32x4*)(AO + (size_t)row * 1536 + (2 * h) * 128 + d); a1[i] = *(const f32x4*)(AO + (size_t)row * 1536 + (2 * h + 1) * 128 + d);
            { const int idc = idx < 160 ? idx : 159; const size_t o = (size_t)row * 640 + 4 * idc;
                ry0[i] = *(const f32x4*)(RY + o); ry1[i] = *(const f32x4*)(RY + S + o); rv[i] = sc::ldu4((const bf16*)(RW + 1 * S) + o); rg[i] = sc::ldu4((const bf16*)(RW + 9 * S) + o);
                sy[i] = *(const f32x4*)(SY + o); sx[i] = *(const f32x4*)(SX + o); sz[i] = sc::ldu4(U + (size_t)row * INP + C_SSM + 4 * idc); bon[i] = BON[(size_t)row * 16 + (idc >> 4)]; } }
#pragma unroll
        for (int i = 0; i < 3; ++i) { const int idx = lane + 64 * i; const f32x4 o = a0[i] - lam * a1[i];
            float ss = (o.x * o.x + o.y * o.y) + (o.z * o.z + o.w * o.w); ss = sum16(ss); ss += __shfl_xor(ss, 16);
            const float sc_ = rsq_(ss * (1.f / 128.f) + EPS) * (1.f - lam_init);
            *(u32x2*)(mr + 4 * idx) = pk4(o * sc_ * sg4); }
#pragma unroll
        for (int i = 0; i < 3; ++i) { const int idx = lane + 64 * i; const int c = 4 * idx, h = idx >> 4;
            if (idx < 160) {
                const f32x4 y = ry0[i] + ry1[i]; const float mean = sum16((y.x + y.y) + (y.z + y.w)) * (1.f / 64.f); const f32x4 yc = y - mean;
                const float var = sum16((yc.x * yc.x + yc.y * yc.y) + (yc.z * yc.z + yc.w * yc.w)) * (1.f / 64.f);
                const f32x4 yn = yc * (rsq_(var + LN_X_EPS));
                const f32x4 out = (yn * lng4[i] + lnb4[i] + bon[i] * rv[i]) * rg[i];
                *(u32x2*)(mr + 768 + c) = pk4(out); } }
        f32x4 yg[3]; float s0 = 0.f, s1 = 0.f;
#pragma unroll
        for (int i = 0; i < 3; ++i) { const int idx = lane + 64 * i; const int h = idx >> 4;
            if (idx < 160) { const float dd = dd3[i]; f32x4 y = sy[i] + dd * sx[i];
#pragma unroll
                for (int e = 0; e < 4; ++e) y[e] *= siluf_(sz[i][e]);
                yg[i] = y; const float p = (y.x * y.x + y.y * y.y) + (y.z * y.z + y.w * y.w); if (idx < 80) s0 += p; else s1 += p; } else yg[i] = z4; }
        s0 = wave_sum(s0); s1 = wave_sum(s1);
        const float r0 = rsq_(s0 * (1.f / 320.f) + EPS), r1 = rsq_(s1 * (1.f / 320.f) + EPS);
#pragma unroll
        for (int i = 0; i < 3; ++i) { const int idx = lane + 64 * i; if (idx < 160) *(u32x2*)(mr + 1408 + 4 * idx) = pk4(yg[i] * (idx < 80 ? r0 : r1) * sng4[i]); }
    }
}
namespace att {
using bf16x8 = __attribute__((ext_vector_type(8))) short;
using s16x4  = __attribute__((ext_vector_type(4))) short;
using f32x16 = __attribute__((ext_vector_type(16))) float;
using u32x4  = __attribute__((ext_vector_type(4))) unsigned;
constexpr int NW = 8, QBLK = 32, KVBLK = 64, LD = 768, LDO = 1536;
constexpr float SCALE = 0.125f, THR = 8.f;
constexpr size_t SHM_V = KVBLK * 128 * 2, SHM_K = KVBLK * 64 * 2, SHM_ATTN = 2 * SHM_V + 2 * SHM_K + NW * 64 * 4;
#define KSWZ64(row, colB) ((row) * 128 + ((colB) ^ ((((row) >> 1) & 7) << 4)))
#define SBAR() __builtin_amdgcn_sched_barrier(0)
__device__ __forceinline__ int crow(int r, int hi) { return (r & 3) + 8 * (r >> 2) + 4 * hi; }
__device__ __forceinline__ unsigned cvtpk(float lo, float hi) { unsigned r; asm volatile("v_cvt_pk_bf16_f32 %0, %1, %2" : "=v"(r) : "v"(lo), "v"(hi)); return r; }

__device__ __forceinline__ void partialSM(f32x16& p0, f32x16& p1, float& m_reg, float& mn, float& alpha) {
  constexpr float C = SCALE * 1.4426950408889634f;
  float pmax = p0[0];
#pragma unroll
  for (int r = 1; r < 16; ++r) pmax = fmaxf(pmax, p0[r]);
#pragma unroll
  for (int r = 0; r < 16; ++r) pmax = fmaxf(pmax, p1[r]);
  { auto rr = __builtin_amdgcn_permlane32_swap(__float_as_uint(pmax), __float_as_uint(pmax), false, false);
    pmax = fmaxf(__uint_as_float(rr[0]), __uint_as_float(rr[1])); }
  if (__builtin_expect(__all(pmax - m_reg <= THR / SCALE), 1)) { mn = m_reg; alpha = 1.f; }
  else { mn = fmaxf(m_reg, pmax); alpha = __builtin_amdgcn_exp2f((m_reg - mn) * C); m_reg = mn; }
  float mnC = -mn * C;
#pragma unroll
  for (int r = 0; r < 16; ++r) p0[r] = fmaf(p0[r], C, mnC);
#pragma unroll
  for (int r = 0; r < 16; ++r) p1[r] = fmaf(p1[r], C, mnC);
#pragma unroll
  for (int r = 0; r < 16; ++r) p0[r] = __builtin_amdgcn_exp2f(p0[r]);
}
__device__ __forceinline__ void finishSM(f32x16& p0, f32x16& p1, float alpha, float& l_reg, bf16x8& pa0, bf16x8& pa1, bf16x8& pa2, bf16x8& pa3) {
#pragma unroll
  for (int r = 0; r < 16; ++r) p1[r] = __builtin_amdgcn_exp2f(p1[r]);
  float ps = 0;
#pragma unroll
  for (int r = 0; r < 16; ++r) ps += p0[r];
#pragma unroll
  for (int r = 0; r < 16; ++r) ps += p1[r];
  { auto rr = __builtin_amdgcn_permlane32_swap(__float_as_uint(ps), __float_as_uint(ps), false, false);
    ps = __uint_as_float(rr[0]) + __uint_as_float(rr[1]); }
  l_reg = l_reg * alpha + ps;
#define PK4(P, BASE, OUT) do { unsigned a0 = cvtpk(P[BASE + 0], P[BASE + 1]), a1 = cvtpk(P[BASE + 2], P[BASE + 3]);   \
    unsigned b0 = cvtpk(P[BASE + 4], P[BASE + 5]), b1 = cvtpk(P[BASE + 6], P[BASE + 7]);                              \
    auto r0 = __builtin_amdgcn_permlane32_swap(a0, b0, false, false); auto r1 = __builtin_amdgcn_permlane32_swap(a1, b1, false, false); \
    u32x4 w = {r0[0], r1[0], r0[1], r1[1]}; OUT = *reinterpret_cast<bf16x8*>(&w); } while (0)
  PK4(p0, 0, pa0); PK4(p0, 8, pa1); PK4(p1, 0, pa2); PK4(p1, 8, pa3);
#undef PK4
}
__device__ __forceinline__ void qkt(f32x16& p0, f32x16& p1, const char* Ks, const bf16x8* qr, int r32, int hi) {
  p0 = f32x16{}; p1 = f32x16{};
#pragma unroll
  for (int d0 = 0; d0 < 4; ++d0) { const int cb = (d0 * 16 + hi * 8) * 2;
    bf16x8 b0 = *reinterpret_cast<const bf16x8*>(Ks + KSWZ64(r32, cb));
    bf16x8 b1 = *reinterpret_cast<const bf16x8*>(Ks + KSWZ64(32 + r32, cb));
    p0 = __builtin_amdgcn_mfma_f32_32x32x16_bf16(b0, qr[d0], p0, 0, 0, 0);
    p1 = __builtin_amdgcn_mfma_f32_32x32x16_bf16(b1, qr[d0], p1, 0, 0, 0); }
}
__device__ __forceinline__ int v_st(int k, int c) { const int kk = (k & ~0xC) | ((k & 4) << 1) | ((k & 8) >> 1); return ((kk >> 3) * 4 + (c >> 5)) * 512 + ((kk & 7) * 32 + (c & 31)) * 2; }
__device__ __forceinline__ int v_rd_base(int lane) { return ((lane & 3) << 3) | (((lane >> 2) & 3) << 6) | (((lane >> 4) & 1) << 5) | (((lane >> 5) & 1) << 8); }
constexpr int v_rd_off(int d0, int ks, int half) { return d0 * 512 + ks * 4096 + half * 2048; }
template <int OFF> __device__ __forceinline__ s16x4 tr_read(int vb) {
  s16x4 r; asm volatile("ds_read_b64_tr_b16 %0, %1 offset:%2" : "=&v"(r) : "v"(vb), "i"(OFF) : "memory"); return r;
}
template <int D0> __device__ __forceinline__ void pv_one(f32x16& od, int vb, bf16x8 pa0, bf16x8 pa1, bf16x8 pa2, bf16x8 pa3) {
  const s16x4 l0 = tr_read<v_rd_off(D0, 0, 0)>(vb), h0 = tr_read<v_rd_off(D0, 0, 1)>(vb), l1 = tr_read<v_rd_off(D0, 1, 0)>(vb), h1 = tr_read<v_rd_off(D0, 1, 1)>(vb);
  const s16x4 l2 = tr_read<v_rd_off(D0, 2, 0)>(vb), h2 = tr_read<v_rd_off(D0, 2, 1)>(vb), l3 = tr_read<v_rd_off(D0, 3, 0)>(vb), h3 = tr_read<v_rd_off(D0, 3, 1)>(vb);
  asm volatile("s_waitcnt lgkmcnt(0)" ::: "memory"); SBAR();
#define PK(L, H) (bf16x8){L[0], L[1], L[2], L[3], H[0], H[1], H[2], H[3]}
  od = __builtin_amdgcn_mfma_f32_32x32x16_bf16(pa0, PK(l0, h0), od, 0, 0, 0);
  od = __builtin_amdgcn_mfma_f32_32x32x16_bf16(pa1, PK(l1, h1), od, 0, 0, 0);
  od = __builtin_amdgcn_mfma_f32_32x32x16_bf16(pa2, PK(l2, h2), od, 0, 0, 0);
  od = __builtin_amdgcn_mfma_f32_32x32x16_bf16(pa3, PK(l3, h3), od, 0, 0, 0);
#undef PK
}
__device__ __forceinline__ void pv_d0(f32x16* o, int vb, bf16x8 pa0, bf16x8 pa1, bf16x8 pa2, bf16x8 pa3) {
  pv_one<0>(o[0], vb, pa0, pa1, pa2, pa3); pv_one<1>(o[1], vb, pa0, pa1, pa2, pa3); pv_one<2>(o[2], vb, pa0, pa1, pa2, pa3); pv_one<3>(o[3], vb, pa0, pa1, pa2, pa3);
}
__device__ __forceinline__ void attn_unit(const unsigned short* Qb, const unsigned short* Kh, const unsigned short* Vh, float* Ob, int seq, char* lds, int wave_s) {
  int tid_l = wave_s * 64 + lane_id_(); asm volatile("" : "+v"(tid_l));
  const int tid = tid_l, wid = tid >> 6, lane = tid & 63, r32 = lane & 31, hi = lane >> 5;
  char* V_lds = lds; char* K_lds = lds + 2 * SHM_V;
  float* wsf = (float*)(lds + 2 * SHM_V + 2 * SHM_K) + wid * 64; float* li_l = wsf; float* al_l = wsf + 32;
  float m_reg = -1e30f, l_reg = 0; f32x16 o[4] = {}; bf16x8 qr[4];
  const unsigned short* Qw = Qb + (long)(wid * QBLK + r32) * LD + hi * 8;
#pragma unroll
  for (int d0 = 0; d0 < 4; ++d0) qr[d0] = *reinterpret_cast<const bf16x8*>(Qw + d0 * 16);
  const int sr = tid >> 4, sc = (tid & 15) * 8, vst0 = v_st(sr, sc), vst1 = v_st(32 + sr, sc);
  const int kr = tid >> 3, kc = (tid & 7) * 8, kst = KSWZ64(kr, kc * 2);
  const int vb0 = (int)(uintptr_t)V_lds + v_rd_base(lane);
  struct { bf16x8 vs0, vs1, ks0; } sr_[2];
#define SLOAD(i, k0) do { sr_[i].vs0 = *reinterpret_cast<const bf16x8*>(&Vh[(long)((k0) + sr) * LD + sc]); sr_[i].vs1 = *reinterpret_cast<const bf16x8*>(&Vh[(long)((k0) + 32 + sr) * LD + sc]); \
    sr_[i].ks0 = *reinterpret_cast<const bf16x8*>(&Kh[(long)((k0) + kr) * LD + kc]); } while (0)
#define SWRITE(b, i) do { *(bf16x8*)(V_lds + (b) * SHM_V + vst0) = sr_[i].vs0; *(bf16x8*)(V_lds + (b) * SHM_V + vst1) = sr_[i].vs1; \
    *(bf16x8*)(K_lds + (b) * SHM_K + kst) = sr_[i].ks0; } while (0)
#define SWAIT() asm volatile("s_waitcnt vmcnt(3)" ::: "memory")
#define RESC(a) do { if (__any((a) < 1.f)) { if (hi == 0) al_l[r32] = (a); asm volatile("s_waitcnt lgkmcnt(0)" ::: "memory"); \
    _Pragma("unroll") for (int d = 0; d < 4; ++d) _Pragma("unroll") for (int r = 0; r < 16; ++r) o[d][r] *= al_l[crow(r, hi)]; } } while (0)
  f32x16 pA0, pA1, pB0, pB1; float mnA, mnB, alA, alB; bf16x8 pa0, pa1, pa2, pa3; const int NT = seq / KVBLK;
  constexpr int SE = 0, SO = 1;
  SLOAD(SE, 0); asm volatile("s_waitcnt vmcnt(0)" ::: "memory"); SWRITE(0, SE); __syncthreads();
  qkt(pA0, pA1, K_lds, qr, r32, hi); partialSM(pA0, pA1, m_reg, mnA, alA);
  SLOAD(SO, KVBLK); if (2 < NT) SLOAD(SE, 2 * KVBLK);
  SWAIT(); SWRITE(1, SO); __syncthreads();
  for (int j = 1; j + 1 < NT; j += 2) {
    SBAR(); qkt(pB0, pB1, K_lds + SHM_K, qr, r32, hi);
    finishSM(pA0, pA1, alA, l_reg, pa0, pa1, pa2, pa3); SBAR();
    SLOAD(SO, (j + 2) * KVBLK); SBAR();
    pv_d0(o, vb0, pa0, pa1, pa2, pa3); partialSM(pB0, pB1, m_reg, mnB, alB);
    __syncthreads(); SWAIT(); SWRITE(0, SE);
    RESC(alB); __syncthreads();
    SBAR(); qkt(pA0, pA1, K_lds, qr, r32, hi);
    finishSM(pB0, pB1, alB, l_reg, pa0, pa1, pa2, pa3); SBAR();
    if (j + 3 < NT) SLOAD(SE, (j + 3) * KVBLK); SBAR();
    pv_d0(o, vb0 + (int)SHM_V, pa0, pa1, pa2, pa3); partialSM(pA0, pA1, m_reg, mnA, alA);
    __syncthreads(); SWAIT(); SWRITE(1, SO);
    RESC(alA); __syncthreads();
  }
  SBAR(); qkt(pB0, pB1, K_lds + SHM_K, qr, r32, hi);
  finishSM(pA0, pA1, alA, l_reg, pa0, pa1, pa2, pa3); SBAR();
  pv_d0(o, vb0, pa0, pa1, pa2, pa3); partialSM(pB0, pB1, m_reg, mnB, alB);
  __syncthreads(); RESC(alB);
  finishSM(pB0, pB1, alB, l_reg, pa0, pa1, pa2, pa3); SBAR();
  pv_d0(o, vb0 + (int)SHM_V, pa0, pa1, pa2, pa3);
  if (hi == 0) li_l[r32] = l_reg; asm volatile("s_waitcnt lgkmcnt(0)" ::: "memory");
  float rli[16];
#pragma unroll
  for (int r = 0; r < 16; ++r) rli[r] = __builtin_amdgcn_rcpf(li_l[crow(r, hi)]);
  float* Ow = Ob + (long)(wid * QBLK) * LDO;
#pragma unroll
  for (int r = 0; r < 16; ++r) { const int orow = crow(r, hi);
#pragma unroll
    for (int d0 = 0; d0 < 4; ++d0) Ow[(long)orow * LDO + d0 * 32 + r32] = o[d0][r] * rli[r]; }
#undef SLOAD
#undef SWRITE
#undef SWAIT
#undef RESC
}
#undef SBAR
}

__device__ __forceinline__ void ssd_a_unit(const Args& a, int l, int rb, int h, LAS unsigned char* lds, int wave_s) {
    int tid = wave_s * 64 + lane_id_(); asm volatile("" : "+v"(tid)); const int lane = tid & 63, wave = wave_s;
    GAS unsigned char* wsg_ = (GAS unsigned char*)a.ws; asm volatile("" : "+s"(wsg_)); unsigned char* ws = (unsigned char*)wsg_;
    const float* SX = (const float*)(ws + WS_SX); const float* SDT = (const float*)(ws + WS_SDT);
    const bf16* Bb = (const bf16*)(ws + WS2_SBB); const bf16* Cb = (const bf16*)(ws + WS2_SCB);
    float* SAF = (float*)(ws + WS2_SAF); float* SS = (float*)(ws + WS2_SS); float* SDEC = (float*)(ws + WS2_SDEC);
    float* YL = (float*)(ws + WS_SY);
    const int grp = h / 5, row0 = rb * 128;
    const float Af = -__expf(a.in[LIDX(I_ALOG)][l * 20 + h]), Ab = -__expf(a.in[LIDX(I_ALOG)][l * 20 + 10 + h]);
    constexpr int PB = 136;
    LAS bf16* BT = (LAS bf16*)lds;
    LAS bf16* xT = BT + 128 * PB;
    LAS bf16* xfT = xT + 64 * PB; LAS bf16* xbT = xfT + 64 * PB;
    LAS float* vec = (LAS float*)(xbT + 64 * PB);
    LAS bf16* Bn = (LAS bf16*)(vec + 512);
    asm volatile("" : "+v"(BT), "+v"(xT), "+v"(xfT), "+v"(xbT), "+v"(vec), "+v"(Bn));
    LAS float* af = vec; LAS float* ab = vec + 128; LAS float* dtf = vec + 256; LAS float* dtb = vec + 384;
    __syncthreads();
    sc::bf16x8 bv[4]; f32x4 xv[4]; float dt0 = 0.f, dt1 = 0.f;
    { const int j = tid >> 2; const bf16* bsrc = Bb + (size_t)(row0 + j) * 256 + grp * 128 + (tid & 3) * 32;
      const int dr = tid < 128 ? tid : 0; dt0 = SDT[(size_t)(row0 + dr) * 32 + h]; dt1 = SDT[(size_t)(row0 + dr) * 32 + 16 + h];
#pragma unroll
      for (int i = 0; i < 4; ++i) bv[i] = *(const sc::bf16x8*)(bsrc + 8 * i); }
    if (tid < 128) { dtf[tid] = dt0; dtb[tid] = dt1; }
    __syncthreads();
    { const float* xsrc = SX + (size_t)(row0 + (tid >> 2)) * 640 + h * 64 + (tid & 3) * 16;
#pragma unroll
      for (int i = 0; i < 4; ++i) xv[i] = *(const f32x4*)(xsrc + 4 * i); }
    if (wave < 2) { const bool bw = wave == 1; const LAS float* dsrc = bw ? dtb : dtf; const float A = bw ? Ab : Af;
        const int i0 = bw ? 127 - 2 * lane : 2 * lane, i1 = bw ? i0 - 1 : i0 + 1;
        const float v0 = dsrc[i0] * A, v1 = dsrc[i1] * A; float run = v0 + v1;
        run = wave_scan_(run);
        LAS float* dst = bw ? ab : af; dst[i1] = run; dst[i0] = run - v1; }
    { const int j = tid >> 2, n0 = (tid & 3) * 32;
#pragma unroll
      for (int i = 0; i < 4; ++i) { *(LAS sc::bf16x8*)(Bn + j * PB + n0 + 8 * i) = bv[i];
#pragma unroll
          for (int e = 0; e < 8; ++e) BT[(n0 + 8 * i + e) * PB + j] = (bf16)bv[i][e]; } }
    __syncthreads();
    { const int j = tid >> 2, p0 = (tid & 3) * 16;
      const float wf = dtf[j] * __expf(af[127] - af[j]), wb = dtb[j] * __expf(ab[0] - ab[j]);
#pragma unroll
      for (int i = 0; i < 4; ++i) { const f32x4 v = xv[i];
#pragma unroll
          for (int e = 0; e < 4; ++e) { const int p = p0 + 4 * i + e; xT[p * PB + j] = (bf16)f2bf(v[e]); xfT[p * PB + j] = (bf16)f2bf(v[e] * wf); xbT[p * PB + j] = (bf16)f2bf(v[e] * wb); } } }
    if (tid < 128) { f32x2 w2 = {af[tid], ab[tid]}; *(f32x2*)(SAF + ((size_t)h * MT + row0 + tid) * 2) = w2; }
    if (tid == 0) { SDEC[((0 * 10 + h) * SSD_NB + rb) * 32] = __expf(af[127]); SDEC[((1 * 10 + h) * SSD_NB + rb) * 32] = __expf(ab[0]); }
    __syncthreads();
    const int fr = lane & 15, fq = lane >> 4;
    const int i_loc = 16 * wave + fr;
    const bf16* crow = Cb + (size_t)(row0 + i_loc) * 256 + grp * 128;
    sc::bf16x8 ccv[4];
#pragma unroll
    for (int ks = 0; ks < 4; ++ks) ccv[ks] = *(const sc::bf16x8*)(crow + 32 * ks + 8 * fq);
    const float afi = af[i_loc], abi = ab[i_loc];
    f32x4 yacc[4];
#pragma unroll
    for (int tp = 0; tp < 4; ++tp) yacc[tp] = (f32x4){0.f, 0.f, 0.f, 0.f};
#pragma unroll 1
    for (int s = 0; s < 4; ++s) {
        unsigned lw[4];
#pragma unroll
        for (int hh = 0; hh < 2; ++hh) { const int tj = 2 * s + hh;
            const LAS bf16* brow = Bn + (16 * tj + fr) * PB;
            f32x4 acc = {0.f, 0.f, 0.f, 0.f};
#pragma unroll
            for (int k0 = 0; k0 < 128; k0 += 32) { const sc::bf16x8 bb = *(const LAS sc::bf16x8*)(brow + k0 + 8 * fq); const sc::bf16x8 cc = ccv[k0 >> 5];
                acc = __builtin_amdgcn_mfma_f32_16x16x32_bf16(bb, cc, acc, 0, 0, 0); }
            float Lv[4];
#pragma unroll
            for (int r = 0; r < 4; ++r) { const int j = 16 * tj + 4 * fq + r;
                float f = 0.f; if (j <= i_loc) f += __expf(afi - af[j]) * dtf[j]; if (j >= i_loc) f += __expf(abi - ab[j]) * dtb[j];
                Lv[r] = acc[r] * f; }
            lw[2 * hh] = sc::cvtpk(Lv[0], Lv[1]); lw[2 * hh + 1] = sc::cvtpk(Lv[2], Lv[3]); }
        const v4u lw4 = {lw[0], lw[1], lw[2], lw[3]}; const sc::bf16x8 Lop = __builtin_bit_cast(sc::bf16x8, lw4);
#pragma unroll
        for (int tp = 0; tp < 4; ++tp) { const LAS bf16* xr = xT + (16 * tp + fr) * PB;
            const sc::bf16x4 lo = *(const LAS sc::bf16x4*)(xr + 32 * s + 4 * fq), hi = *(const LAS sc::bf16x4*)(xr + 32 * s + 16 + 4 * fq);
            const sc::bf16x8 xb = {lo[0], lo[1], lo[2], lo[3], hi[0], hi[1], hi[2], hi[3]};
            yacc[tp] = __builtin_amdgcn_mfma_f32_16x16x32_bf16(xb, Lop, yacc[tp], 0, 0, 0); }
    }
#pragma unroll
    for (int tp = 0; tp < 4; ++tp) *(f32x4*)(YL + (size_t)(row0 + i_loc) * 640 + h * 64 + 16 * tp + 4 * fq) = yacc[tp];
#pragma unroll 1
    for (int t = wave; t < 64; t += 8) { const int d = t >> 5, tp = (t >> 3) & 3, tn = t & 7;
        const LAS bf16* ar = (d ? xbT : xfT) + (16 * tp + fr) * PB; const LAS bf16* br = BT + (16 * tn + fr) * PB;
        f32x4 acc = {0.f, 0.f, 0.f, 0.f};
        acc = sc::tile_nt<128>(acc, ar, br, fq);
        *(f32x4*)(SS + ((size_t)((d * 10 + h) * SSD_NB + rb)) * 8192 + (16 * tp + fr) * 128 + 16 * tn + 4 * fq) = acc; }
}
__device__ __forceinline__ void ssd_b_phase(const Args& a, int bid, int G, int tid) {
    GAS unsigned char* wsg_ = (GAS unsigned char*)a.ws; asm volatile("" : "+s"(wsg_)); unsigned char* ws = (unsigned char*)wsg_;
    const float* SS = (const float*)(ws + WS2_SS); const float* SDEC = (const float*)(ws + WS2_SDEC); bf16* HIN = (bf16*)(ws + WS2_SHIN);
    for (int it = bid * NTHR + tid; it < 20 * 2048; it += G * NTHR) {
        const int dh = it / 2048, e4 = (it % 2048) * 4, d = dh / 10;
        float z_; asm volatile("v_mov_b32 %0, 0" : "=v"(z_));
        f32x4 H = {z_, z_, z_, z_};
        static_assert(SSD_NB % 11 == 0, "batches of 11 chunks");
#pragma unroll 1
        for (int s0 = 0; s0 < SSD_NB; s0 += 11) {
            f32x4 Sv[11]; float dv[11]; size_t ov[11];
#pragma unroll
            for (int j = 0; j < 11; ++j) { const int s = s0 + j; const int rb = d == 0 ? s : (s < 2 ? 1 - s : SSD_NB + 1 - s);
                ov[j] = ((size_t)dh * SSD_NB + rb) * 8192 + e4; Sv[j] = *(const f32x4*)(SS + ov[j]); dv[j] = SDEC[(dh * SSD_NB + rb) * 32]; }
#pragma unroll
            for (int j = 0; j < 11; ++j) { u32x2 w; w.x = pk2(H.x, H.y); w.y = pk2(H.z, H.w); *(u32x2*)(HIN + ov[j]) = w; H = H * dv[j] + Sv[j]; }
        }
    }
}
__device__ __forceinline__ void ssd_c_unit(const Args& a, int rb, int h, int wave_s, float pscale = 1.f) {
    int tid_ = wave_s * 64 + lane_id_(); asm volatile("" : "+v"(tid_)); const int lane = tid_ & 63, wave = wave_s;
    GAS unsigned char* wsg_ = (GAS unsigned char*)a.ws; asm volatile("" : "+s"(wsg_)); unsigned char* ws = (unsigned char*)wsg_;
    const bf16* Cb = (const bf16*)(ws + WS2_SCB); const bf16* HIN = (const bf16*)(ws + WS2_SHIN); const float* SAF = (const float*)(ws + WS2_SAF);
    float* YL = (float*)(ws + WS_SY);
    const int fr = lane & 15, fq = lane >> 4, grp = h / 5, row = rb * 128 + 16 * wave + fr;
    const bf16* crow = Cb + (size_t)row * 256 + grp * 128;
    const f32x2 afb = *(const f32x2*)(SAF + ((size_t)h * MT + row) * 2); const float ef = __expf(afb.x), eb = __expf(afb.y);
    sc::bf16x8 cf[4];
#pragma unroll
    for (int ks = 0; ks < 4; ++ks) cf[ks] = *(const sc::bf16x8*)(crow + 32 * ks + 8 * fq);
#pragma unroll 1
    for (int tp0 = 0; tp0 < 4; tp0 += 2) {
        sc::bf16x8 hfv[2][4], hbv[2][4]; f32x4 yo[2]; float* yp[2];
#pragma unroll
        for (int j = 0; j < 2; ++j) { const int tp = tp0 + j;
            const bf16* hf = HIN + ((size_t)(0 * 10 + h) * SSD_NB + rb) * 8192 + (16 * tp + fr) * 128;
            const bf16* hb = HIN + ((size_t)(1 * 10 + h) * SSD_NB + rb) * 8192 + (16 * tp + fr) * 128;
#pragma unroll
            for (int ks = 0; ks < 4; ++ks) { hfv[j][ks] = *(const sc::bf16x8*)(hf + 32 * ks + 8 * fq); hbv[j][ks] = *(const sc::bf16x8*)(hb + 32 * ks + 8 * fq); }
            yp[j] = YL + (size_t)row * 640 + h * 64 + 16 * tp + 4 * fq; yo[j] = *(const f32x4*)yp[j]; }
#pragma unroll
        for (int j = 0; j < 2; ++j) { f32x4 yf = {0.f, 0.f, 0.f, 0.f}, yb = {0.f, 0.f, 0.f, 0.f};
#pragma unroll
            for (int ks = 0; ks < 4; ++ks) { yf = __builtin_amdgcn_mfma_f32_16x16x32_bf16(hfv[j][ks], cf[ks], yf, 0, 0, 0); yb = __builtin_amdgcn_mfma_f32_16x16x32_bf16(hbv[j][ks], cf[ks], yb, 0, 0, 0); }
            yo[j] += (yf * ef + yb * eb) * pscale; }
#pragma unroll
        for (int j = 0; j < 2; ++j) *(f32x4*)yp[j] = yo[j];
    }
}

__device__ __forceinline__ void rwkv_a_unit(const Args& a, int h, int dir, int c, LAS unsigned char* lds, int wave_s) {
    int tid = wave_s * 64 + lane_id_(); asm volatile("" : "+v"(tid)); const int lane = tid & 63, wave = wave_s;
    GAS unsigned char* wsg_ = (GAS unsigned char*)a.ws; asm volatile("" : "+s"(wsg_)); unsigned char* ws = (unsigned char*)wsg_; constexpr size_t S = (size_t)MT * 640;
    const float* RW = (const float*)(ws + WS_RW);
    float* Y = (float*)(ws + RWKV_YBUF) + dir * S;
    bf16* RQ = (bf16*)(ws + WS2_RQ) + (size_t)dir * S; bf16* TCT = (bf16*)(ws + WS2_TCT) + ((size_t)(dir * 10 + h) * RW_NC + c) * 4096; float* DC = (float*)(ws + WS2_DC) + ((size_t)(dir * 10 + h) * RW_NC + c) * 4096;
    constexpr int P = 72;
    constexpr int MB = 64 * P * 2;
    LAS bf16* mKKd = (LAS bf16*)(lds + 0 * MB);  LAS bf16* mBd = (LAS bf16*)(lds + 1 * MB);  LAS bf16* mRd = (LAS bf16*)(lds + 2 * MB);
    LAS bf16* mBeT = (LAS bf16*)(lds + 3 * MB);  LAS bf16* mKeT = (LAS bf16*)(lds + 4 * MB); LAS bf16* mVT = (LAS bf16*)(lds + 5 * MB);
    LAS bf16* mArk = (LAS bf16*)(lds + 6 * MB);  LAS bf16* mArb = (LAS bf16*)(lds + 7 * MB);
    LAS bf16* mKd = (LAS bf16*)(lds + 8 * MB);   LAS bf16* mRT = (LAS bf16*)(lds + 9 * MB);
    LAS bf16* mAkk = (LAS bf16*)(lds + 11 * MB); LAS bf16* mLoT = (LAS bf16*)(lds + 12 * MB); LAS bf16* mD = (LAS bf16*)(lds + 13 * MB); LAS bf16* mM = (LAS bf16*)(lds + 14 * MB);
    LAS float* fDg = (LAS float*)(lds + 15 * MB);
    LAS float* fWc = (LAS float*)(lds + 15 * MB + 5120);
    LAS float* fcs = (LAS float*)(lds + 11 * MB);
    asm volatile("" : "+v"(mKKd), "+v"(mBd), "+v"(mKd), "+v"(mRd), "+v"(mBeT), "+v"(mKeT), "+v"(mVT), "+v"(mAkk), "+v"(mArk), "+v"(mArb));
    asm volatile("" : "+v"(mRT), "+v"(mLoT), "+v"(mD), "+v"(mM), "+v"(fDg), "+v"(fWc), "+v"(fcs));
    LAS bf16* mXT = mKKd;
    LAS bf16* mnWmT = mKKd; LAS bf16* mnU0T = mBd;
    const int p0 = 64 * c;
    __syncthreads();
    const float* LW = RW + (3 + dir) * S;
    f32x4 gl[2][6];
    sc::bf16x8 gicl, gv, gkk, gk, gr;
    { const int t = tid >> 3, k8 = (tid & 7) * 8; const int row = seq_row(p0 + t, dir); const size_t o = (size_t)row * 640 + h * 64 + k8;
#pragma unroll
      for (int e = 0; e < 2; ++e) gl[e][0] = *(const f32x4*)(LW + o + 4 * e);
      gkk = *(const sc::bf16x8*)((const bf16*)(RW + 2 * S) + o); gk = *(const sc::bf16x8*)((const bf16*)(RW + (5 + dir) * S) + o); gr = *(const sc::bf16x8*)((const bf16*)(RW + 0 * S) + o);
      gicl = *(const sc::bf16x8*)((const bf16*)(RW + (7 + dir) * S) + o); gv = *(const sc::bf16x8*)((const bf16*)(RW + 1 * S) + o);
      *(LAS f32x4*)(fcs + t * 64 + k8) = gl[0][0]; *(LAS f32x4*)(fcs + t * 64 + k8 + 4) = gl[1][0]; }
    __syncthreads();
    { const int kc = tid & 63, tb = tid >> 6; float loc[8]; float run = 0.f;
#pragma unroll
      for (int j = 0; j < 8; ++j) { run += fcs[(8 * tb + j) * 64 + kc]; loc[j] = run; }
      fWc[64 + tid] = run;
      __syncthreads();
      float off = 0.f;
#pragma unroll
      for (int b = 0; b < 7; ++b) if (b < tb) off += fWc[64 + b * 64 + kc];
#pragma unroll
      for (int j = 0; j < 8; ++j) fcs[(8 * tb + j) * 64 + kc] = loc[j] + off;
      if (tb == 7) fWc[kc] = __expf(loc[7] + off); }
    __syncthreads();
    { const int t = tid >> 3, k8 = (tid & 7) * 8;
      float cs[8], lw[8], csC[8], kk[8], bb[8], kx[8], rr[8], vv[8], kkd[8];
#pragma unroll
      for (int e = 0; e < 8; ++e) { cs[e] = fcs[t * 64 + k8 + e]; csC[e] = fcs[63 * 64 + k8 + e]; }
#pragma unroll
      for (int e = 0; e < 8; e += 4) { const f32x4 x0 = gl[e >> 2][0];
#pragma unroll
          for (int i = 0; i < 4; ++i) { lw[e + i] = x0[i]; kk[e + i] = sc::bf2f((unsigned short)gkk[e + i]); bb[e + i] = kk[e + i] * sc::bf2f((unsigned short)gicl[e + i]); kx[e + i] = sc::bf2f((unsigned short)gk[e + i]);
              rr[e + i] = sc::bf2f((unsigned short)gr[e + i]); vv[e + i] = sc::bf2f((unsigned short)gv[e + i]); } }
      unsigned wkkd[4], wbd[4], wkd[4], wrd[4];
      float be[8], ke[8];
#pragma unroll
      for (int e = 0; e < 8; ++e) { const float ei = __expf(-cs[e]); kkd[e] = kk[e] * __expf(cs[e] - lw[e]);
          const float bd = bb[e] * ei, kd = kx[e] * ei, rd = rr[e] * __expf(cs[e]); const float ec = __expf(csC[e] - cs[e]); be[e] = bb[e] * ec; ke[e] = kx[e] * ec;
          if (e & 1) { wkkd[e >> 1] = sc::cvtpk(kkd[e - 1], kkd[e]); }
          cs[e] = bd; lw[e] = kd; csC[e] = rd; }
#pragma unroll
      for (int e = 0; e < 4; ++e) { wbd[e] = sc::cvtpk(cs[2 * e], cs[2 * e + 1]); wkd[e] = sc::cvtpk(lw[2 * e], lw[2 * e + 1]); wrd[e] = sc::cvtpk(csC[2 * e], csC[2 * e + 1]); }
      __syncthreads();
      *(LAS v4u*)(mKKd + t * P + k8) = (v4u){wkkd[0], wkkd[1], wkkd[2], wkkd[3]}; *(LAS v4u*)(mBd + t * P + k8) = (v4u){wbd[0], wbd[1], wbd[2], wbd[3]};
      *(LAS v4u*)(mKd + t * P + k8) = (v4u){wkd[0], wkd[1], wkd[2], wkd[3]};    *(LAS v4u*)(mRd + t * P + k8) = (v4u){wrd[0], wrd[1], wrd[2], wrd[3]};
#pragma unroll
      for (int e = 0; e < 8; ++e) { mBeT[(k8 + e) * P + t] = (bf16)f2bf(be[e]); mKeT[(k8 + e) * P + t] = (bf16)f2bf(ke[e]); mVT[(k8 + e) * P + t] = (bf16)f2bf(vv[e]); mRT[(k8 + e) * P + t] = (bf16)f2bf(kkd[e]); }
      for (int i = tid; i < 2 * MB / 16; i += NTHR) *(LAS v4u*)((LAS unsigned char*)mD + i * 16) = (v4u){0u, 0u, 0u, 0u};
    }
    __syncthreads();
    const int fr = lane & 15, fq = lane >> 4;
#pragma unroll
    for (int i8 = 0; i8 < 8; ++i8) { const int tt = wave + 8 * i8; const int m = i8 >> 1, ti = (tt >> 2) & 3, tj = tt & 3;
        f32x4 acc = {0.f, 0.f, 0.f, 0.f};
        if (m == 0) {
            u32x2 w = {0u, 0u};
            if (ti > tj) { acc = sc::tile_nt<64>(acc, mBd + (16 * tj + fr) * P, mKKd + (16 * ti + fr) * P, fq);
                w.x = sc::cvtpk(acc[0], acc[1]); w.y = sc::cvtpk(acc[2], acc[3]); }
            else if (ti == tj) { acc = sc::tile_nt<64>(acc, mKKd + (16 * ti + fr) * P, mBd + (16 * tj + fr) * P, fq);
#pragma unroll
                for (int r = 0; r < 4; ++r) if (!(4 * fq + r < fr)) acc[r] = 0.f;
                *(LAS f32x4*)(fDg + ti * 320 + fr * 20 + 4 * fq) = acc; }
            *(LAS u32x2*)(mLoT + (16 * tj + fr) * P + 16 * ti + 4 * fq) = w;
        } else {
            const LAS bf16* A = (m == 1 ? mKKd : mRd) + (16 * ti + fr) * P; const LAS bf16* Bt = (m == 3 ? mBd : mKd) + (16 * tj + fr) * P;
            if (tj <= ti) acc = sc::tile_nt<64>(acc, A, Bt, fq);
            const int t = 16 * ti + fr;
#pragma unroll
            for (int r = 0; r < 4; ++r) { const int s = 16 * tj + 4 * fq + r; const bool keep = (m == 1) ? (s < t) : (s <= t); if (!keep) acc[r] = 0.f; }
            LAS bf16* Dm = (m == 1 ? mAkk : (m == 2 ? mArk : mArb)); u32x2 w; w.x = sc::cvtpk(acc[0], acc[1]); w.y = sc::cvtpk(acc[2], acc[3]); *(LAS u32x2*)(Dm + t * P + 16 * tj + 4 * fq) = w; }
    }
    __syncthreads();
    for (int i = tid; i < 2 * MB / 16; i += NTHR) *(LAS v4u*)((LAS unsigned char*)mXT + i * 16) = (v4u){0u, 0u, 0u, 0u};
    if (wave == 0) { const int bi = lane >> 4, cI = lane & 15; const LAS float* L = fDg + bi * 320; float y[16];
#pragma unroll
        for (int r = 0; r < 16; ++r) { float v = (r == cI) ? 1.f : 0.f;
#pragma unroll
            for (int r2 = 0; r2 < r; ++r2) v -= L[r * 20 + r2] * y[r2];
            y[r] = v; }
#pragma unroll
        for (int r = 0; r < 16; ++r) mD[(16 * bi + r) * P + 16 * bi + cI] = (bf16)f2bf(y[r]);
    } else {
#pragma unroll 1
        for (int tt = wave - 1; tt < 16; tt += 7) { const int tv = tt >> 2, ti = tt & 3;
            f32x4 acc = {0.f, 0.f, 0.f, 0.f};
            acc = sc::tile_nt<64>(acc, mVT + (16 * tv + fr) * P, mAkk + (16 * ti + fr) * P, fq);
            u32x2 w; w.x = sc::cvtpk(acc[0], acc[1]); w.y = sc::cvtpk(acc[2], acc[3]); *(LAS u32x2*)(mRT + (64 + 16 * tv + fr) * P + 16 * ti + 4 * fq) = w; }
    }
    __syncthreads();
    f32x4 g[4];
#pragma unroll
    for (int I = 0; I < 4; ++I) { f32x4 z = {0.f, 0.f, 0.f, 0.f}; g[I] = sc::tile_nt<64>(z, mD + (16 * I + fr) * P, mRT + (16 * wave + fr) * P, fq); }
    if (wave < 6) { const int ti = wave < 1 ? 1 : (wave < 3 ? 2 : 3), tj = wave < 1 ? 0 : (wave < 3 ? wave - 1 : wave - 3);
        f32x4 z = {0.f, 0.f, 0.f, 0.f}; const f32x4 acc = sc::tile_nt<64>(z, mD + (16 * ti + fr) * P, mLoT + (16 * tj + fr) * P, fq);
        u32x2 w; w.x = sc::cvtpk(acc[0], acc[1]); w.y = sc::cvtpk(acc[2], acc[3]); *(LAS u32x2*)(mM + (16 * ti + fr) * P + 16 * tj + 4 * fq) = w; }
    __syncthreads();
#pragma unroll
    for (int I = 0; I < 4; ++I) { f32x4 acc = g[I];
        if (I > 0) acc = sc::tile_nt<64>(acc, mM + (16 * I + fr) * P, mXT + (16 * wave + fr) * P, fq);
#pragma unroll
        for (int r = 0; r < 4; ++r) mXT[(16 * wave + 4 * fq + r) * P + 16 * I + fr] = (bf16)f2bf(-acc[r]);
        asm volatile("s_waitcnt lgkmcnt(0)" ::: "memory"); }
    __syncthreads();
    LAS float* oY = (LAS float*)mKd;
    LAS float* oD = oY + 4096;
    LAS bf16* oR = (LAS bf16*)(oD + 4096);
    LAS bf16* oT = oR + 4096;
#pragma unroll
    for (int i8 = 0; i8 < 8; ++i8) { const int tt = wave + 8 * i8; const int m = i8 >> 1, ti = (tt >> 2) & 3, tj = tt & 3; const int rI = 16 * ti + fr, c4 = 16 * tj + 4 * fq;
        f32x4 acc = {0.f, 0.f, 0.f, 0.f};
        if (m == 0) {
            acc = sc::tile_nt<64>(acc, mArk + rI * P, mVT + (16 * tj + fr) * P, fq); acc = sc::tile_nt<64>(acc, mArb + rI * P, mnU0T + (16 * tj + fr) * P, fq);
            *(LAS f32x4*)(oY + rI * 64 + c4) = acc;
        } else if (m == 1) {
            const LAS bf16* rp = mRd + rI * P + c4;
#pragma unroll
            for (int r = 0; r < 4; ++r) acc[r] = sc::bf2f(rp[r]);
            acc = sc::tile_nt<64>(acc, mArb + rI * P, mnWmT + (16 * tj + fr) * P, fq);
            u32x2 w; w.x = sc::cvtpk(acc[0], acc[1]); w.y = sc::cvtpk(acc[2], acc[3]); *(LAS u32x2*)(oR + rI * 64 + c4) = w;
        } else if (m == 2) {
            acc = sc::tile_nt<64>(acc, mBeT + rI * P, mnWmT + (16 * tj + fr) * P, fq);
#pragma unroll
            for (int r = 0; r < 4; ++r) if (c4 + r == rI) acc[r] += fWc[rI];
            u32x2 w; w.x = sc::cvtpk(acc[0], acc[1]); w.y = sc::cvtpk(acc[2], acc[3]); *(LAS u32x2*)(oT + rI * 64 + c4) = w;
        } else {
            acc = sc::tile_nt<64>(acc, mVT + rI * P, mKeT + (16 * tj + fr) * P, fq); acc = sc::tile_nt<64>(acc, mnU0T + rI * P, mBeT + (16 * tj + fr) * P, fq);
            *(LAS f32x4*)(oD + rI * 64 + c4) = acc;
        }
    }
    __syncthreads();
    { const int r8 = tid >> 3, q8 = tid & 7;
      const size_t yrow = (size_t)seq_row(p0 + r8, dir) * 640 + h * 64;
      *(f32x4*)(Y + yrow + 4 * q8) = *(const LAS f32x4*)(oY + r8 * 64 + 4 * q8); *(f32x4*)(Y + yrow + 32 + 4 * q8) = *(const LAS f32x4*)(oY + r8 * 64 + 32 + 4 * q8);
      *(v4u*)(RQ + (size_t)(p0 + r8) * 640 + h * 64 + 8 * q8) = *(const LAS v4u*)(oR + r8 * 64 + 8 * q8);
      *(v4u*)(TCT + tid * 8) = *(const LAS v4u*)(oT + tid * 8);
      *(f32x4*)(DC + tid * 4) = *(const LAS f32x4*)(oD + tid * 4); *(f32x4*)(DC + 2048 + tid * 4) = *(const LAS f32x4*)(oD + 2048 + tid * 4); }
}
__device__ __forceinline__ void rwkv_b_task(const Args& a, int h, int dir, LAS unsigned char* lds, int tid, int lane, int wave) {
    GAS unsigned char* wsg_ = (GAS unsigned char*)a.ws; asm volatile("" : "+s"(wsg_)); unsigned char* ws = (unsigned char*)wsg_;
    const bf16* TCT = (const bf16*)(ws + WS2_TCT) + (size_t)(dir * 10 + h) * RW_NC * 4096; const float* DC = (const float*)(ws + WS2_DC) + (size_t)(dir * 10 + h) * RW_NC * 4096;
    bf16* SIN = (bf16*)(ws + WS2_SIN) + (size_t)(dir * 10 + h) * RW_NC * 4096;
    constexpr int P = 72;
    LAS bf16* Sb0 = (LAS bf16*)lds; LAS bf16* Sb1 = Sb0 + 64 * P;
    const int fr = lane & 15, fq = lane >> 4;
    __syncthreads();
    for (int i = tid; i < 64 * P; i += NTHR) Sb0[i] = 0;
    __syncthreads();
    const int tv = wave >> 1, tk0 = 2 * (wave & 1); const int v = 16 * tv + fr;
    sc::bf16x8 tq0[2][2], tq1[2][2], tq2[2][2], tq3[2][2], tq4[2][2], tq5[2][2]; f32x4 dq0[2], dq1[2], dq2[2], dq3[2], dq4[2], dq5[2];
#define RWB_LOAD(tq, dq, c_) do { const int cc_ = (c_) < RW_NC ? (c_) : RW_NC - 1; const bf16* tct_ = TCT + (size_t)cc_ * 4096; const float* dc_ = DC + (size_t)cc_ * 4096; \
        _Pragma("unroll") for (int q = 0; q < 2; ++q) { const int tk = tk0 + q; dq[q] = *(const f32x4*)(dc_ + v * 64 + 16 * tk + 4 * fq); \
            _Pragma("unroll") for (int ks = 0; ks < 2; ++ks) tq[q][ks] = *(const sc::bf16x8*)(tct_ + (16 * tk + fr) * 64 + 32 * ks + 8 * fq); } } while (0)
#define RWB_STEP(tq, dq, c_, Sc, Sn) do { \
        { const v4u sin_ = *(const LAS v4u*)(Sc + (tid >> 3) * P + (tid & 7) * 8); *(v4u*)(SIN + (size_t)(c_) * 4096 + (tid >> 3) * 64 + (tid & 7) * 8) = sin_; }     \
        _Pragma("unroll") for (int q = 0; q < 2; ++q) { const int tk = tk0 + q; const int k4 = 16 * tk + 4 * fq; \
            f32x4 acc = dq[q]; \
            _Pragma("unroll") for (int ks = 0; ks < 2; ++ks) { const sc::bf16x8 sa = *(const LAS sc::bf16x8*)(Sc + v * P + 32 * ks + 8 * fq); acc = __builtin_amdgcn_mfma_f32_16x16x32_bf16(tq[q][ks], sa, acc, 0, 0, 0); } \
            u32x2 w; w.x = sc::cvtpk(acc[0], acc[1]); w.y = sc::cvtpk(acc[2], acc[3]); *(LAS u32x2*)(Sn + v * P + k4) = w; } \
        asm volatile("s_waitcnt lgkmcnt(0)" ::: "memory"); __builtin_amdgcn_s_barrier(); asm volatile("" ::: "memory"); } while (0)
    RWB_LOAD(tq0, dq0, 0); RWB_LOAD(tq1, dq1, 1); RWB_LOAD(tq2, dq2, 2); RWB_LOAD(tq3, dq3, 3); RWB_LOAD(tq4, dq4, 4);
    static_assert(RW_NC % 6 == 0, "ring of 6");
    for (int c = 0; c < RW_NC; c += 6) {
        RWB_LOAD(tq5, dq5, c + 5); RWB_STEP(tq0, dq0, c, Sb0, Sb1);
        RWB_LOAD(tq0, dq0, c + 6); RWB_STEP(tq1, dq1, c + 1, Sb1, Sb0);
        RWB_LOAD(tq1, dq1, c + 7); RWB_STEP(tq2, dq2, c + 2, Sb0, Sb1);
        RWB_LOAD(tq2, dq2, c + 8); RWB_STEP(tq3, dq3, c + 3, Sb1, Sb0);
        RWB_LOAD(tq3, dq3, c + 9); RWB_STEP(tq4, dq4, c + 4, Sb0, Sb1);
        RWB_LOAD(tq4, dq4, c + 10); RWB_STEP(tq5, dq5, c + 5, Sb1, Sb0);
    }
    asm volatile("s_waitcnt vmcnt(0)" ::: "memory");
    __syncthreads();
#undef RWB_LOAD
#undef RWB_STEP
}
__device__ __forceinline__ void rwkv_c_unit(const Args& a, int dir, int c, int wave_s, float pscale = 1.f) {
    int tid_ = wave_s * 64 + lane_id_(); asm volatile("" : "+v"(tid_)); const int lane = tid_ & 63, wave = wave_s;
    GAS unsigned char* wsg_ = (GAS unsigned char*)a.ws; asm volatile("" : "+s"(wsg_)); unsigned char* ws = (unsigned char*)wsg_; constexpr size_t S = (size_t)MT * 640;
    const bf16* RQ = (const bf16*)(ws + WS2_RQ) + (size_t)dir * S; float* Y = (float*)(ws + RWKV_YBUF) + dir * S;
    const int fr = lane & 15, fq = lane >> 4, p0 = 64 * c;
#pragma unroll 1
    for (int t0 = wave; t0 < 160; t0 += 40) {
        sc::bf16x8 af[5][2], bfv[5][2]; f32x4 yo[5]; float* yp[5];
#pragma unroll
        for (int j = 0; j < 5; ++j) { const int tt = t0 + 8 * j; const int h = tt >> 4, ti = (tt >> 2) & 3, tv = tt & 3;
            const bf16* sin = (const bf16*)(ws + WS2_SIN) + ((size_t)(dir * 10 + h) * RW_NC + c) * 4096 + (16 * tv + fr) * 64;
            const bf16* rq = RQ + (size_t)(p0 + 16 * ti + fr) * 640 + h * 64;
            af[j][0] = *(const sc::bf16x8*)(rq + 8 * fq); af[j][1] = *(const sc::bf16x8*)(rq + 32 + 8 * fq); bfv[j][0] = *(const sc::bf16x8*)(sin + 8 * fq); bfv[j][1] = *(const sc::bf16x8*)(sin + 32 + 8 * fq);
            yp[j] = Y + (size_t)seq_row(p0 + 16 * ti + fr, dir) * 640 + h * 64 + 16 * tv + 4 * fq; yo[j] = *(const f32x4*)yp[j]; }
#pragma unroll
        for (int j = 0; j < 5; ++j) { f32x4 acc = {0.f, 0.f, 0.f, 0.f};
            acc = __builtin_amdgcn_mfma_f32_16x16x32_bf16(bfv[j][0], af[j][0], acc, 0, 0, 0); acc = __builtin_amdgcn_mfma_f32_16x16x32_bf16(bfv[j][1], af[j][1], acc, 0, 0, 0);
            yo[j] += acc * pscale; }
#pragma unroll
        for (int j = 0; j < 5; ++j) *(f32x4*)yp[j] = yo[j];
    }
}
__device__ __forceinline__ void rwkv_scan_task(const Args& a, int h, int dir, LAS unsigned char* lds, int tid, int lane, int wave) {
    unsigned char* ws = a.ws; constexpr size_t S = (size_t)MT * 640;
    const float* RW = (const float*)(ws + WS_RW);
    const float* arr[6] = { RW + 2 * S  , RW + (7 + dir) * S  , RW + (3 + dir) * S  , RW + (5 + dir) * S  , RW + 0 * S  , RW + 1 * S   };
    float* Y = (float*)(ws + WS_RY) + dir * S;
    LAS float* tile = (LAS float*)lds;
    const int rr = lane >> 2, kq = lane & 3, vrow = wave * 16 + rr;
    float st[16];
#pragma unroll
    for (int j = 0; j < 16; ++j) st[j] = 0.f;
    for (int p0 = 0; p0 < MT; p0 += 32) {
        __syncthreads();
        { const int s = tid >> 4, q4 = tid & 15; const int row = seq_row(p0 + s, dir);
#pragma unroll
          for (int i = 0; i < 6; ++i) { f32x4 vv_ = *(const f32x4*)(arr[i] + (size_t)row * 640 + h * 64 + 4 * q4); if (i == 2) { vv_.x = expf(vv_.x); vv_.y = expf(vv_.y); vv_.z = expf(vv_.z); vv_.w = expf(vv_.w); } *(LAS f32x4*)(tile + (i * 32 + s) * 64 + 4 * q4) = vv_; } }
        __syncthreads();
        if (wave < 4) {
            for (int s = 0; s < 32; ++s) {
                const LAS float* tk = tile + (0 * 32 + s) * 64 + 16 * kq; const LAS float* tb = tile + (1 * 32 + s) * 64 + 16 * kq; const LAS float* tw = tile + (2 * 32 + s) * 64 + 16 * kq;
                const LAS float* tkk = tile + (3 * 32 + s) * 64 + 16 * kq; const LAS float* tr = tile + (4 * 32 + s) * 64 + 16 * kq;
                const float vv = tile[(5 * 32 + s) * 64 + vrow];
                float sa = 0.f;
#pragma unroll
                for (int j = 0; j < 16; ++j) sa += st[j] * tk[j];
                sa = quad_sum(sa);
                float y = 0.f;
#pragma unroll
                for (int j = 0; j < 16; ++j) { st[j] = st[j] * tw[j] - sa * tb[j] + vv * tkk[j]; y += st[j] * tr[j]; }
                y = quad_sum(y);
                if (kq == 0) Y[(size_t)seq_row(p0 + s, dir) * 640 + h * 64 + vrow] = y;
            }
        }
    }
    __syncthreads();
}
__device__ __forceinline__ void ssd_scan_task(const Args& a, int l, int h, int dir, LAS unsigned char* lds, int tid, int lane, int wave) {
    unsigned char* ws = a.ws; constexpr size_t S = (size_t)MT * 640;
    const float* SX = (const float*)(ws + WS_SX); const bf16* SBb = (const bf16*)(ws + WS2_SBB); const bf16* SCb = (const bf16*)(ws + WS2_SCB); const float* SDT = (const float*)(ws + WS_SDT);
    float* Y = (float*)(ws + WS_SY) + dir * S;
    const float A = -expf(a.in[I_ALOG][l * 20 + dir * 10 + h]);
    const int grp = h / 5;
    LAS float* tB = (LAS float*)lds;
    LAS float* tC = tB + 32 * 128;
    LAS float* tX = tC + 32 * 128;
    LAS float* tD = tX + 32 * 64;
    const int rr = lane >> 2, kq = lane & 3, prow = wave * 16 + rr;
    float st[32];
#pragma unroll
    for (int j = 0; j < 32; ++j) st[j] = 0.f;
    for (int p0 = 0; p0 < MT; p0 += 32) {
        __syncthreads();
#pragma unroll
        for (int i = 0; i < 2; ++i) { const int idx = tid + 512 * i, s = idx >> 5, q4 = idx & 31; const int row = seq_row(p0 + s, dir);
            const sc::bf16x4 b4 = *(const sc::bf16x4*)(SBb + (size_t)row * 256 + grp * 128 + 4 * q4), c4 = *(const sc::bf16x4*)(SCb + (size_t)row * 256 + grp * 128 + 4 * q4);
            *(LAS f32x4*)(tB + s * 128 + 4 * q4) = (f32x4){sc::bf2f(b4[0]), sc::bf2f(b4[1]), sc::bf2f(b4[2]), sc::bf2f(b4[3])};
            *(LAS f32x4*)(tC + s * 128 + 4 * q4) = (f32x4){sc::bf2f(c4[0]), sc::bf2f(c4[1]), sc::bf2f(c4[2]), sc::bf2f(c4[3])}; }
        { const int s = tid >> 4, q4 = tid & 15; const int row = seq_row(p0 + s, dir);
          *(LAS f32x4*)(tX + s * 64 + 4 * q4) = *(const f32x4*)(SX + (size_t)row * 640 + h * 64 + 4 * q4); }
        if (tid < 32) tD[tid] = SDT[(size_t)seq_row(p0 + tid, dir) * 32 + dir * 16 + h];
        __syncthreads();
        if (wave < 4) {
            for (int s = 0; s < 32; ++s) {
                const float dt = tD[s]; const float dA = expf(dt * A); const float cf = dt * tX[s * 64 + prow];
                const LAS float* pb = tB + s * 128 + 32 * kq; const LAS float* pc = tC + s * 128 + 32 * kq;
                float y = 0.f;
#pragma unroll
                for (int j = 0; j < 32; ++j) { st[j] = st[j] * dA + cf * pb[j]; y += st[j] * pc[j]; }
                y = quad_sum(y);
                if (kq == 0) Y[(size_t)seq_row(p0 + s, dir) * 640 + h * 64 + prow] = y;
            }
        }
    }
    __syncthreads();
}

#ifndef MK_SINGLE
#ifdef RWKV_DEBUG
#define MK_SINGLE 0
#else
#define MK_SINGLE 1
#endif
#endif
enum Phase { PH_PRE = 0, PH_NORM1, PH_INPROJ, PH_PREP, PH_SCAN_A, PH_ATTN, PH_SCAN_B  , PH_SCAN_C, PH_MIXFIN, PH_OUTPROJ, PH_NORM2, PH_FFN1, PH_FFN2, PH_COUNT };

constexpr unsigned KM_ALL = 0xFFFFu, KM_GEMM = (1u << PH_INPROJ) | (1u << PH_OUTPROJ) | (1u << PH_FFN1) | (1u << PH_FFN2), KM_REST = KM_ALL & ~KM_GEMM;
__device__ __forceinline__ bool run_here(int single, int layer, int phase, int l, int k) { asm volatile("" : "+s"(single), "+s"(layer), "+s"(phase)); return single || (layer == l && phase == k); }
template <unsigned PHM> __global__ void __launch_bounds__(NTHR, 2) fwd_kernel(Args a) {
    extern __shared__ __attribute__((aligned(16))) unsigned char lds_raw[];
    LAS unsigned char* lds = (LAS unsigned char*)lds_raw;
    int G = gridDim.x, bid = blockIdx.x, NGW = G * NWAVES;
    const int wave_s = __builtin_amdgcn_readfirstlane((int)threadIdx.x >> 6);
    int tid = wave_s * 64 + lane_id_(), lane = tid & 63, wave = wave_s, gw = bid * NWAVES + wave;
#define FRESH() do { tid = wave_s * 64 + lane_id_(); asm volatile("" : "+v"(tid)); lane = tid & 63; wave = wave_s; bid = blockIdx.x; G = gridDim.x; asm volatile("" : "+s"(bid), "+s"(G)); NGW = G * NWAVES; gw = bid * NWAVES + wave; { GAS unsigned char* wsg_ = (GAS unsigned char*)a.ws; asm volatile("" : "+s"(wsg_)); ws = (unsigned char*)wsg_; } } while (0)
    unsigned char* ws = a.ws;
    volatile LAS unsigned* MISC = (volatile LAS unsigned*)(lds + MISC_OFF);
    if (tid < 64) MISC[tid] = 0u;
    __syncthreads();
    XcdBarrier bar; bar.bar = (unsigned*)(ws + WS_CTL) + CW_BAR; bar.x = 0; bar.st = nullptr;
    if (a.single) bar = xcd_barrier_post((unsigned*)(ws + WS_CTL) + CW_BAR, MISC + 8, tid == 0);
#define RUN(l_, k_) (((PHM >> (k_)) & 1u) && run_here(a.single, a.layer, a.phase, (l_), (k_)))
#ifndef DUPMASK
#define DUPMASK 0u
#endif
#define NREP(k_) (((DUPMASK >> (k_)) & 1u) ? 2 : 1)
#ifndef NSEAM
#define NSEAM 1
#endif
#define SEAM() do { int sg_ = a.single; asm volatile("" : "+s"(sg_)); if (sg_) { for (int sr_ = 0; sr_ < NSEAM; ++sr_) xcd_barrier(bar, (wave_s * 64 + lane_id_()) == 0); } } while (0)

    if (RUN(0, PH_PRE)) for (int rep_ = 0; rep_ < NREP(PH_PRE); ++rep_) { FRESH(); pre_phase(a, lds, tid, lane, wave, bid, G); SEAM(); }

    const int l_lo = a.single ? 0 : a.layer, l_hi = a.single ? DEPTH : a.layer + 1;
    for (int l = l_lo; l < l_hi; ++l) {
#define xl_in ((l == 0) ? a.in[LIDX(I_X)] : (const float*)a.out)
#define xc_in ((l == 0) ? a.in[LIDX(I_CTX)] : (const float*)(ws + WS_XC))
#define xl_out (a.out)
#define xc_out ((float*)(ws + WS_XC))
#define modl ((const float*)(ws + WS_MOD) + (size_t)l * 2 * 12288)
#define H ((bf16*)(ws + WS_H))

        if (RUN(l, PH_NORM1)) for (int rep_ = 0; rep_ < NREP(PH_NORM1); ++rep_) { FRESH();
            if (l == 0) { mod_reduce(a, 0, 32, bid, G, tid); SEAM(); FRESH(); }
            norm_phase(xl_in, xc_in, a.in[LIDX(I_N1G)] + l * DM, modl, 0, H, gw, NGW, lane, l > 0 ? KS_F2 : 0, (const float*)(ws + WS3_SLAB), modl - 2 * 12288 + 12288 + 5 * DM, xc_out, lds, wave, bid, G); SEAM(); }

        if (RUN(l, PH_INPROJ)) for (int rep_ = 0; rep_ < NREP(PH_INPROJ); ++rep_) {
            FRESH();
            pg8::Gemm g{(const pg8::bf16_t*)H, (const pg8::bf16_t*)(ws + WS_WIN + l * SZ_WIN), MT, INP, DM}; pg8::StaticOrder S; S.init(MT, INP, G, bid);
            EpiStoreBf16 E{(bf16*)(ws + WS_U), INP};
            pg8::gemm_phase<EpiStoreBf16, pg8::StaticOrder, true, true>(lds, g, S, E, wave_s);
            if (l + 1 < DEPTH) {
                const int nun_ = (MT / 256) * (INP / 256), rounds_ = (nun_ + G - 1) / G; int first_idle = nun_ - (rounds_ - 1) * G; if (first_idle >= G) first_idle = 0;
                if (bid >= first_idle) convert_items(a, l + 1, (LAS float*)(lds + wave * 17408), lane, (bid - first_idle) * NWAVES + wave, (G - first_idle) * NWAVES); }
            SEAM();
        }

        if (RUN(l, PH_PREP)) for (int rep_ = 0; rep_ < NREP(PH_PREP); ++rep_) { FRESH(); { const int nrw = (MT / PREP_RI < G - 64) ? MT / PREP_RI : G / 2;
              if (bid < nrw) { prep_rwkv(a, l, lds, tid, lane, wave, bid, nrw);
#ifdef PROBE_PRW2
                  prep_rwkv(a, l, lds, tid, lane, wave, bid, nrw);
#endif
              } else { prep_rows(a, l, (bid - nrw) * NWAVES + wave, (G - nrw) * NWAVES, lane);
#ifdef PROBE_PRR2
                  prep_rows(a, l, (bid - nrw) * NWAVES + wave, (G - nrw) * NWAVES, lane);
#endif
              } } SEAM(); }

#ifndef NATT_A
#define NATT_A 148
#endif
#define ATTN_UNIT(u_) do { const int u__ = (u_); __syncthreads(); \
            if (u__ < 384) { const int vh = u__ >> 5, qb = u__ & 31; \
                att::attn_unit(Qb + (size_t)(CTX + 256 * qb) * 768 + vh * 64, Kb + vh * 64, Vb + (vh >> 1) * 128, AO + (size_t)(CTX + 256 * qb) * 1536 + vh * 128, MT, (char*)lds_raw, wave_s); \
            } else { const int vh = u__ - 384; \
                att::attn_unit(Qb + vh * 64, Kb + vh * 64, Vb + (vh >> 1) * 128, AO + vh * 128, CTX, (char*)lds_raw, wave_s); } } while (0)
        if (RUN(l, PH_SCAN_A)) {
            FRESH();
            const unsigned short* Qb = (const unsigned short*)(ws + WS_Q); const unsigned short* Kb = (const unsigned short*)(ws + WS_K); const unsigned short* Vb = (const unsigned short*)(ws + WS_V);
            float* AO = (float*)(ws + WS_AO);
            for (int u = bid; u < NATT_A + 12; u += G) { if (u < NATT_A) ATTN_UNIT(u); else if (l < DEPTH - 1) ATTN_UNIT(384 + (u - NATT_A)); }
            unsigned* qctr = (unsigned*)(ws + WS_CTL) + CW_QUEUE + 64 * l;
            unsigned qnext = 0u; if (tid == 0) qnext = __hip_atomic_fetch_add(qctr, 1u, __ATOMIC_RELAXED, __HIP_MEMORY_SCOPE_AGENT);
            for (;;) {
                __syncthreads();
                if (tid == 0) MISC[16] = qnext;
                __syncthreads();
                const int u = (int)MISC[16];
                if (u >= 2640 + 660) break;
                if (tid == 0) qnext = __hip_atomic_fetch_add(qctr, 1u, __ATOMIC_RELAXED, __HIP_MEMORY_SCOPE_AGENT);
                if (u < 2640) { const int c = u / 20, hd = u % 20; rwkv_a_unit(a, hd >> 1, hd & 1, c, lds, wave_s); }
                else { const int v = u - 2640; ssd_a_unit(a, l, v / 10, v % 10, lds, wave_s); }
            }
            __syncthreads();
            SEAM();
        }

        if (RUN(l, PH_ATTN)) {
            FRESH();
            if (G >= 236) { if (bid < 20) rwkv_b_task(a, bid >> 1, bid & 1, lds, tid, lane, wave); else if (bid < 236) ssd_b_phase(a, bid - 20, 216, tid); }
            else { for (int t = bid; t < 20; t += G) rwkv_b_task(a, t >> 1, t & 1, lds, tid, lane, wave); ssd_b_phase(a, bid, G, tid); }
            const unsigned short* Qb = (const unsigned short*)(ws + WS_Q); const unsigned short* Kb = (const unsigned short*)(ws + WS_K); const unsigned short* Vb = (const unsigned short*)(ws + WS_V);
            float* AO = (float*)(ws + WS_AO);
#ifndef PROBE_AT
#define PROBE_AT 1
#endif
            if (G > 20) { for (int u = NATT_A + (bid - 20); bid >= 20 && u < 384; u += (G - 20)) { for (int pr_ = 0; pr_ < PROBE_AT; ++pr_) ATTN_UNIT(u); } } else { for (int u = NATT_A + bid; u < 384; u += G) ATTN_UNIT(u); }
            __syncthreads();
            SEAM();
        }
#undef ATTN_UNIT

        if (RUN(l, PH_SCAN_C)) for (int rep_ = 0; rep_ < NREP(PH_SCAN_C); ++rep_) {
            FRESH();
            const float psc = rep_ ? 0.f : 1.f;
            for (int u = bid; u < 264 + 660; u += G) {
                if (u < 264) rwkv_c_unit(a, u & 1, u >> 1, wave_s, psc);
                else { const int v = u - 264; ssd_c_unit(a, v / 10, v % 10, wave_s, psc); }
            }
            SEAM();
        }

        if (RUN(l, PH_MIXFIN)) for (int rep_ = 0; rep_ < NREP(PH_MIXFIN); ++rep_) { FRESH();
#ifdef RWKV_DEBUG
            { const float* R0 = (const float*)(ws + WS_RY); const float* R1 = (const float*)(ws + WS3_RYALT); unsigned* flag = (unsigned*)(ws + WS_CTL) + CW_DBG;
              for (int row = gw; row < 2 * MT; row += NGW) { const int dirr = row / MT, rr_ = row % MT;
                  if (!(DBG_ROW_OK(dirr, rr_))) continue;
                  float mr = 0.f, md = 0.f; bool bad = false;
                  for (int i = 0; i < 10; ++i) { const size_t o = (size_t)row * 640 + i * 64 + lane; const float x0 = R0[o], x1 = R1[o]; mr = fmaxf(mr, fabsf(x0)); md = fmaxf(md, fabsf(x0 - x1)); if (!(fabsf(x1) < 1e30f)) bad = true; }
                  for (int o = 1; o < 64; o <<= 1) { mr = fmaxf(mr, __shfl_xor(mr, o)); md = fmaxf(md, __shfl_xor(md, o)); }
                  if (__any(bad)) { if (lane == 0) atomicOr(flag, 2u); }
                  else if (md > DBG_TOL * (mr + 1e-3f)) { if (lane == 0) atomicOr(flag, dirr == 1 ? 8u : (rr_ < 64 ? 1u : 4u)); } } }
#endif
            mixfin_phase(a, l, gw, NGW, lane); SEAM(); }

        if (RUN(l, PH_OUTPROJ)) {
            FRESH();
            if (l == DEPTH - 1) {
                pg8::Gemm g{(const pg8::bf16_t*)(ws + WS_MIX) + (size_t)CTX * DM, (const pg8::bf16_t*)(ws + WS_WOUT + l * SZ_WOUT), SEQ, DM, DM}; pg8::StaticOrder S; S.init(SEQ, DM, G, bid);
                EpiResid E{xl_in, xc_in, xl_out, xc_out, modl + 2 * DM, modl + 12288 + 2 * DM, 1, nullptr};
                pg8::gemm_phase<EpiResid, pg8::StaticOrder, true, true>(lds, g, S, E, wave_s);
            } else {
                pg8::Gemm g{(const pg8::bf16_t*)(ws + WS_MIX), (const pg8::bf16_t*)(ws + WS_WOUT + l * SZ_WOUT), MT, DM, DM}; SplitOrder S; S.init(SEQ, DM, G, bid, KS_OUT, (DM / 64) / KS_OUT);
                EpiResid E{xl_in, xc_in, xl_out, xc_out, modl + 2 * DM, modl + 12288 + 2 * DM, 0, (float*)(ws + WS3_SLAB)};
                pg8::gemm_phase<EpiResid, SplitOrder, true, true>(lds, g, S, E, wave_s);
            }
            SEAM();
        }

        if (RUN(l, PH_NORM2)) for (int rep_ = 0; rep_ < NREP(PH_NORM2); ++rep_) { FRESH(); norm_phase(xl_out, xc_in, a.in[LIDX(I_N2G)] + l * DM, modl, 3, H, gw, NGW, lane, l < DEPTH - 1 ? KS_OUT : 0, (const float*)(ws + WS3_SLAB), modl + 12288 + 2 * DM, xc_out, lds, wave, bid, G); SEAM(); }

        if (RUN(l, PH_FFN1)) for (int rep_ = 0; rep_ < NREP(PH_FFN1); ++rep_) {
            FRESH();
            const int skip = (l == DEPTH - 1) ? 1 : 0;
            pg8::Gemm g{(const pg8::bf16_t*)H + (size_t)skip * CTX * DM, (const pg8::bf16_t*)(ws + WS_WF1 + l * SZ_WF1), MT - skip * CTX, 2 * DFF, DM}; pg8::StaticOrder S; S.init(MT - skip * CTX, 2 * DFF, G, bid);
            EpiSwiglu E{(bf16*)(ws + WS_G) + (size_t)skip * CTX * DFF};
            pg8::gemm_phase<EpiSwiglu, pg8::StaticOrder, true, true>(lds, g, S, E, wave_s);
            if (l + 1 < DEPTH) {
                const int nun_ = (MT / 256) * (2 * DFF / 256), rounds_ = (nun_ + G - 1) / G; int first_idle = nun_ - (rounds_ - 1) * G; if (first_idle >= G) first_idle = 0;
                if (bid >= first_idle) mod_tasks(a, l + 1, 13, (bid - first_idle) * NWAVES + wave, (G - first_idle) * NWAVES, lane); }
            SEAM();
        }

        if (RUN(l, PH_FFN2)) {
            FRESH();
            if (l + 1 < DEPTH) { mod_reduce(a, l + 1, 13, bid, G, tid); FRESH(); }
            if (l == DEPTH - 1) {
                pg8::Gemm g{(const pg8::bf16_t*)(ws + WS_G) + (size_t)CTX * DFF, (const pg8::bf16_t*)(ws + WS_WF2 + l * SZ_WF2), SEQ, DM, DFF}; pg8::StaticOrder S; S.init(SEQ, DM, G, bid);
                EpiResid E{xl_out, xc_out, xl_out, xc_out, modl + 5 * DM, modl + 12288 + 5 * DM, 1, nullptr};
                pg8::gemm_phase<EpiResid, pg8::StaticOrder, true, true>(lds, g, S, E, wave_s);
            } else {
                pg8::Gemm g{(const pg8::bf16_t*)(ws + WS_G), (const pg8::bf16_t*)(ws + WS_WF2 + l * SZ_WF2), MT, DM, DFF}; SplitOrder S; S.init(SEQ, DM, G, bid, KS_F2, (DFF / 64) / KS_F2);
                EpiResid E{xl_out, xc_out, xl_out, xc_out, modl + 5 * DM, modl + 12288 + 5 * DM, 0, (float*)(ws + WS3_SLAB)};
                pg8::gemm_phase<EpiResid, SplitOrder, true, true>(lds, g, S, E, wave_s);
            }
            SEAM();
        }
    }
#ifdef RWKV_DEBUG
    if (a.phase == 99) { FRESH(); const unsigned f = __hip_atomic_load((unsigned*)(ws + WS_CTL) + CW_DBG, __ATOMIC_RELAXED, __HIP_MEMORY_SCOPE_AGENT);
      if (f & DBG_POISON_MASK) { for (size_t i = (size_t)bid * NTHR + tid; i < (size_t)SEQ * DM; i += (size_t)G * NTHR) a.out[i] = 1e30f * (float)(1u + f); } }
#endif
#undef RUN
#undef SEAM
#undef xl_in
#undef xc_in
#undef xl_out
#undef xc_out
#undef modl
#undef H
}

#ifdef RWKV_DEBUG
__global__ void __launch_bounds__(NTHR, 2) dbg_naive_kernel(Args a) {
    extern __shared__ __attribute__((aligned(16))) unsigned char lds_raw[];
    LAS unsigned char* lds = (LAS unsigned char*)lds_raw;
    const int tid = threadIdx.x, lane = tid & 63, wave = __builtin_amdgcn_readfirstlane(tid >> 6), bid = blockIdx.x;
    if (bid < 20) rwkv_scan_task(a, bid >> 1, bid & 1, lds, tid, lane, wave);
}
#endif
extern "C" void kernel_launch(void* const* d_in, const int* in_sizes, int n_in, void* d_out, int out_size, void* d_ws, size_t ws_size, hipStream_t stream) {
    static int grid = 0;
    if (grid == 0) {
        if (n_in != 33 || out_size != SEQ * DM || ws_size < WS3_RYALT) { fprintf(stderr, "kernel_launch: unexpected shapes: n_in %d out %d ws %zu (need %zu)\n", n_in, out_size, ws_size, (size_t)WS3_RYALT); grid = -1; return; }
        int dev = 0, cus = 0, per_cu = 0;
        if (hipGetDevice(&dev) != hipSuccess || hipDeviceGetAttribute(&cus, hipDeviceAttributeMultiprocessorCount, dev) != hipSuccess) { grid = -1; return; }
#ifdef RWKV_DEBUG
        (void)hipFuncSetAttribute((const void*)dbg_naive_kernel, hipFuncAttributeMaxDynamicSharedMemorySize, LDS_BYTES);
#endif
#if MK_SINGLE
        if (hipFuncSetAttribute((const void*)fwd_kernel<KM_ALL>, hipFuncAttributeMaxDynamicSharedMemorySize, LDS_BYTES) != hipSuccess) { fprintf(stderr, "kernel_launch: hipFuncSetAttribute failed\n"); grid = -1; return; }
        if (hipOccupancyMaxActiveBlocksPerMultiprocessor(&per_cu, (const void*)fwd_kernel<KM_ALL>, NTHR, LDS_BYTES) != hipSuccess || per_cu < 1) { fprintf(stderr, "kernel_launch: occupancy query says %d\n", per_cu); }
#else
        (void)hipFuncSetAttribute((const void*)fwd_kernel<KM_GEMM>, hipFuncAttributeMaxDynamicSharedMemorySize, LDS_BYTES); (void)hipFuncSetAttribute((const void*)fwd_kernel<KM_REST>, hipFuncAttributeMaxDynamicSharedMemorySize, LDS_BYTES); (void)per_cu;
#endif
        (void)hipGetLastError();
        grid = cus;
    }
    if (grid < 0) return;
    (void)hipMemsetAsync((char*)d_ws + WS_CTL, 0, CTL_ZERO_BYTES, stream);
    Args a{};
    for (int i = 0; i < 33; ++i) a.in[i] = (const float*)d_in[i];
    a.out = (float*)d_out; a.ws = (unsigned char*)d_ws;
#if MK_SINGLE
    a.single = 1; a.layer = 0; a.phase = 0;
    hipLaunchKernelGGL(fwd_kernel<KM_ALL>, dim3(grid), dim3(NTHR), LDS_BYTES, stream, a);
#else
    a.single = 0;
    a.layer = 0; a.phase = PH_PRE; hipLaunchKernelGGL(fwd_kernel<KM_REST>, dim3(grid), dim3(NTHR), LDS_BYTES, stream, a);
    for (int l = 0; l < DEPTH; ++l)
        for (int k = PH_NORM1; k < PH_COUNT; ++k) { a.layer = l; a.phase = k; if ((KM_GEMM >> k) & 1u) hipLaunchKernelGGL(fwd_kernel<KM_GEMM>, dim3(grid), dim3(NTHR), LDS_BYTES, stream, a); else hipLaunchKernelGGL(fwd_kernel<KM_REST>, dim3(grid), dim3(NTHR), LDS_BYTES, stream, a);
#ifdef RWKV_DEBUG
            if (k == PH_SCAN_B) hipLaunchKernelGGL(dbg_naive_kernel, dim3(20), dim3(NTHR), LDS_BYTES, stream, a);
#endif
        }
#ifdef RWKV_DEBUG
    a.layer = 99; a.phase = 99; hipLaunchKernelGGL(fwd_kernel<KM_REST>, dim3(grid), dim3(NTHR), LDS_BYTES, stream, a);
#endif
#endif
    const hipError_t le = hipPeekAtLastError();
    if (le != hipSuccess) fprintf(stderr, "kernel_launch: launch failed: %s\n", hipGetErrorName(le));
}
```

```cpp
#include <hip/hip_runtime.h>
#include <hip/hip_bf16.h>
#include <cstdio>
#include <cstdint>
#include <cmath>
__device__ __forceinline__ int lane_id_() { return (int)__builtin_amdgcn_mbcnt_hi(~0u, __builtin_amdgcn_mbcnt_lo(~0u, 0u)); }

namespace pg8 {
#define PG8_LAS __attribute__((address_space(3)))
typedef unsigned short bf16_t;
typedef short bf16x8 __attribute__((ext_vector_type(8)));
typedef float f32x4 __attribute__((ext_vector_type(4)));
typedef unsigned u32x4 __attribute__((ext_vector_type(4)));
constexpr int BM = 256, BK = 64, HALF = 128, HTB = HALF * BK * 2  , STAGE_BYTES = 8 * HTB, NXCD = 8, WGM = 8;

__host__ __device__ __forceinline__ int lds_byte(int r, int c) { const int st = (r >> 4) * 2 + (c >> 5), rr = r & 15, cc = c & 31, ob = rr * 64 + cc * 2; return st * 1024 + (ob ^ (((ob >> 9) & 1) << 5)); }
__host__ __device__ __forceinline__ void stage_rc(int b, int& R, int& C) { const int st = b / 1024, sb = b % 1024, swz = sb ^ (((sb >> 9) & 1) << 5); R = (st >> 1) * 16 + swz / 64; C = (st & 1) * 32 + (swz % 64) / 2; }
__host__ __device__ __forceinline__ int perm32(int rho) { const int n = rho >> 4, i = rho & 15; return 8 * (i >> 2) + 4 * n + (i & 3); }

struct Unit { int pm, pn, k0, nt, kp; };
struct Gemm { const bf16_t* A; const bf16_t* Bt; int M, N, K; };

struct StaticOrder {
    int nM, nN, nwg, G, c;
    __host__ __device__ void init(int M, int N, int G_, int c_) { nM = M / BM; nN = N / BM; nwg = nM * nN; G = G_; c = c_; }
    __host__ __device__ bool next(int i, Unit& u) const {
        const long L = (long)i * G + c; if (L >= nwg) return false;
        int wgid = (int)L; { const int q = nwg / NXCD, r = nwg % NXCD, xcd = wgid % NXCD, off = wgid / NXCD; wgid = (xcd < r ? xcd * (q + 1) : r * (q + 1) + (xcd - r) * q) + off; }
        const int nig = WGM * nN, gid = wgid / nig, fm = gid * WGM, gsz = (nM - fm) < WGM ? (nM - fm) : WGM;
        u.pm = fm + ((wgid % nig) % gsz); u.pn = (wgid % nig) / gsz; u.k0 = 0; u.nt = 0; u.kp = -1; return true;
    }
    __device__ __forceinline__ void a_ready(const Unit&) const {}
    __device__ __forceinline__ void done(const Unit&) const {}
};

__device__ __forceinline__ unsigned cvt_pk_bf16(float lo, float hi) { unsigned r; asm volatile("v_cvt_pk_bf16_f32 %0, %1, %2" : "=v"(r) : "v"(lo), "v"(hi)); return r; }
typedef float f32x2 __attribute__((ext_vector_type(2)));
__device__ __forceinline__ f32x2 gelu_pk(f32x2 v) {
    const f32x2 av = __builtin_elementwise_abs(v), d = av * 0.2316418882f + 1.0f;
    f32x2 t; t.x = __builtin_amdgcn_rcpf(d.x); t.y = __builtin_amdgcn_rcpf(d.y);
    f32x2 q = t * 0.5307027145f + (-0.7265760135f); q = q * t + 0.7107068705f; q = q * t + (-0.142248368f); q = q * t + 0.127414796f; q = q * t;
    const f32x2 s = (v * v) * (-0.72134752044f);
    f32x2 e; e.x = __builtin_amdgcn_exp2f(s.x); e.y = __builtin_amdgcn_exp2f(s.y);
    const f32x2 m = v * (q * e), r = v - m;
    f32x2 o; o.x = v.x < 0.f ? m.x : r.x; o.y = v.y < 0.f ? m.y : r.y; return o;
}

template <int ACT  > struct EpiBf16 {
    static constexpr bool PERM = true, AFTER_DRAIN = false; static_assert(ACT == 0 || ACT == 1, "EpiBf16: ACT is 0 (none) or 1 (gelu_pk)");
    bf16_t* O; int ldc; const float* bias; int split_cols; size_t split_stride; float scale0;
    __device__ __forceinline__ void operator()(const f32x4 (&acc)[2][2][4][2], const Unit& u, int wr, int wc, int fr, int fq) const {
        const int row0 = u.pm * BM + wr * 64 + fr; int colt = u.pn * BM; bf16_t* base = O;
        float sc = 1.f; if (split_cols) { const int t = colt / split_cols; base += (size_t)t * split_stride; colt -= t * split_cols; if (t == 0) sc = scale0; }
        const int col0 = colt + wc * 32 + 8 * fq, bcol0 = u.pn * BM + wc * 32 + 8 * fq;
        f32x4 bv[2][2];
#pragma unroll
        for (int bj = 0; bj < 2; ++bj)
#pragma unroll
            for (int n = 0; n < 2; ++n) bv[bj][n] = bias ? *(const f32x4*)(bias + bcol0 + bj * HALF + 4 * n) : (f32x4){0.f, 0.f, 0.f, 0.f};
#pragma unroll
        for (int ai = 0; ai < 2; ++ai)
#pragma unroll
            for (int m = 0; m < 4; ++m) { bf16_t* rowp = base + (size_t)(row0 + ai * HALF + m * 16) * ldc + col0;
#pragma unroll
                for (int bj = 0; bj < 2; ++bj) { f32x4 v0 = acc[ai][bj][m][0] + bv[bj][0], v1 = acc[ai][bj][m][1] + bv[bj][1];
                    if (ACT == 1) { f32x2 a = gelu_pk((f32x2){v0[0], v0[1]}), b = gelu_pk((f32x2){v0[2], v0[3]}), c = gelu_pk((f32x2){v1[0], v1[1]}), d = gelu_pk((f32x2){v1[2], v1[3]});
                        v0 = (f32x4){a.x, a.y, b.x, b.y}; v1 = (f32x4){c.x, c.y, d.x, d.y}; }
                    v0 = v0 * sc; v1 = v1 * sc; u32x4 w; w.x = cvt_pk_bf16(v0[0], v0[1]); w.y = cvt_pk_bf16(v0[2], v0[3]); w.z = cvt_pk_bf16(v1[0], v1[1]); w.w = cvt_pk_bf16(v1[2], v1[3]);
                    *(u32x4*)(rowp + bj * HALF) = w; } }
    }
};

struct PanelStats {
    unsigned* xbuf;
    unsigned* cnt;
    unsigned* tmo;
    int ntn; float eps;
    unsigned code;
    __device__ __forceinline__ bool run(const f32x4 (&v)[2][2][4][2], const Unit& u, int wr, int wc, int fr, int fq, PG8_LAS unsigned char* lds, int wid, int lane) const {
        typedef float f32x2v __attribute__((ext_vector_type(2)));
        PG8_LAS f32x2v* P = (PG8_LAS f32x2v*)lds;
        PG8_LAS f32x2v* S = (PG8_LAS f32x2v*)(lds + 8192);
        PG8_LAS unsigned* flag = (PG8_LAS unsigned*)(lds + 8192 + 2048);
#pragma unroll
        for (int ai = 0; ai < 2; ++ai)
#pragma unroll
            for (int m = 0; m < 4; ++m) {
                float s = 0.f;
#pragma unroll
                for (int bj = 0; bj < 2; ++bj)
#pragma unroll
                    for (int n = 0; n < 2; ++n) { const f32x4 x = v[ai][bj][m][n]; s += (x[0] + x[1]) + (x[2] + x[3]); }
                s += __shfl_xor(s, 16); s += __shfl_xor(s, 32);
                const float mw = s * (1.0f / 64.0f); float q = 0.f;
#pragma unroll
                for (int bj = 0; bj < 2; ++bj)
#pragma unroll
                    for (int n = 0; n < 2; ++n) { const f32x4 d = v[ai][bj][m][n] - mw; q += (d[0] * d[0] + d[1] * d[1]) + (d[2] * d[2] + d[3] * d[3]); }
                q += __shfl_xor(q, 16); q += __shfl_xor(q, 32);
                if (fq == 0) P[(ai * HALF + wr * 64 + m * 16 + fr) * 4 + wc] = (f32x2v){mw, q};
            }
        asm volatile("s_waitcnt lgkmcnt(0)" ::: "memory"); __builtin_amdgcn_s_barrier(); asm volatile("" ::: "memory");
#if defined(BROKEN_EXCHANGE_NO_WAIT)
#warning BROKEN CONTROL BUILD: the row-statistics exchange does not wait; results are wrong by design
        if (blockIdx.x >= 64) { const long long t0_ = clock64(); while (clock64() - t0_ < 60000) __builtin_amdgcn_s_sleep(8); }
#endif
        const int row = wid * 32 + (lane & 31);
        if (lane < 32) {
            const f32x2v a = P[row * 4 + 0], b = P[row * 4 + 1], c = P[row * 4 + 2], d = P[row * 4 + 3];
            const float mt = (a.x + b.x + c.x + d.x) * 0.25f;
            const float da = a.x - mt, db = b.x - mt, dc = c.x - mt, dd = d.x - mt;
            const float m2 = (a.y + b.y) + (c.y + d.y) + 64.0f * ((da * da + db * db) + (dc * dc + dd * dd));
            unsigned long long* slot = (unsigned long long*)xbuf + ((size_t)(u.pm * BM + row) * 4 + u.pn);
            __hip_atomic_store(slot, ((unsigned long long)__float_as_uint(m2) << 32) | __float_as_uint(mt), __ATOMIC_RELAXED, __HIP_MEMORY_SCOPE_AGENT);
        }
        asm volatile("s_waitcnt vmcnt(0)" ::: "memory");
        if (lane == 0) __hip_atomic_fetch_add(cnt + 64 * u.pm, 1u, __ATOMIC_RELAXED, __HIP_MEMORY_SCOPE_AGENT);
        if (wid == 0) {
            bool dead = false; const unsigned long long t0 = __builtin_amdgcn_s_memrealtime(); const unsigned want = 8u * (unsigned)ntn;
            for (;;) {
#if defined(BROKEN_EXCHANGE_NO_WAIT)
                break;
#endif
                if ((unsigned)__builtin_amdgcn_readfirstlane(__hip_atomic_load(cnt + 64 * u.pm, __ATOMIC_RELAXED, __HIP_MEMORY_SCOPE_AGENT)) >= want) break;
                if (__builtin_amdgcn_s_memrealtime() - t0 > 2000000ull) {
                    if (lane == 0) { unsigned expect = 0u; __hip_atomic_compare_exchange_strong(tmo + 1, &expect, code | (unsigned)(u.pm & 0xff), __ATOMIC_RELAXED, __ATOMIC_RELAXED, __HIP_MEMORY_SCOPE_AGENT);
                                     __hip_atomic_store(tmo, 1u, __ATOMIC_RELAXED, __HIP_MEMORY_SCOPE_AGENT); }
                    dead = true; break; }
                __builtin_amdgcn_s_sleep(2);
            }
            __builtin_amdgcn_fence(__ATOMIC_ACQUIRE, "agent");
            if (lane == 0) flag[0] = dead ? 1u : 0u;
        }
        asm volatile("s_waitcnt vmcnt(0) lgkmcnt(0)" ::: "memory"); __builtin_amdgcn_s_barrier(); asm volatile("" ::: "memory");
        const bool bad = flag[0] != 0u;
        if (lane < 32) {
            const unsigned long long* slot = (const unsigned long long*)xbuf + (size_t)(u.pm * BM + row) * 4; float mt[4], m2[4]; float ms = 0.f;
#pragma unroll
            for (int t = 0; t < 4; ++t) { if (t < ntn) { const unsigned long long w = __hip_atomic_load(slot + t, __ATOMIC_RELAXED, __HIP_MEMORY_SCOPE_AGENT); mt[t] = __uint_as_float((unsigned)w); m2[t] = __uint_as_float((unsigned)(w >> 32)); } else { mt[t] = 0.f; m2[t] = 0.f; } ms += mt[t]; }
            const float mean = ms / (float)ntn; float q = 0.f;
#pragma unroll
            for (int t = 0; t < 4; ++t) if (t < ntn) { const float dm = mt[t] - mean; q += m2[t] + 256.0f * dm * dm; }
            S[row] = (f32x2v){mean, 1.0f / sqrtf(q / (256.0f * (float)ntn) + eps)};
        }
        asm volatile("s_waitcnt lgkmcnt(0)" ::: "memory"); __builtin_amdgcn_s_barrier(); asm volatile("" ::: "memory");
        return bad;
    }
};
struct EpiLnRes {
    static constexpr bool PERM = false, AFTER_DRAIN = true;
    const float* base; float* out; int ldc; const float* bias; PanelStats st; unsigned poison;
    __device__ __forceinline__ void fused(f32x4 (&acc)[2][2][4][2], const Unit& u, int wr, int wc, int fr, int fq, PG8_LAS unsigned char* lds, int wid, int lane) const {
        typedef float f32x2v __attribute__((ext_vector_type(2)));
        const PG8_LAS f32x2v* S = (const PG8_LAS f32x2v*)(lds + 8192);
        const int col0 = u.pn * BM + wc * 32 + 4 * fq;
#pragma unroll
        for (int bj = 0; bj < 2; ++bj)
#pragma unroll
            for (int n = 0; n < 2; ++n) { const f32x4 bv = bias ? *(const f32x4*)(bias + col0 + bj * HALF + n * 16) : (f32x4){0.f, 0.f, 0.f, 0.f};
#pragma unroll
                for (int ai = 0; ai < 2; ++ai)
#pragma unroll
                    for (int m = 0; m < 4; ++m) acc[ai][bj][m][n] += bv; }
        f32x4 pre[4][2][2];
#pragma unroll
        for (int m = 0; m < 4; ++m) { const size_t off = (size_t)(u.pm * BM + wr * 64 + m * 16 + fr) * ldc + col0;
#pragma unroll
            for (int bj = 0; bj < 2; ++bj)
#pragma unroll
                for (int n = 0; n < 2; ++n) pre[m][bj][n] = *(const f32x4*)(base + off + bj * HALF + n * 16); }
        const bool bad = st.run(acc, u, wr, wc, fr, fq, lds, wid, lane) || poison != 0u;
        const float qnan = __builtin_nanf("");
#pragma unroll
        for (int ai = 0; ai < 2; ++ai)
#pragma unroll
            for (int m = 0; m < 4; ++m) { const int r = ai * HALF + wr * 64 + m * 16 + fr; const f32x2v sr = S[r]; const size_t off = (size_t)(u.pm * BM + r) * ldc + col0;
#pragma unroll
                for (int bj = 0; bj < 2; ++bj)
#pragma unroll
                    for (int n = 0; n < 2; ++n) { const f32x4 bs = ai == 0 ? pre[m][bj][n] : *(const f32x4*)(base + off + bj * HALF + n * 16); f32x4 o = bs + (acc[ai][bj][m][n] - sr.x) * sr.y;
                        if (bad) o = (f32x4){qnan, qnan, qnan, qnan}; *(f32x4*)(out + off + bj * HALF + n * 16) = o; }
                if (m & 1) asm volatile("" ::: "memory"); }
    }
};
struct EpiLnResLn {
    static constexpr bool PERM = false, AFTER_DRAIN = true;
    const float* base; float* out; bf16_t* xn; int ldc; const float* bias; PanelStats st1, st2; unsigned poison;
    __device__ __forceinline__ void fused(f32x4 (&acc)[2][2][4][2], const Unit& u, int wr, int wc, int fr, int fq, PG8_LAS unsigned char* lds, int wid, int lane) const {
        typedef float f32x2v __attribute__((ext_vector_type(2))); typedef unsigned u32x2v __attribute__((ext_vector_type(2)));
        const PG8_LAS f32x2v* S = (const PG8_LAS f32x2v*)(lds + 8192);
        const int col0 = u.pn * BM + wc * 32 + 4 * fq;
#pragma unroll
        for (int bj = 0; bj < 2; ++bj)
#pragma unroll
            for (int n = 0; n < 2; ++n) { const f32x4 bv = bias ? *(const f32x4*)(bias + col0 + bj * HALF + n * 16) : (f32x4){0.f, 0.f, 0.f, 0.f};
#pragma unroll
                for (int ai = 0; ai < 2; ++ai)
#pragma unroll
                    for (int m = 0; m < 4; ++m) acc[ai][bj][m][n] += bv; }
        bool bad = st1.run(acc, u, wr, wc, fr, fq, lds, wid, lane) || poison != 0u;
        const float qnan = __builtin_nanf("");
#pragma unroll
        for (int ai = 0; ai < 2; ++ai)
#pragma unroll
            for (int m = 0; m < 4; ++m) { const int r = ai * HALF + wr * 64 + m * 16 + fr; const f32x2v sr = S[r]; const size_t off = (size_t)(u.pm * BM + r) * ldc + col0;
#pragma unroll
                for (int bj = 0; bj < 2; ++bj)
#pragma unroll
                    for (int n = 0; n < 2; ++n) { const f32x4 bs = *(const f32x4*)(base + off + bj * HALF + n * 16); acc[ai][bj][m][n] = bs + (acc[ai][bj][m][n] - sr.x) * sr.y; }
                asm volatile("" : "+v"(acc[ai][0][m][0]), "+v"(acc[ai][0][m][1]), "+v"(acc[ai][1][m][0]), "+v"(acc[ai][1][m][1]));
                if (m & 1) asm volatile("" ::: "memory"); }
        const bool bad1 = bad;
        bad = st2.run(acc, u, wr, wc, fr, fq, lds, wid, lane) || bad;
#pragma unroll
        for (int ai = 0; ai < 2; ++ai)
#pragma unroll
            for (int m = 0; m < 4; ++m) { const int r = ai * HALF + wr * 64 + m * 16 + fr; const f32x2v sr = S[r]; const size_t off = (size_t)(u.pm * BM + r) * ldc + col0;
#pragma unroll
                for (int bj = 0; bj < 2; ++bj)
#pragma unroll
                    for (int n = 0; n < 2; ++n) { const f32x4 x1 = acc[ai][bj][m][n]; *(f32x4*)(out + off + bj * HALF + n * 16) = bad1 ? (f32x4){qnan, qnan, qnan, qnan} : x1;
                        const f32x4 o = (x1 - sr.x) * sr.y; u32x2v w; w.x = cvt_pk_bf16(o[0], o[1]); w.y = cvt_pk_bf16(o[2], o[3]);
                        if (bad) { w.x = 0x7fc07fc0u; w.y = 0x7fc07fc0u; } *(u32x2v*)(xn + off + bj * HALF + n * 16) = w; }
                asm volatile("" ::: "memory"); }
    }
};

template <class Epi, class Sched, bool ALIGN_EPI = false, bool SP2 = false>
__device__ __forceinline__ void gemm_phase(PG8_LAS unsigned char* lds, const Gemm g, const Sched& S, const Epi& E, int wave_s) {
    int tid_l = wave_s * 64 + lane_id_(); asm volatile("" : "+v"(tid_l));
    const int tid = tid_l, wid = __builtin_amdgcn_readfirstlane(tid >> 6), lane = tid & 63, wr = wid >> 2, wc = wid & 3, fr = lane & 15, fq = lane >> 4;
    const int K = g.K, nt = K / BK;
    unsigned voffA[2], voffB[2];
#pragma unroll
    for (int i = 0; i < 2; ++i) { int R, C; stage_rc(tid * 16 + i * 8192, R, C); const int Rb = Epi::PERM ? ((R & ~31) + perm32(R & 31)) : R;
        voffA[i] = (unsigned)(R * K + C) * 2u; voffB[i] = (unsigned)(Rb * K + C) * 2u; }
    const size_t kstep = (size_t)(BK * 2);
    const size_t hstep = (size_t)HALF * K * 2;
    const size_t tstep = 2 * hstep;
    const unsigned ldsw = (unsigned)wid * 1024u;
    const int aoff = lds_byte(wr * 64 + fr, fq * 8), boff = lds_byte(wc * 32 + fr, fq * 8);
#define PG8_SA(b, h) (((b) * 2 + (h)) * HTB)
#define PG8_SB(b, h) ((4 + (b) * 2 + (h)) * HTB)
#define PG8_STAGE(bufoff, gbase, voff) do { _Pragma("unroll") for (int _i = 0; _i < 2; ++_i) \
        __builtin_amdgcn_global_load_lds((const unsigned*)((const char*)(gbase) + (voff)[_i]), (PG8_LAS unsigned*)(lds + (bufoff) + ldsw + _i * 8192), 16, 0, 0); } while (0)
#define PG8_LDA(dst, b, h) do { _Pragma("unroll") for (int m = 0; m < 4; ++m) _Pragma("unroll") for (int k = 0; k < 2; ++k) dst[m][k] = *(const PG8_LAS bf16x8*)(lds + PG8_SA(b, h) + aoff + m * 2048 + k * 1024); } while (0)
#define PG8_LDB(dst, b, h) do { _Pragma("unroll") for (int n = 0; n < 2; ++n) _Pragma("unroll") for (int k = 0; k < 2; ++k) dst[n][k] = *(const PG8_LAS bf16x8*)(lds + PG8_SB(b, h) + boff + n * 2048 + k * 1024); } while (0)
#define PG8_MMA(ai, bj, At, Bt) do { __builtin_amdgcn_s_setprio(1); _Pragma("unroll") for (int m = 0; m < 4; ++m) _Pragma("unroll") for (int n = 0; n < 2; ++n) _Pragma("unroll") for (int k = 0; k < 2; ++k) \
        acc[ai][bj][m][n] = __builtin_amdgcn_mfma_f32_16x16x32_bf16(Bt[n][k], At[m][k], acc[ai][bj][m][n], 0, 0, 0); __builtin_amdgcn_s_setprio(0); } while (0)
#define PG8_WAIT_V(n) asm volatile("s_waitcnt vmcnt(" #n ")" ::: "memory")
#define PG8_WAIT_L(n) asm volatile("s_waitcnt lgkmcnt(" #n ")" ::: "memory")
#define PG8_BAR __builtin_amdgcn_s_barrier()
#define PG8_SCHED __builtin_amdgcn_sched_barrier(0)
    Unit cur, nxt; int ui = 0;
    if (!S.next(0, cur)) return;
    f32x4 acc[2][2][4][2];
#pragma unroll
    for (int a = 0; a < 2; ++a)
#pragma unroll
        for (int b = 0; b < 2; ++b)
#pragma unroll
            for (int m = 0; m < 4; ++m)
#pragma unroll
                for (int n = 0; n < 2; ++n) acc[a][b][m][n] = (f32x4){0.f, 0.f, 0.f, 0.f};
    bf16x8 At[4][2], B0[2][2], B1[2][2];
    const char* cA = (const char*)g.A + (size_t)cur.pm * tstep + (size_t)cur.k0 * kstep; const char* cB = (const char*)g.Bt + (size_t)cur.pn * tstep + (size_t)cur.k0 * kstep;
    int cnt = cur.nt ? cur.nt : nt;
    S.a_ready(cur);
    if constexpr (SP2) {
        PG8_STAGE(PG8_SB(0, 0), cB, voffB); PG8_STAGE(PG8_SB(0, 1), cB + hstep, voffB); PG8_STAGE(PG8_SA(0, 0), cA, voffA); PG8_STAGE(PG8_SA(0, 1), cA + hstep, voffA);
        if (wr == 1) PG8_BAR;
        PG8_WAIT_V(2); PG8_BAR;
        PG8_STAGE(PG8_SB(1, 0), cB + kstep, voffB); PG8_STAGE(PG8_SA(1, 0), cA + kstep, voffA); PG8_STAGE(PG8_SB(1, 1), cB + hstep + kstep, voffB);
        PG8_WAIT_V(6); PG8_BAR;
    } else {
        PG8_STAGE(PG8_SB(0, 0), cB, voffB); PG8_STAGE(PG8_SA(0, 0), cA, voffA); PG8_STAGE(PG8_SB(0, 1), cB + hstep, voffB); PG8_STAGE(PG8_SA(0, 1), cA + hstep, voffA);
        if (wr == 1) PG8_BAR;
        PG8_WAIT_V(4); PG8_BAR;
        PG8_STAGE(PG8_SB(1, 0), cB + kstep, voffB); PG8_STAGE(PG8_SA(1, 0), cA + kstep, voffA); PG8_STAGE(PG8_SB(1, 1), cB + hstep + kstep, voffB);
        PG8_WAIT_V(6); PG8_BAR;
    }
    for (;;) {
        const bool has_next = S.next(ui + 1, nxt);
        const char* nA = has_next ? (const char*)g.A + (size_t)nxt.pm * tstep + (size_t)nxt.k0 * kstep : cA; const char* nB = has_next ? (const char*)g.Bt + (size_t)nxt.pn * tstep + (size_t)nxt.k0 * kstep : cB;
        for (int t = 0; t < cnt; t += 2) {
            const bool last = (t == cnt - 2);
            const char* a1 = cA + (size_t)(t + 1) * kstep;
            const char* a2 = last ? nA : cA + (size_t)(t + 2) * kstep; const char* b2 = last ? nB : cB + (size_t)(t + 2) * kstep;
            const char* a3 = a2 + kstep; const char* b3 = b2 + kstep;
            if (last && has_next) S.a_ready(nxt);
            if constexpr (SP2) {
            PG8_LDB(B0, 0, 0); PG8_LDB(B1, 0, 1); PG8_SCHED; PG8_LDA(At, 0, 0); PG8_STAGE(PG8_SA(1, 1), a1 + hstep, voffA);
            PG8_WAIT_V(8); PG8_WAIT_L(0); PG8_BAR; PG8_MMA(0, 0, At, B0); PG8_MMA(0, 1, At, B1); PG8_BAR; PG8_SCHED;
            PG8_LDA(At, 0, 1); PG8_STAGE(PG8_SB(0, 0), b2, voffB); PG8_STAGE(PG8_SB(0, 1), b2 + hstep, voffB); PG8_STAGE(PG8_SA(0, 0), a2, voffA);
            PG8_WAIT_V(8); PG8_WAIT_L(0); PG8_BAR; PG8_MMA(1, 0, At, B0); PG8_MMA(1, 1, At, B1); PG8_BAR; PG8_SCHED;
            PG8_LDB(B0, 1, 0); PG8_LDB(B1, 1, 1); PG8_SCHED; PG8_LDA(At, 1, 0); PG8_STAGE(PG8_SA(0, 1), a2 + hstep, voffA);
            PG8_WAIT_V(8); PG8_WAIT_L(0); PG8_BAR; PG8_MMA(0, 0, At, B0); PG8_MMA(0, 1, At, B1); PG8_BAR; PG8_SCHED;
            PG8_LDA(At, 1, 1); PG8_STAGE(PG8_SB(1, 0), b3, voffB); PG8_STAGE(PG8_SB(1, 1), b3 + hstep, voffB); PG8_STAGE(PG8_SA(1, 0), a3, voffA);
            PG8_WAIT_V(8); PG8_WAIT_L(0); PG8_BAR; PG8_MMA(1, 0, At, B0); PG8_MMA(1, 1, At, B1); PG8_BAR; PG8_SCHED;
            } else {
            PG8_LDB(B0, 0, 0); PG8_SCHED; PG8_LDA(At, 0, 0); PG8_STAGE(PG8_SA(1, 1), a1 + hstep, voffA);
            PG8_WAIT_L(8); PG8_BAR; PG8_WAIT_L(0); PG8_MMA(0, 0, At, B0); PG8_BAR; PG8_SCHED;
            PG8_LDB(B1, 0, 1); PG8_STAGE(PG8_SB(0, 0), b2, voffB);
            PG8_BAR; PG8_WAIT_L(0); PG8_MMA(0, 1, At, B1); PG8_BAR;
            PG8_LDA(At, 0, 1); PG8_STAGE(PG8_SA(0, 0), a2, voffA);
            PG8_BAR; PG8_WAIT_L(0); PG8_MMA(1, 0, At, B0); PG8_BAR; PG8_SCHED;
            PG8_STAGE(PG8_SB(0, 1), b2 + hstep, voffB);
            PG8_WAIT_V(6); PG8_BAR; PG8_MMA(1, 1, At, B1); PG8_BAR;
            PG8_LDB(B0, 1, 0); PG8_SCHED; PG8_LDA(At, 1, 0); PG8_STAGE(PG8_SA(0, 1), a2 + hstep, voffA);
            PG8_WAIT_L(8); PG8_BAR; PG8_WAIT_L(0); PG8_MMA(0, 0, At, B0); PG8_BAR; PG8_SCHED;
            PG8_LDB(B1, 1, 1); PG8_STAGE(PG8_SB(1, 0), b3, voffB);
            PG8_BAR; PG8_WAIT_L(0); PG8_MMA(0, 1, At, B1); PG8_BAR;
            PG8_LDA(At, 1, 1); PG8_STAGE(PG8_SA(1, 0), a3, voffA);
            PG8_BAR; PG8_WAIT_L(0); PG8_MMA(1, 0, At, B0); PG8_BAR; PG8_SCHED;
            PG8_STAGE(PG8_SB(1, 1), b3 + hstep, voffB);
            PG8_WAIT_V(6); PG8_BAR; PG8_MMA(1, 1, At, B1); PG8_BAR;
            }
        }
        if constexpr (ALIGN_EPI) { if (wr == 0) PG8_BAR; }
        if constexpr (!Epi::AFTER_DRAIN) { E(acc, cur, wr, wc, fr, fq); S.done(cur); }
        if (!has_next) break;
#pragma unroll
        for (int a = 0; a < 2; ++a)
#pragma unroll
            for (int b = 0; b < 2; ++b)
#pragma unroll
                for (int m = 0; m < 4; ++m)
#pragma unroll
                    for (int n = 0; n < 2; ++n) acc[a][b][m][n] = (f32x4){0.f, 0.f, 0.f, 0.f};
        cur = nxt; cA = nA; cB = nB; ++ui; cnt = cur.nt ? cur.nt : nt;
        if constexpr (ALIGN_EPI) { if (wr == 1) PG8_BAR; }
    }
    PG8_WAIT_V(0);
    if constexpr (!ALIGN_EPI) { if (wr == 0) PG8_BAR; }
    PG8_BAR;
    if constexpr (Epi::AFTER_DRAIN) { E.fused(acc, cur, wr, wc, fr, fq, lds, wid, lane); S.done(cur); }
#undef PG8_SA
#undef PG8_SB
#undef PG8_STAGE
#undef PG8_LDA
#undef PG8_LDB
#undef PG8_MMA
#undef PG8_WAIT_V
#undef PG8_WAIT_L
#undef PG8_BAR
#undef PG8_SCHED
}
}
#define GAS __attribute__((address_space(1)))
#define LAS __attribute__((address_space(3)))
typedef unsigned short bf16;
typedef unsigned v4u __attribute__((ext_vector_type(4)));
typedef float f32x4 __attribute__((ext_vector_type(4)));
typedef short bf16x8 __attribute__((ext_vector_type(8)));
typedef GAS unsigned gu32;
typedef GAS unsigned long long gu64;
#define RLX_AGENT __ATOMIC_RELAXED, __HIP_MEMORY_SCOPE_AGENT
#define LDS_WAIT() asm volatile("s_waitcnt lgkmcnt(0)" ::: "memory")
#define VM_WAIT() asm volatile("s_waitcnt vmcnt(0)" ::: "memory")
__device__ __forceinline__ unsigned long long rt() { return __builtin_amdgcn_s_memrealtime(); }
__device__ __forceinline__ unsigned f2bf(float f) { unsigned u = __builtin_bit_cast(unsigned, f); return (u + 0x7fffu + ((u >> 16) & 1u)) >> 16; }
__device__ __forceinline__ unsigned pk2(float lo, float hi) { return f2bf(lo) | (f2bf(hi) << 16); }

#define XB_TMO      128
#define XB_XCNT(j)  (256  + 64 * (j))
#define XB_XSUB(j)  (1280 + 64 * (j))
#define XB_XGEN(j)  (2304 + 64 * (j))
#define XB_TOP      3328
#define XB_TOPGEN   3392
#define XCD_BAR_WORDS 3456
#define XB_SPIN_CAP (1u << 18)

__device__ __forceinline__ unsigned xb_ld(unsigned* p)              { return __hip_atomic_load(p, __ATOMIC_RELAXED, __HIP_MEMORY_SCOPE_AGENT); }
__device__ __forceinline__ unsigned xb_add(unsigned* p, unsigned v) { return __hip_atomic_fetch_add(p, v, __ATOMIC_RELAXED, __HIP_MEMORY_SCOPE_AGENT); }
__device__ __forceinline__ unsigned xb_xcc_id() { return (unsigned)__builtin_amdgcn_s_getreg((3 << 11) | 20) & 0xFu; }
#define XB_SPIN(cond, bar) do { unsigned _sp = 0; while (cond) { __builtin_amdgcn_s_sleep(1); \
    if ((++_sp & 255u) == 0u) { if (xb_ld(&(bar)[XB_TMO])) break; if (_sp > XB_SPIN_CAP) { atomicAdd(&(bar)[XB_TMO], 1u); break; } } } } while (0)

struct XcdBarrier {
    unsigned* bar; unsigned x;
    volatile LAS unsigned* st;
};

__device__ __forceinline__ XcdBarrier xcd_barrier_post(unsigned* bar, volatile LAS unsigned* st, bool t0) {
    XcdBarrier b; b.bar = bar; b.x = xb_xcc_id(); b.st = st;
    if (t0) (void)xb_add(&bar[XB_XCNT(b.x)], 1u);
    return b;
}
__device__ __forceinline__ void xcd_barrier_complete(unsigned* bar, unsigned x, unsigned& nloc, unsigned& nx) {
    const unsigned G = gridDim.x * gridDim.y * gridDim.z;
    unsigned sum, cnt, mine, sp = 0u;
    for (;;) {
        sum = 0u; cnt = 0u; mine = 0u;
#pragma unroll
        for (unsigned j = 0; j < 16; ++j) { const unsigned c = xb_ld(&bar[XB_XCNT(j)]); sum += c; cnt += (c > 0u) ? 1u : 0u; }
        mine = xb_ld(&bar[XB_XCNT(x)]);
        if (sum == G) break;
        __builtin_amdgcn_s_sleep(1);
        if ((++sp & 255u) == 0u) { if (xb_ld(&bar[XB_TMO])) break; if (sp > XB_SPIN_CAP) { atomicAdd(&bar[XB_TMO], 1u); break; } }
    }
    nloc = mine > 0u ? mine : 1u; nx = cnt > 0u ? cnt : 1u;
}

__device__ __forceinline__ void xcd_barrier(const XcdBarrier& b, bool t0) {
    asm volatile("s_waitcnt vmcnt(0)" ::: "memory");
    __syncthreads();
    if (t0) {
        unsigned* bar = b.bar;
        __builtin_amdgcn_s_waitcnt(0);
        unsigned nloc = b.st[0], nx = b.st[1];
        if (nloc == 0u) { xcd_barrier_complete(bar, b.x, nloc, nx); b.st[0] = nloc; b.st[1] = nx; }
        const unsigned old = xb_add(&bar[XB_XSUB(b.x)], 1u);
        const unsigned gen = old / nloc;
        if (old + 1u == (gen + 1u) * nloc) {
            __builtin_amdgcn_fence(__ATOMIC_RELEASE, "agent");
            asm volatile("s_waitcnt vmcnt(0)" ::: "memory");
            const unsigned og = xb_add(&bar[XB_TOP], 1u);
            const unsigned tg = og / nx;
            if (og + 1u == (tg + 1u) * nx) xb_add(&bar[XB_TOPGEN], 1u);
            else XB_SPIN(xb_ld(&bar[XB_TOPGEN]) == tg, bar);
            __builtin_amdgcn_fence(__ATOMIC_ACQUIRE, "agent");
            xb_add(&bar[XB_XGEN(b.x)], 1u);
            asm volatile("s_waitcnt vmcnt(0)" ::: "memory");
        } else {
            XB_SPIN(xb_ld(&bar[XB_XGEN(b.x)]) == gen, bar);
            __builtin_amdgcn_fence(__ATOMIC_ACQUIRE, "agent");
            asm volatile("s_waitcnt vmcnt(0)" ::: "memory");
        }
    }
    __syncthreads();
}
namespace sc {
typedef short bf16x8 __attribute__((ext_vector_type(8)));
typedef short bf16x4 __attribute__((ext_vector_type(4)));
typedef float f32x4 __attribute__((ext_vector_type(4)));
typedef float f32x2_t __attribute__((ext_vector_type(2))); typedef __bf16 bf16x2_t __attribute__((ext_vector_type(2)));
__device__ __forceinline__ unsigned cvtpk(float lo, float hi) { f32x2_t v = {lo, hi}; bf16x2_t b = __builtin_convertvector(v, bf16x2_t); return __builtin_bit_cast(unsigned, b); }
__device__ __forceinline__ float bf2f(unsigned short b) { return __uint_as_float((unsigned)b << 16); }
template <int K, class PA, class PB> __device__ __forceinline__ f32x4 tile_nt(f32x4 acc, PA a_row, PB b_row, int fq) {
#pragma unroll
    for (int k0 = 0; k0 < K; k0 += 32) { const bf16x8 a = *(const bf16x8*)(a_row + k0 + 8 * fq); const bf16x8 b = *(const bf16x8*)(b_row + k0 + 8 * fq);
        acc = __builtin_amdgcn_mfma_f32_16x16x32_bf16(b, a, acc, 0, 0, 0); }
    return acc;
}
__device__ __forceinline__ f32x4 ldu4(const unsigned short* p) { const bf16x4 v = *(const bf16x4*)p; return (f32x4){bf2f((unsigned short)v[0]), bf2f((unsigned short)v[1]), bf2f((unsigned short)v[2]), bf2f((unsigned short)v[3])}; }
__device__ __forceinline__ float ldu1(const unsigned short* p) { return bf2f(*p); }
__device__ __forceinline__ f32x4 widen4(bf16x4 v) { return (f32x4){bf2f((unsigned short)v[0]), bf2f((unsigned short)v[1]), bf2f((unsigned short)v[2]), bf2f((unsigned short)v[3])}; }
}
constexpr int DM = 2048, SEQ = 8192, CTX = 256, MT = SEQ + CTX, DEPTH = 4;
constexpr int INC = 6420, INP = 6656, DFF = 5632;
constexpr int W_ATT = 768, W_RW = 640, W_SSM = 640;
constexpr int C_RW = 2304, C_SSM = 4608;
constexpr float EPS = 1e-6f, LN_X_EPS = 64e-5f;
constexpr int NWAVES = 8, NTHR = 512;

constexpr size_t al256(size_t x) { return (x + 255) / 256 * 256; }
constexpr size_t WS_CTL = 0, CTL_ZERO_BYTES = 1u << 20;
constexpr size_t WS_MOD = CTL_ZERO_BYTES;
constexpr size_t WS_LAM = WS_MOD + al256((size_t)DEPTH * 2 * 12288 * 4);
constexpr size_t WS_WIN = WS_LAM + 256;
constexpr size_t SZ_WIN = (size_t)INP * DM * 2;
constexpr size_t WS_WOUT = WS_WIN + DEPTH * SZ_WIN;
constexpr size_t SZ_WOUT = (size_t)DM * DM * 2;
constexpr size_t WS_WF1 = WS_WOUT + DEPTH * SZ_WOUT;
constexpr size_t SZ_WF1 = (size_t)2 * DFF * DM * 2;
constexpr size_t WS_WF2 = WS_WF1 + DEPTH * SZ_WF1;
constexpr size_t SZ_WF2 = (size_t)DM * DFF * 2;
constexpr size_t WS_XC = WS_WF2 + DEPTH * SZ_WF2;
constexpr size_t WS_H = WS_XC + (size_t)CTX * DM * 4;
constexpr size_t WS_U = WS_H + (size_t)MT * DM * 2;
constexpr size_t WS_Q = WS_U + (size_t)MT * INP * 4;
constexpr size_t WS_K = WS_Q + (size_t)MT * 768 * 2;
constexpr size_t WS_V = WS_K + (size_t)MT * 768 * 2;
constexpr size_t WS_AO = WS_V + (size_t)MT * 768 * 2;
constexpr size_t SZ_RW = (size_t)MT * 640 * 4;
constexpr size_t WS_RW = WS_AO + (size_t)MT * 1536 * 4;
constexpr size_t WS_BONUS = WS_RW + 10 * SZ_RW;
constexpr size_t WS_RY = WS_BONUS + (size_t)MT * 16 * 4;
constexpr size_t WS_SX = WS_RY + 2 * SZ_RW;
constexpr size_t WS_SB = WS_SX + SZ_RW;
constexpr size_t WS_SC = WS_SB + (size_t)MT * 256 * 4;
constexpr size_t WS_SDT = WS_SC + (size_t)MT * 256 * 4;
constexpr size_t WS_SY = WS_SDT + (size_t)MT * 32 * 4;
constexpr size_t WS_MIX = WS_SY + 2 * SZ_RW;
constexpr size_t WS_G = WS_MIX + (size_t)MT * DM * 2;
constexpr size_t WS_END = WS_G + (size_t)MT * DFF * 2;

constexpr int SSD_NB = MT / 128;
constexpr size_t WS2_SBB = WS_END;
constexpr size_t WS2_SCB = WS2_SBB + (size_t)MT * 256 * 2;
constexpr size_t WS2_SAF = WS2_SCB + (size_t)MT * 256 * 2;
constexpr size_t WS2_SS = WS2_SAF + (size_t)MT * 32 * 4;
constexpr size_t WS2_SDEC = WS2_SS + (size_t)2 * 10 * SSD_NB * 8192 * 4;
constexpr size_t WS2_SHIN = WS2_SDEC + (size_t)2 * 10 * SSD_NB * 128;
constexpr size_t WS2_RQ = WS2_SHIN + (size_t)2 * 10 * SSD_NB * 8192 * 2;
constexpr size_t WS2_TCT = WS2_RQ + (size_t)2 * MT * 640 * 2;
constexpr size_t WS2_DC = WS2_TCT + (size_t)2 * 10 * 132 * 4096 * 2;
constexpr size_t WS2_SIN = WS2_DC + (size_t)2 * 10 * 132 * 4096 * 4;
constexpr size_t WS2_END = WS2_SIN + (size_t)2 * 10 * 132 * 4096 * 2;

constexpr int RW_NC = MT / 64;
constexpr size_t WS3_LRW = WS2_END;
constexpr size_t SZ_LRW = (size_t)(4 * 640 * 64 + 640 * 128) * 2;
#ifndef KS_OUT
#define KS_OUT 8
#endif
#ifndef KS_F2
#define KS_F2 22
#endif
constexpr size_t WS3_SLAB = WS3_LRW + DEPTH * SZ_LRW;
constexpr size_t WS3_MODP = WS3_SLAB + (size_t)22 * CTX * DM * 4;
constexpr size_t WS3_RYALT = WS3_MODP + (size_t)32 * 2 * 12288 * 4;
#ifdef RWKV_DEBUG
#define RWKV_YBUF WS3_RYALT
#else
#define RWKV_YBUF WS_RY
#endif
constexpr int CW_QUEUE = 1024;
constexpr int CW_DBG = 64;
constexpr int CW_BAR = 4096;

constexpr int RING_BYTES = 131072;
constexpr int MISC_OFF = 147456 - 256;
constexpr int LDS_BYTES = 147456;

typedef float f32x2 __attribute__((ext_vector_type(2)));
typedef unsigned u32x2 __attribute__((ext_vector_type(2)));

template <int CTRL> __device__ __forceinline__ float dppf_(float v) { return __int_as_float(__builtin_amdgcn_update_dpp(0, __float_as_int(v), CTRL, 0xF, 0xF, true)); }
__device__ __forceinline__ float xor8f_(float v) { return dppf_<0x128>(v); }
__device__ __forceinline__ float xor16f_(float v) { return __int_as_float(__builtin_amdgcn_ds_swizzle(__float_as_int(v), 0x401F)); }
__device__ __forceinline__ float sum16d_(float v) { v += dppf_<0xB1>(v); v += dppf_<0x4E>(v); v += dppf_<0x141>(v); v += dppf_<0x140>(v); return v; }
__device__ __forceinline__ float sumhi_(float v) { v += xor16f_(v); auto r = __builtin_amdgcn_permlane32_swap(__float_as_uint(v), __float_as_uint(v), false, false); return __uint_as_float(r[0]) + __uint_as_float(r[1]); }
__device__ __forceinline__ float wave_sum(float v) { return sumhi_(sum16d_(v)); }
template <int CTRL, int ROWMASK> __device__ __forceinline__ float dpp0_(float v) { return __int_as_float(__builtin_amdgcn_update_dpp(0, __float_as_int(v), CTRL, ROWMASK, 0xF, false)); }
__device__ __forceinline__ float wave_scan_(float v) {
    v += dpp0_<0x111, 0xF>(v); v += dpp0_<0x112, 0xF>(v); v += dpp0_<0x114, 0xF>(v); v += dpp0_<0x118, 0xF>(v);
    v += dpp0_<0x142, 0xA>(v);
    v += dpp0_<0x143, 0xC>(v);
    return v; }
__device__ __forceinline__ float rsq_(float x) { return __builtin_amdgcn_rsqf(x); }
__device__ __forceinline__ float sigmoidf_(float x) { return __builtin_amdgcn_rcpf(1.f + __expf(-x)); }
__device__ __forceinline__ float siluf_(float x) { return x * __builtin_amdgcn_rcpf(1.f + __expf(-x)); }
__device__ __forceinline__ float softplusf_(float x) { return fmaxf(x, 0.f) + __logf(1.f + __expf(-fabsf(x))); }

__device__ __forceinline__ int lidx_(int i) { asm volatile("" : "+s"(i)); return i; }
#define LIDX(i) (i)
struct Args { const float* in[33]; float* out; unsigned char* ws; int single, layer, phase, pad; };
enum In { I_X = 0, I_C, I_CTX, I_CCTX, I_ADAW, I_ADAB, I_N1G, I_N2G, I_WIN, I_WOUT, I_QKG, I_LAMQ, I_LAMK, I_SUBLN, I_MU, I_W0, I_WUP, I_A0, I_AUP, I_GUP, I_KK, I_KA, I_RK,
          I_LNG, I_LNB, I_CONVW, I_CONVB, I_DTB, I_ALOG, I_DSKIP, I_SSMG, I_WF1, I_WF2 };

__device__ __forceinline__ void transpose_item(const float* W, int K, int N, bf16* WT, int dst_row0, LAS float* scr, int k0, int n0, int lane) {
    const int nn = n0 + (lane & 31);
#pragma unroll 8
    for (int i = 0; i < 32; ++i) { const int kk = 2 * i + (lane >> 5); scr[kk * 33 + (lane & 31)] = nn < N ? W[(size_t)(k0 + kk) * N + nn] : 0.f; }
    LDS_WAIT(); asm volatile("" ::: "memory");
    const int c = lane & 7;
#pragma unroll
    for (int j = 0; j < 4; ++j) { const int n = (lane >> 3) + 8 * j; const LAS float* s = scr + (8 * c) * 33 + n;
        v4u o; o.x = pk2(s[0 * 33], s[1 * 33]); o.y = pk2(s[2 * 33], s[3 * 33]); o.z = pk2(s[4 * 33], s[5 * 33]); o.w = pk2(s[6 * 33], s[7 * 33]);
        *(GAS v4u*)(WT + (size_t)(dst_row0 + n) * K + k0 + 8 * c) = o; }
    LDS_WAIT(); asm volatile("" ::: "memory");
}
__device__ __forceinline__ void transpose_item64(const float* W, int K, int N, bf16* WT, int dst_row0, LAS float* scr, int k0, int n0, int lane) {
    const int q = lane & 15, rs = lane >> 4; const bool ok = (n0 + 4 * q) < N;
    f32x4 v[16];
#pragma unroll
    for (int i = 0; i < 16; ++i) v[i] = ok ? *(const f32x4*)(W + (size_t)(k0 + 4 * i + rs) * N + n0 + 4 * q) : (f32x4){0.f, 0.f, 0.f, 0.f};
#pragma unroll
    for (int i = 0; i < 16; ++i) *(LAS f32x4*)(scr + (4 * i + rs) * 68 + 4 * q) = v[i];
    LDS_WAIT(); asm volatile("" ::: "memory");
    const int c = lane & 7, ns = lane >> 3;
#pragma unroll
    for (int j = 0; j < 8; ++j) { const int n = ns + 8 * j; const LAS float* sp = scr + (8 * c) * 68 + n;
        v4u o; o.x = pk2(sp[0 * 68], sp[1 * 68]); o.y = pk2(sp[2 * 68], sp[3 * 68]); o.z = pk2(sp[4 * 68], sp[5 * 68]); o.w = pk2(sp[6 * 68], sp[7 * 68]);
        *(GAS v4u*)(WT + (size_t)(dst_row0 + n) * K + k0 + 8 * c) = o; }
    LDS_WAIT(); asm volatile("" ::: "memory");
}
__device__ __forceinline__ void convert_items(const Args& a, int l, LAS float* scr, int lane, int first, int stride) {
    GAS unsigned char* wsg_ = (GAS unsigned char*)a.ws; asm volatile("" : "+s"(wsg_)); unsigned char* ws = (unsigned char*)wsg_;
    constexpr int NB_IN = (INC + 63) / 64;
    constexpr int IT_IN = 32 * NB_IN, IT_OUT = 32 * 32, IT_F1 = 32 * 176, IT_F2 = 88 * 32, IT_L = IT_IN + IT_OUT + IT_F1 + IT_F2;
    for (int it = first; it < IT_L; it += stride) {
        int r = it;
        if (r < IT_IN) { const int kb = r / NB_IN, nb = r % NB_IN;
            transpose_item64(a.in[LIDX(I_WIN)] + (size_t)l * DM * INC, DM, INC, (bf16*)(ws + WS_WIN + l * SZ_WIN), 64 * nb, scr, 64 * kb, 64 * nb, lane); continue; }
        r -= IT_IN;
        if (r < IT_OUT) { const int kb = r / 32, nb = r % 32;
            transpose_item64(a.in[LIDX(I_WOUT)] + (size_t)l * DM * DM, DM, DM, (bf16*)(ws + WS_WOUT + l * SZ_WOUT), 64 * nb, scr, 64 * kb, 64 * nb, lane); continue; }
        r -= IT_OUT;
        if (r < IT_F1) { const int kb = r / 176, nb = r % 176; const int n0 = 64 * nb; const int j0 = n0 < DFF ? n0 : n0 - DFF;
            const int dst = 256 * (j0 / 128) + (n0 < DFF ? 0 : 128) + (j0 % 128);
            transpose_item64(a.in[LIDX(I_WF1)] + (size_t)l * DM * 2 * DFF, DM, 2 * DFF, (bf16*)(ws + WS_WF1 + l * SZ_WF1), dst, scr, 64 * kb, n0, lane); continue; }
        r -= IT_F1;
        { const int kb = r / 32, nb = r % 32;
            transpose_item64(a.in[LIDX(I_WF2)] + (size_t)l * DFF * DM, DFF, DM, (bf16*)(ws + WS_WF2 + l * SZ_WF2), 64 * nb, scr, 64 * kb, 64 * nb, lane); }
    }
}
__device__ __forceinline__ void mod_tasks(const Args& a, int l, int nks, int first, int stride, int lane) {
    GAS unsigned char* wsg_ = (GAS unsigned char*)a.ws; asm volatile("" : "+s"(wsg_)); unsigned char* ws = (unsigned char*)wsg_;
    float* part = (float*)(ws + WS3_MODP);
    const float* W = a.in[LIDX(I_ADAW)] + (size_t)l * DM * 12288; const float* c0 = a.in[LIDX(I_C)]; const float* c1 = a.in[LIDX(I_CCTX)];
    const int rows = (((DM + nks - 1) / nks) + 15) & ~15;
    for (int t = first; t < 48 * nks; t += stride) {
        const int cb = t % 48, ks = t / 48; const int r0 = ks * rows; const int r1 = (r0 + rows < DM) ? r0 + rows : DM;
        const float* Wp = W + (size_t)r0 * 12288 + 256 * cb + 4 * lane;
        f32x4 a0 = {0.f, 0.f, 0.f, 0.f}, a1 = {0.f, 0.f, 0.f, 0.f};
        int r = r0;
#pragma unroll 1
        for (; r + 16 <= r1; r += 16) { f32x4 w[16];
#pragma unroll
            for (int i = 0; i < 16; ++i) w[i] = __builtin_nontemporal_load((const f32x4*)(Wp + (size_t)i * 12288));
#pragma unroll
            for (int i = 0; i < 16; ++i) { const float s0 = siluf_(c0[r + i]), s1 = siluf_(c1[r + i]); a0 += w[i] * s0; a1 += w[i] * s1; }
            Wp += (size_t)16 * 12288; }
#pragma unroll 1
        for (; r < r1; ++r) { const f32x4 w = *(const f32x4*)Wp; const float s0 = siluf_(c0[r]), s1 = siluf_(c1[r]); a0 += w * s0; a1 += w * s1; Wp += 12288; }
        float* p0 = part + (size_t)ks * 2 * 12288 + 256 * cb + 4 * lane;
        *(f32x4*)p0 = a0; *(f32x4*)(p0 + 12288) = a1;
    }
}
__device__ __forceinline__ void mod_reduce(const Args& a, int l, int nks, int bid, int G, int tid) {
    GAS unsigned char* wsg_ = (GAS unsigned char*)a.ws; asm volatile("" : "+s"(wsg_)); unsigned char* ws = (unsigned char*)wsg_;
    const float* part = (const float*)(ws + WS3_MODP); float* mod = (float*)(ws + WS_MOD) + (size_t)l * 2 * 12288;
    const int per = (2 * 12288 + G - 1) / G;
    for (int i = tid; i < per; i += NTHR) { const int idx = bid * per + i; if (idx < 2 * 12288) {
        float sacc = a.in[LIDX(I_ADAB)][(size_t)l * 12288 + idx % 12288];
#pragma unroll 1
        for (int k0 = 0; k0 < nks; k0 += 16) { float t[16];
#pragma unroll
            for (int k = 0; k < 16; ++k) t[k] = part[(size_t)(k0 + k < nks ? k0 + k : 0) * 2 * 12288 + idx];
#pragma unroll
            for (int k = 0; k < 16; ++k) sacc += (k0 + k < nks) ? t[k] : 0.f; }
        mod[idx] = sacc; } }
}
__device__ __forceinline__ void pre_phase(const Args& a, LAS unsigned char* lds, int tid, int lane, int wave, int bid, int G) {
    GAS unsigned char* wsg_ = (GAS unsigned char*)a.ws; asm volatile("" : "+s"(wsg_)); unsigned char* ws = (unsigned char*)wsg_;
    LAS float* scr = (LAS float*)(lds + wave * 17408);
    const int gw = bid * NWAVES + wave, NGW = G * NWAVES;
    constexpr int NB_IN = (INC + 31) / 32;
    constexpr int IT_IN = 32 * NB_IN, IT_OUT = 32 * 64, IT_F1 = 32 * 352, IT_F2 = 88 * 64, IT_L = IT_IN + IT_OUT + IT_F1 + IT_F2;
    convert_items(a, 0, scr, lane, gw, NGW);
    __syncthreads();
    mod_tasks(a, 0, 32, gw, NGW, lane);
    for (int i0 = bid * NTHR + tid; i0 < DEPTH * 245760; i0 += 8 * G * NTHR) {
        float val[8]; bf16* dp[8];
#pragma unroll
        for (int q = 0; q < 8; ++q) { const int i = i0 + q * G * NTHR; const int ic = i < DEPTH * 245760 ? i : i0;
            const int l = ic / 245760; const int r = ic % 245760; bf16* dst = (bf16*)(ws + WS3_LRW + l * SZ_LRW); const float* sp;
            if (r < 163840) { const int mtx = r / 40960, e = r % 40960, c = e / 64, j = e % 64;
                sp = (mtx < 2 ? a.in[I_WUP] : a.in[I_AUP]) + ((size_t)l * 2 + (mtx & 1)) * 64 * 640 + (size_t)j * 640 + c; dp[q] = dst + mtx * 40960 + c * 64 + j; }
            else { const int e = r - 163840, c = e / 128, j = e % 128; sp = a.in[I_GUP] + (size_t)l * 128 * 640 + (size_t)j * 640 + c; dp[q] = dst + 163840 + c * 128 + j; }
            val[q] = *sp; }
#pragma unroll
        for (int q = 0; q < 8; ++q) *dp[q] = (bf16)f2bf(val[q]);
    }
    if (bid == G - 1 && wave < DEPTH) {
        const int l = wave;
        const float s0 = wave_sum(a.in[LIDX(I_LAMQ)][l * 128 + lane] * a.in[LIDX(I_LAMK)][l * 128 + lane]), s1 = wave_sum(a.in[LIDX(I_LAMQ)][l * 128 + 64 + lane] * a.in[LIDX(I_LAMK)][l * 128 + 64 + lane]);
        const float lam_init = 0.8f - 0.6f * __expf(-0.3f * (float)l);
        if (lane == 0) ((float*)(ws + WS_LAM))[l] = __expf(s0) - __expf(s1) + lam_init;
    }
}

__device__ __forceinline__ void norm_phase(const float* xl, const float* xc, const float* g, const float* modl  , int shift_idx, bf16* H, int gw, int NGW, int lane,
                                           int nsplit, const float* slab, const float* sgate, float* xc_wb, LAS unsigned char* lds, int wave, int bid, int G) {
    LAS float* red = (LAS float*)lds;
    for (int row = bid; row < (nsplit < 0 ? 0 : CTX); row += G) {
        const int col = 256 * wave + 4 * lane;
        f32x4 v = *(const f32x4*)(xc + (size_t)row * DM + col);
        if (nsplit > 0) { f32x4 s = {0.f, 0.f, 0.f, 0.f}; const f32x4 sgj = *(const f32x4*)(sgate + col);
#pragma unroll 1
            for (int p0 = 0; p0 < nsplit; p0 += 8) { f32x4 t[8];
#pragma unroll
                for (int p = 0; p < 8; ++p) t[p] = *(const f32x4*)(slab + ((size_t)(p0 + p < nsplit ? p0 + p : 0) * CTX + row) * DM + col);
#pragma unroll
                for (int p = 0; p < 8; ++p) { const float m = p0 + p < nsplit ? 1.f : 0.f; s += m * t[p]; } }
            v += sgj * s; *(f32x4*)(xc_wb + (size_t)row * DM + col) = v; }
        const float ssw = wave_sum((v.x * v.x + v.y * v.y) + (v.z * v.z + v.w * v.w));
        __syncthreads();
        if (lane == 0) red[wave] = ssw;
        __syncthreads();
        float tot = 0.f;
#pragma unroll
        for (int w = 0; w < NWAVES; ++w) tot += red[w];
        const float rs = rsq_(tot * (1.f / DM) + EPS);
        const float* md = modl + 12288;
        const f32x4 gg = *(const f32x4*)(g + col), sh = *(const f32x4*)(md + shift_idx * DM + col), sc = *(const f32x4*)(md + (shift_idx + 1) * DM + col);
        const f32x4 h = (v * rs) * gg * (1.f + sc) + sh; u32x2 w; w.x = pk2(h.x, h.y); w.y = pk2(h.z, h.w); *(u32x2*)(H + (size_t)row * DM + col) = w;
    }
    f32x4 Al[8], Bl[8];
    { f32x4 gq[8];
#pragma unroll
      for (int j = 0; j < 8; ++j) { const int col = 4 * lane + 256 * j; gq[j] = *(const f32x4*)(g + col); Al[j] = *(const f32x4*)(modl + (shift_idx + 1) * DM + col); Bl[j] = *(const f32x4*)(modl + shift_idx * DM + col); }
      asm volatile("" : "+v"(gq[0]), "+v"(gq[1]), "+v"(gq[2]), "+v"(gq[3]), "+v"(gq[4]), "+v"(gq[5]), "+v"(gq[6]), "+v"(gq[7]));
#pragma unroll
      for (int j = 0; j < 8; ++j) Al[j] = gq[j] * (1.f + Al[j]); }
    for (int row = CTX + gw; row < MT; row += NGW) {
        const float* xr = xl + (size_t)(row - CTX) * DM;
        f32x4 v[8]; float ss = 0.f;
#pragma unroll
        for (int j = 0; j < 8; ++j) v[j] = *(const f32x4*)(xr + 4 * lane + 256 * j);
#pragma unroll
        for (int j = 0; j < 8; ++j) ss += (v[j].x * v[j].x + v[j].y * v[j].y) + (v[j].z * v[j].z + v[j].w * v[j].w);
        const float rs = rsq_(wave_sum(ss) * (1.f / DM) + EPS);
#pragma unroll
        for (int j = 0; j < 8; ++j) { const int col = 4 * lane + 256 * j; const f32x4 h = (v[j] * rs) * Al[j] + Bl[j]; u32x2 w; w.x = pk2(h.x, h.y); w.y = pk2(h.z, h.w); *(u32x2*)(H + (size_t)row * DM + col) = w; }
    }
}

struct EpiStoreF32 {
    static constexpr bool PERM = false, AFTER_DRAIN = false;
    float* O; int ldc;
    __device__ __forceinline__ void operator()(const pg8::f32x4 (&acc)[2][2][4][2], const pg8::Unit& u, int wr, int wc, int fr, int fq) const {
        const int row0 = u.pm * 256 + wr * 64 + fr, col0 = u.pn * 256 + wc * 32 + 4 * fq;
#pragma unroll
        for (int ai = 0; ai < 2; ++ai)
#pragma unroll
            for (int m = 0; m < 4; ++m) { float* rowp = O + (size_t)(row0 + ai * 128 + m * 16) * ldc + col0;
#pragma unroll
                for (int bj = 0; bj < 2; ++bj)
#pragma unroll
                    for (int n = 0; n < 2; ++n) *(pg8::f32x4*)(rowp + bj * 128 + n * 16) = acc[ai][bj][m][n]; }
    }
};
struct EpiStoreBf16 {
    static constexpr bool PERM = true, AFTER_DRAIN = false;
    bf16* O; int ldc;
    __device__ __forceinline__ void operator()(const pg8::f32x4 (&acc)[2][2][4][2], const pg8::Unit& u, int wr, int wc, int fr, int fq) const {
        const int row0 = u.pm * 256 + wr * 64 + fr, col0 = u.pn * 256 + wc * 32 + 8 * fq;
#pragma unroll
        for (int ai = 0; ai < 2; ++ai)
#pragma unroll
            for (int m = 0; m < 4; ++m) { bf16* rowp = O + (size_t)(row0 + ai * 128 + m * 16) * ldc + col0;
#pragma unroll
                for (int bj = 0; bj < 2; ++bj) { const pg8::f32x4 v0 = acc[ai][bj][m][0], v1 = acc[ai][bj][m][1];
                    pg8::u32x4 w; w.x = sc::cvtpk(v0[0], v0[1]); w.y = sc::cvtpk(v0[2], v0[3]); w.z = sc::cvtpk(v1[0], v1[1]); w.w = sc::cvtpk(v1[2], v1[3]);
                    *(pg8::u32x4*)(rowp + bj * 128) = w; } }
    }
};
struct EpiResid {
    static constexpr bool PERM = false, AFTER_DRAIN = false;
    const float* xl_in; const float* xc_in; float* xl_out; float* xc_out; const float* gate_l; const float* gate_c; int pm_off; float* slab;
    __device__ __forceinline__ void operator()(const pg8::f32x4 (&acc)[2][2][4][2], const pg8::Unit& u, int wr, int wc, int fr, int fq) const {
        if (u.kp >= 0) {
            float* Sl = slab + (size_t)u.kp * CTX * DM; const int r0 = wr * 64 + fr, c0 = u.pn * 256 + wc * 32 + 4 * fq;
#pragma unroll
            for (int ai = 0; ai < 2; ++ai)
#pragma unroll
                for (int m = 0; m < 4; ++m)
#pragma unroll
                    for (int bj = 0; bj < 2; ++bj)
#pragma unroll
                        for (int n = 0; n < 2; ++n) *(pg8::f32x4*)(Sl + (size_t)(r0 + ai * 128 + m * 16) * DM + c0 + bj * 128 + n * 16) = acc[ai][bj][m][n];
            return; }
        const int pm = u.pm + pm_off; const bool isc = (pm == 0);
        const int row0 = (isc ? 0 : (pm - 1) * 256) + wr * 64 + fr, col0 = u.pn * 256 + wc * 32 + 4 * fq;
        const float* bin = isc ? xc_in : xl_in; float* bout = isc ? xc_out : xl_out; const float* gt = isc ? gate_c : gate_l;
        pg8::f32x4 gv[2][2];
#pragma unroll
        for (int bj = 0; bj < 2; ++bj)
#pragma unroll
            for (int n = 0; n < 2; ++n) gv[bj][n] = *(const pg8::f32x4*)(gt + col0 + bj * 128 + n * 16);
#pragma unroll
        for (int am = 0; am < 8; am += 2) { pg8::f32x4 b[2][2][2]; const int ai = am >> 2;
#pragma unroll
            for (int mm = 0; mm < 2; ++mm) { const int m = (am & 3) + mm; const size_t off = (size_t)(row0 + ai * 128 + m * 16) * DM + col0;
#pragma unroll
                for (int bj = 0; bj < 2; ++bj)
#pragma unroll
                    for (int n = 0; n < 2; ++n) b[mm][bj][n] = *(const pg8::f32x4*)(bin + off + bj * 128 + n * 16); }
#pragma unroll
            for (int mm = 0; mm < 2; ++mm) { const int m = (am & 3) + mm; const size_t off = (size_t)(row0 + ai * 128 + m * 16) * DM + col0;
#pragma unroll
                for (int bj = 0; bj < 2; ++bj)
#pragma unroll
                    for (int n = 0; n < 2; ++n) *(pg8::f32x4*)(bout + off + bj * 128 + n * 16) = b[mm][bj][n] + gv[bj][n] * acc[ai][bj][m][n]; } }
    }
};
struct EpiSwiglu {
    static constexpr bool PERM = true, AFTER_DRAIN = false;
    bf16* O;
    __device__ __forceinline__ void operator()(const pg8::f32x4 (&acc)[2][2][4][2], const pg8::Unit& u, int wr, int wc, int fr, int fq) const {
        const int row0 = u.pm * 256 + wr * 64 + fr, col0 = u.pn * 128 + wc * 32 + 8 * fq;
#pragma unroll
        for (int ai = 0; ai < 2; ++ai)
#pragma unroll
            for (int m = 0; m < 4; ++m) { bf16* rowp = O + (size_t)(row0 + ai * 128 + m * 16) * DFF + col0;
                float o[8];
#pragma unroll
                for (int n = 0; n < 2; ++n)
#pragma unroll
                    for (int i = 0; i < 4; ++i) { const float gt = acc[ai][0][m][n][i], up = acc[ai][1][m][n][i]; o[4 * n + i] = gt * __builtin_amdgcn_rcpf(1.f + __expf(-gt)) * up; }
                pg8::u32x4 w; w.x = pg8::cvt_pk_bf16(o[0], o[1]); w.y = pg8::cvt_pk_bf16(o[2], o[3]); w.z = pg8::cvt_pk_bf16(o[4], o[5]); w.w = pg8::cvt_pk_bf16(o[6], o[7]);
                *(pg8::u32x4*)rowp = w; }
    }
};

struct SplitOrder {
    pg8::StaticOrder lat; int nlr, G, c, npn, nsplit, ntp;
    __device__ void init(int Mlat, int N, int G_, int c_, int nsplit_, int ntp_) { lat.init(Mlat, N, G_, c_); nlr = (lat.nwg + G_ - 1) / G_; G = G_; c = c_; npn = N / 256; nsplit = nsplit_; ntp = ntp_; }
    __device__ bool next(int i, pg8::Unit& u) const {
        if (i < nlr) { if (lat.next(i, u)) { u.pm += 1; return true; } i = nlr; }
        const int j = (i - nlr) * G + c; if (j >= npn * nsplit) return false;
        u.pm = 0; u.pn = j % npn; u.kp = j / npn; u.k0 = u.kp * ntp; u.nt = ntp; return true;
    }
    __device__ __forceinline__ void a_ready(const pg8::Unit&) const {}
    __device__ __forceinline__ void done(const pg8::Unit&) const {}
};

__device__ __forceinline__ float sum16(float v) { return sum16d_(v); }
__device__ __forceinline__ u32x2 pk4(f32x4 v) { u32x2 w; w.x = sc::cvtpk(v.x, v.y); w.y = sc::cvtpk(v.z, v.w); return w; }
__device__ __forceinline__ void prep_rows(const Args& a, int l, int gw, int NGW, int lane) {
    GAS unsigned char* wsg_ = (GAS unsigned char*)a.ws; asm volatile("" : "+s"(wsg_)); unsigned char* ws = (unsigned char*)wsg_;
    const bf16* U = (const bf16*)(ws + WS_U);
    bf16* Qb = (bf16*)(ws + WS_Q); bf16* Kb = (bf16*)(ws + WS_K); bf16* Vb = (bf16*)(ws + WS_V);
    float* SX = (float*)(ws + WS_SX); bf16* SBb = (bf16*)(ws + WS2_SBB); bf16* SCb = (bf16*)(ws + WS2_SCB); float* SDT = (float*)(ws + WS_SDT);
    const float* qkg = a.in[I_QKG] + l * 128; const float* cw = a.in[I_CONVW] + (size_t)l * 3 * 1152; const float* cb = a.in[I_CONVB] + l * 1152; const float* dtb = a.in[I_DTB] + l * 20;
    const int g16 = lane >> 4, j16 = lane & 15;
    const f32x4 gq = *(const f32x4*)(qkg + 4 * j16), gk = *(const f32x4*)(qkg + 64 + 4 * j16);
    float inv[4];
#pragma unroll
    for (int e = 0; e < 4; ++e) inv[e] = __builtin_amdgcn_exp2f(-(float)((4 * j16 + e) & 15) * 0.83048202372184059f);
    f32x4 cw0[5], cw1[5], cw2[5], cbb[5];
#pragma unroll
    for (int i = 0; i < 5; ++i) { const int idx = lane + 64 * i; const int ch = idx < 288 ? 4 * idx : 0;
        cw0[i] = *(const f32x4*)(cw + ch); cw1[i] = *(const f32x4*)(cw + 1152 + ch); cw2[i] = *(const f32x4*)(cw + 2304 + ch); cbb[i] = *(const f32x4*)(cb + ch); }
    float dtbias = 0.f; if (lane < 20) dtbias = dtb[lane];
    for (int row = gw; row < MT; row += NGW) {
        const bool lat = row >= CTX; const int t = row - CTX;
        const bf16* ur = U + (size_t)row * INP;
        const bool hp = (row != 0 && row != CTX), hn = (row != CTX - 1 && row != MT - 1);
        f32x4 qk[6], vv[3], c0[5], cm[5], cp[5];
#pragma unroll
        for (int i = 0; i < 6; ++i) qk[i] = sc::ldu4(ur + (4 * i + g16) * 64 + 4 * j16);
#pragma unroll
        for (int i = 0; i < 3; ++i) vv[i] = sc::ldu4(ur + 1536 + 4 * (lane + 64 * i));
#pragma unroll
        for (int i = 0; i < 5; ++i) { const int idx = lane + 64 * i; const bf16* p = ur + C_SSM + 640 + 4 * (idx < 288 ? idx : 287); const f32x4 z4 = {0.f, 0.f, 0.f, 0.f};
            c0[i] = sc::ldu4(p); cm[i] = sc::ldu4(hp ? p - INP : p); cp[i] = sc::ldu4(hn ? p + INP : p);
            if (!hp) cm[i] = z4; if (!hn) cp[i] = z4; }
        float dtr = sc::ldu1(ur + C_SSM + 1792 + (lane < 20 ? lane : 0));
        float cs[4], sn[4];
#pragma unroll
        for (int e = 0; e < 4; ++e) { cs[e] = 1.f; sn[e] = 0.f;
            if (lat) { const int d32 = (4 * j16 + e) & 31; const float pos = (float)(d32 < 16 ? (t >> 6) : (t & 63)); const float ang = pos * inv[e]; cs[e] = __cosf(ang); sn[e] = __sinf(ang); } }
#pragma unroll
        for (int i = 0; i < 6; ++i) { const int s = 4 * i + g16;
            const f32x4 x = qk[i]; const float ss = sum16((x.x * x.x + x.y * x.y) + (x.z * x.z + x.w * x.w));
            const float rs = rsq_(ss * (1.f / 64.f) + EPS);
            f32x4 y = x * rs * (i < 3 ? gq : gk);
            f32x4 pt; pt.x = xor8f_(y.x); pt.y = xor8f_(y.y); pt.z = xor8f_(y.z); pt.w = xor8f_(y.w);
            if (lat) {
#pragma unroll
                for (int e = 0; e < 4; ++e) y[e] = (j16 < 8) ? y[e] * cs[e] - pt[e] * sn[e] : y[e] * cs[e] + pt[e] * sn[e]; }
            *(u32x2*)((i < 3 ? Qb : Kb) + (size_t)row * 768 + (s - (i < 3 ? 0 : 12)) * 64 + 4 * j16) = pk4(y); }
#pragma unroll
        for (int i = 0; i < 3; ++i) *(u32x2*)(Vb + (size_t)row * 768 + 4 * (lane + 64 * i)) = pk4(vv[i]);
#pragma unroll
        for (int i = 0; i < 5; ++i) { const int idx = lane + 64 * i; const int ch = 4 * idx;
            if (idx < 288) {
                f32x4 y = cw0[i] * cm[i] + cw1[i] * c0[i] + cw2[i] * cp[i] + cbb[i];
#pragma unroll
                for (int e = 0; e < 4; ++e) y[e] = siluf_(y[e]);
                if (ch < 640) *(f32x4*)(SX + (size_t)row * 640 + ch) = y; else if (ch < 896) *(u32x2*)(SBb + (size_t)row * 256 + ch - 640) = pk4(y); else *(u32x2*)(SCb + (size_t)row * 256 + ch - 896) = pk4(y); } }
        if (lane < 20) { const int d = lane / 10, hh = lane % 10; SDT[(size_t)row * 32 + d * 16 + hh] = softplusf_(dtr + dtbias); }
    }
}
#ifndef PREP_RI
#define PREP_RI 48
#endif
__device__ __forceinline__ void prep_rwkv(const Args& a, int l, LAS unsigned char* lds, int tid, int lane, int wave, int bid, int G) {
    GAS unsigned char* wsg_ = (GAS unsigned char*)a.ws; asm volatile("" : "+s"(wsg_)); unsigned char* ws = (unsigned char*)wsg_;
    const bf16* U = (const bf16*)(ws + WS_U);
    float* RW = (float*)(ws + WS_RW); constexpr size_t S = (size_t)MT * 640;
    float* BON = (float*)(ws + WS_BONUS);
    constexpr int RI = PREP_RI;
    constexpr int PA = 392;
    LAS bf16* act = (LAS bf16*)lds;
    LAS bf16* tmp = (LAS bf16*)(lds + 51200) + wave * 3072;
    const float* mu = a.in[I_MU] + (size_t)l * 2 * 2304;
    const float* w0 = a.in[I_W0] + (size_t)l * 2 * 640; const float* a0 = a.in[I_A0] + (size_t)l * 2 * 640;
    const float* kkw = a.in[I_KK] + l * 640; const float* kaw = a.in[I_KA] + l * 640; const float* rkw = a.in[I_RK] + l * 640;
    const bf16* LRW = (const bf16*)(ws + WS3_LRW + l * SZ_LRW);
    const int fr = lane & 15, fq = lane >> 4;
    LAS float* cv = (LAS float*)(lds + 102400);
    __syncthreads();
#ifndef PROBE_CV
#define PROBE_CV 1
#endif
#ifndef PROBE_S1
#define PROBE_S1 1
#endif
#ifndef PROBE_S2
#define PROBE_S2 1
#endif
    for (int pcv_ = 0; pcv_ < PROBE_CV; ++pcv_)
    { f32x4 v[5];
#pragma unroll
      for (int j = 0; j < 5; ++j) { const int i = 4 * (tid + NTHR * j); const float* p;
          if (i < 1920) p = mu + i; else if (i < 3840) p = mu + 2304 + (i - 1920); else if (i < 5120) p = w0 + (i - 3840); else if (i < 6400) p = a0 + (i - 5120);
          else if (i < 7040) p = kkw + (i - 6400); else if (i < 7680) p = kaw + (i - 7040); else p = rkw + (i < 8320 ? i - 7680 : 0);
          v[j] = *(const f32x4*)p; }
#pragma unroll
      for (int j = 0; j < 5; ++j) { const int i = 4 * (tid + NTHR * j); if (i < 8320) *(LAS f32x4*)(cv + i) = v[j]; } }
    for (int it = bid; it < MT / RI; it += G) {
        const int row0 = it * RI;
        __syncthreads();
        static_assert((RI * 384) % (NTHR * 6) == 0, "staging batches");
#pragma unroll 1
        for (int ps1_ = 0; ps1_ < PROBE_S1; ++ps1_)
#pragma unroll 1
        for (int i0 = tid; i0 < RI * 384; i0 += NTHR * 6) {
            float x0[6], xm[6], xp[6];
#pragma unroll
            for (int j = 0; j < 6; ++j) { const int i = i0 + j * NTHR; const int r = i / 384, cc = i % 384; const int row = row0 + r;
                const bf16* p = U + (size_t)row * INP + C_RW + 1920 + cc;
                const bool hp = (row != 0 && row != CTX), hn = (row != CTX - 1 && row != MT - 1);
                x0[j] = sc::ldu1(p); xm[j] = sc::ldu1(hp ? p - INP : p); xp[j] = sc::ldu1(hn ? p + INP : p); }
#pragma unroll
            for (int j = 0; j < 6; ++j) { const int i = i0 + j * NTHR; const int r = i / 384, cc = i % 384, c = 1920 + cc; const int row = row0 + r;
                const bool hp = (row != 0 && row != CTX), hn = (row != CTX - 1 && row != MT - 1);
                float y = x0[j] + mu[c] * ((hp ? xm[j] : 0.f) - x0[j]) + mu[2304 + c] * ((hn ? xp[j] : 0.f) - x0[j]);
                if (cc < 128) y = 1.f - 2.f * __builtin_amdgcn_rcpf(1.f + __expf(2.f * y)); else if (cc >= 256) y = sigmoidf_(y);
                act[r * PA + cc] = (bf16)f2bf(y); }
        }
        __syncthreads();
#pragma unroll 1
        for (int ps2_ = 0; ps2_ < PROBE_S2; ++ps2_)
        { constexpr int NP = (RI / 16) * 10;
          sc::bf16x8 wq[12]; sc::bf16x4 x0r[3], xmr[3], xpr[3];
#define TILE_LOAD_W(pr_, tc_) do { const int h_ = (pr_) % 10; const int wrow_ = 64 * h_ + 16 * (tc_) + fr; \
              _Pragma("unroll") for (int mtx = 0; mtx < 4; ++mtx) { wq[2 * mtx] = *(const sc::bf16x8*)(LRW + mtx * 40960 + wrow_ * 64 + 8 * fq); wq[2 * mtx + 1] = *(const sc::bf16x8*)(LRW + mtx * 40960 + wrow_ * 64 + 32 + 8 * fq); } \
              _Pragma("unroll") for (int ks = 0; ks < 4; ++ks) wq[8 + ks] = *(const sc::bf16x8*)(LRW + 163840 + wrow_ * 128 + 32 * ks + 8 * fq); } while (0)
#define TILE_LOAD_X(pr_, tc_) do { const int rt_ = (pr_) / 10, h_ = (pr_) % 10; const int row_ = row0 + 16 * rt_ + fr; const int c_ = 64 * h_ + 16 * (tc_) + 4 * fq; \
              const bool hp_ = (row_ != 0 && row_ != CTX), hn_ = (row_ != CTX - 1 && row_ != MT - 1); const bf16* ur_ = U + (size_t)row_ * INP + C_RW; \
              _Pragma("unroll") for (int q = 0; q < 3; ++q) { const bf16* p = ur_ + q * 640 + c_; x0r[q] = *(const sc::bf16x4*)p; xmr[q] = *(const sc::bf16x4*)(hp_ ? p - INP : p); xpr[q] = *(const sc::bf16x4*)(hn_ ? p + INP : p); } } while (0)
#define TILE_LOAD(pr_, tc_) do { TILE_LOAD_W(pr_, tc_); TILE_LOAD_X(pr_, tc_); } while (0)
          int pr = wave, tc = 0; float ssq = 0.f, bsum = 0.f, rn_prev = 0.f; size_t o_prev = (size_t)(row0 + 16 * (wave / 10) + fr) * 640 + 64 * (wave % 10) + 4 * fq;
          if (pr < NP) TILE_LOAD(pr, 0);
          u32x2 st_r = {0u, 0u}, st_v = {0u, 0u}, st_kf = {0u, 0u}, st_kb = {0u, 0u}, st_gt = {0u, 0u}, st_if = {0u, 0u}, st_ib = {0u, 0u}; f32x4 st_lwf = {0.f, 0.f, 0.f, 0.f}, st_lwb = {0.f, 0.f, 0.f, 0.f};
          size_t st_o = o_prev;
#pragma unroll 1
          while (pr < NP) {
              const int rt = pr / 10, h = pr % 10; const int row = row0 + 16 * rt + fr; const int c = 64 * h + 16 * tc + 4 * fq;
              const int pr2 = (tc < 3) ? pr : pr + 8, tc2 = (tc < 3) ? tc + 1 : 0; const int prl = pr2 < NP ? pr2 : pr;
              const LAS bf16* arow = act + (16 * rt + fr) * PA;
              f32x4 m0[3], m1[3], kc[3];
#pragma unroll
              for (int q = 0; q < 3; ++q) { m0[q] = *(const LAS f32x4*)(cv + q * 640 + c); m1[q] = *(const LAS f32x4*)(cv + 1920 + q * 640 + c); kc[q] = *(const LAS f32x4*)(cv + 6400 + q * 640 + c); }
              f32x4 wlf = *(const LAS f32x4*)(cv + 3840 + c), wlb = *(const LAS f32x4*)(cv + 4480 + c), icf = *(const LAS f32x4*)(cv + 5120 + c), icb = *(const LAS f32x4*)(cv + 5760 + c), gt = {0.f, 0.f, 0.f, 0.f};
#pragma unroll
              for (int ks = 0; ks < 2; ++ks) { const sc::bf16x8 a0_ = *(const LAS sc::bf16x8*)(arow + 32 * ks + 8 * fq), a1_ = *(const LAS sc::bf16x8*)(arow + 64 + 32 * ks + 8 * fq),
                      a2_ = *(const LAS sc::bf16x8*)(arow + 128 + 32 * ks + 8 * fq), a3_ = *(const LAS sc::bf16x8*)(arow + 192 + 32 * ks + 8 * fq);
                  wlf = __builtin_amdgcn_mfma_f32_16x16x32_bf16(wq[0 + ks], a0_, wlf, 0, 0, 0); wlb = __builtin_amdgcn_mfma_f32_16x16x32_bf16(wq[2 + ks], a1_, wlb, 0, 0, 0);
                  icf = __builtin_amdgcn_mfma_f32_16x16x32_bf16(wq[4 + ks], a2_, icf, 0, 0, 0); icb = __builtin_amdgcn_mfma_f32_16x16x32_bf16(wq[6 + ks], a3_, icb, 0, 0, 0); }
#pragma unroll
              for (int ks = 0; ks < 4; ++ks) { const sc::bf16x8 a4_ = *(const LAS sc::bf16x8*)(arow + 256 + 32 * ks + 8 * fq); gt = __builtin_amdgcn_mfma_f32_16x16x32_bf16(wq[8 + ks], a4_, gt, 0, 0, 0); }
              __builtin_amdgcn_sched_barrier(0);
              TILE_LOAD_W(prl, tc2);
              __builtin_amdgcn_sched_barrier(0);
              f32x4 sh[3];
              { const bool hp = (row != 0 && row != CTX), hn = (row != CTX - 1 && row != MT - 1); const f32x4 z4 = {0.f, 0.f, 0.f, 0.f};
#pragma unroll
                for (int q = 0; q < 3; ++q) { const f32x4 x0 = sc::widen4(x0r[q]), xm = sc::widen4(xmr[q]), xp = sc::widen4(xpr[q]); sh[q] = x0 + m0[q] * ((hp ? xm : z4) - x0) + m1[q] * ((hn ? xp : z4) - x0); } }
              asm volatile("" : "+v"(sh[0]), "+v"(sh[1]), "+v"(sh[2]));
              __builtin_amdgcn_sched_barrier(0);
              *(u32x2*)((bf16*)(RW + 0 * S) + st_o) = st_r; *(u32x2*)((bf16*)(RW + 1 * S) + st_o) = st_v; *(f32x4*)(RW + 3 * S + st_o) = st_lwf; *(f32x4*)(RW + 4 * S + st_o) = st_lwb;
              *(u32x2*)((bf16*)(RW + 5 * S) + st_o) = st_kf; *(u32x2*)((bf16*)(RW + 6 * S) + st_o) = st_kb; *(u32x2*)((bf16*)(RW + 9 * S) + st_o) = st_gt;
              *(u32x2*)((bf16*)(RW + 7 * S) + st_o) = st_if; *(u32x2*)((bf16*)(RW + 8 * S) + st_o) = st_ib;
              { const sc::bf16x4 k4 = *(const LAS sc::bf16x4*)(tmp + tc * 256 + 4 * lane);
                f32x4 kk;
#pragma unroll
                for (int i = 0; i < 4; ++i) kk[i] = sc::bf2f(k4[i]) * rn_prev;
                *(u32x2*)((bf16*)(RW + 2 * S) + o_prev + 16 * tc) = pk4((rn_prev != 0.f) ? kk : (f32x4){0.f, 0.f, 0.f, 0.f}); }
              __builtin_amdgcn_sched_barrier(0);
              TILE_LOAD_X(prl, tc2);
              __builtin_amdgcn_sched_barrier(0);
              f32x4 lwf, lwb, kf, kb, krv, ifv, ibv;
#pragma unroll
              for (int i = 0; i < 4; ++i) { const float kx = sh[1][i];
                  lwf[i] = -0.60653066f * sigmoidf_(wlf[i]); lwb[i] = -0.60653066f * sigmoidf_(wlb[i]);
                  const float if_ = sigmoidf_(icf[i]), ib_ = sigmoidf_(icb[i]);
                  kf[i] = kx * (1.f + (if_ - 1.f) * kc[1][i]); kb[i] = kx * (1.f + (ib_ - 1.f) * kc[1][i]);
                  const float kr = kx * kc[0][i]; krv[i] = kr; ifv[i] = if_; ibv[i] = ib_; ssq += kr * kr; bsum += sh[0][i] * (kf[i] + kb[i]) * kc[2][i]; }
              st_o = (size_t)row * 640 + c; st_r = pk4(sh[0]); st_v = pk4(sh[2]); st_lwf = lwf; st_lwb = lwb; st_kf = pk4(kf); st_kb = pk4(kb); st_gt = pk4(gt); st_if = pk4(ifv); st_ib = pk4(ibv);
              *(LAS u32x2*)(tmp + tc * 256 + 4 * lane) = pk4(krv);
              if (tc == 3) {
                  ssq = sumhi_(ssq); bsum = sumhi_(bsum);
                  rn_prev = rsq_(ssq + 1e-12f); o_prev = (size_t)row * 640 + 64 * h + 4 * fq;
                  if (fq == 0) BON[(size_t)row * 16 + h] = bsum;
                  ssq = 0.f; bsum = 0.f; }
              pr = pr2; tc = tc2;
          }
          if (rn_prev != 0.f) {
              *(u32x2*)((bf16*)(RW + 0 * S) + st_o) = st_r; *(u32x2*)((bf16*)(RW + 1 * S) + st_o) = st_v; *(f32x4*)(RW + 3 * S + st_o) = st_lwf; *(f32x4*)(RW + 4 * S + st_o) = st_lwb;
              *(u32x2*)((bf16*)(RW + 5 * S) + st_o) = st_kf; *(u32x2*)((bf16*)(RW + 6 * S) + st_o) = st_kb; *(u32x2*)((bf16*)(RW + 9 * S) + st_o) = st_gt;
              *(u32x2*)((bf16*)(RW + 7 * S) + st_o) = st_if; *(u32x2*)((bf16*)(RW + 8 * S) + st_o) = st_ib;
#pragma unroll
              for (int t4 = 0; t4 < 4; ++t4) { const sc::bf16x4 k4 = *(const LAS sc::bf16x4*)(tmp + t4 * 256 + 4 * lane); f32x4 kk;
#pragma unroll
                  for (int i = 0; i < 4; ++i) kk[i] = sc::bf2f(k4[i]) * rn_prev;
                  *(u32x2*)((bf16*)(RW + 2 * S) + o_prev + 16 * t4) = pk4(kk); } }
#undef TILE_LOAD
#undef TILE_LOAD_W
#undef TILE_LOAD_X
        }
    }
    __syncthreads();
}

__device__ __forceinline__ int seq_row(int p, int dir) { return dir == 0 ? p : (p < CTX ? CTX - 1 - p : MT - 1 - (p - CTX)); }
__device__ __forceinline__ float quad_sum(float v) { v += __shfl_xor(v, 1); v += __shfl_xor(v, 2); return v; }

#ifdef USE_NAIVE_SSD
#define NAIVE_SSD_EXTRA(x) (x)
#else
#define NAIVE_SSD_EXTRA(x) 0.f
#endif
__device__ __forceinline__ void mixfin_phase(const Args& a, int l, int gw, int NGW, int lane) {
    GAS unsigned char* wsg_ = (GAS unsigned char*)a.ws; asm volatile("" : "+s"(wsg_)); unsigned char* ws = (unsigned char*)wsg_;
    constexpr size_t S = (size_t)MT * 640;
    const float* AO = (const float*)(ws + WS_AO); const float* RW = (const float*)(ws + WS_RW); const float* BON = (const float*)(ws + WS_BONUS);
    const float* RY = (const float*)(ws + WS_RY); const float* SY = (const float*)(ws + WS_SY); const float* SX = (const float*)(ws + WS_SX); const bf16* U = (const bf16*)(ws + WS_U);
    bf16* MIX = (bf16*)(ws + WS_MIX);
    const float lam = ((const float*)(ws + WS_LAM))[l]; const float lam_init = 0.8f - 0.6f * __expf(-0.3f * (float)l);
    const float* subg = a.in[I_SUBLN] + l * 128; const float* lng = a.in[I_LNG] + l * 640; const float* lnb = a.in[I_LNB] + l * 640;
    const float* dsk = a.in[I_DSKIP] + l * 20; const float* sng = a.in[I_SSMG] + l * 640;
    const f32x4 sg4 = *(const f32x4*)(subg + 4 * (lane & 31));
    f32x4 lng4[3], lnb4[3], sng4[3]; float dd3[3];
#pragma unroll
    for (int i = 0; i < 3; ++i) { const int idx = lane + 64 * i; const int idc = idx < 160 ? idx : 159; const int h = idc >> 4;
        lng4[i] = *(const f32x4*)(lng + 4 * idc); lnb4[i] = *(const f32x4*)(lnb + 4 * idc); sng4[i] = *(const f32x4*)(sng + 4 * idc); dd3[i] = dsk[h] + dsk[10 + h]; }
    for (int row = (l == DEPTH - 1 ? CTX : 0) + gw; row < MT; row += NGW) {
        bf16* mr = MIX + (size_t)row * DM;
        f32x4 a0[3], a1[3], ry0[3], ry1[3], rv[3], rg[3], sy[3], sx[3], sz[3]; float bon[3]; const f32x4 z4 = {0.f, 0.f, 0.f, 0.f};
#pragma unroll
        for (int i = 0; i < 3; ++i) { const int idx = lane + 64 * i; const int h = idx >> 5, d = 4 * (idx & 31);
            a0[i] = *(const f32x4*)(AO + (size_t)row * 1536 + (2 * h) * 128 + d); a1[i] = *(const f32x4*)(AO + (size_t)row * 1536 + (2 * h + 1) * 128 + d);
            { const int idc = idx < 160 ? idx : 159; const size_t o = (size_t)row * 640 + 4 * idc;
                ry0[i] = *(const f32x4*)(RY + o); ry1[i] = *(const f32x4*)(RY + S + o); rv[i] = sc::ldu4((const bf16*)(RW + 1 * S) + o); rg[i] = sc::ldu4((const bf16*)(RW + 9 * S) + o);
                sy[i] = *(const f32x4*)(SY + o); sx[i] = *(const f32x4*)(SX + o); sz[i] = sc::ldu4(U + (size_t)row * INP + C_SSM + 4 * idc); bon[i] = BON[(size_t)row * 16 + (idc >> 4)]; } }
#pragma unroll
        for (int i = 0; i < 3; ++i) { const int idx = lane + 64 * i; const f32x4 o = a0[i] - lam * a1[i];
            float ss = (o.x * o.x + o.y * o.y) + (o.z * o.z + o.w * o.w); ss = sum16(ss); ss += xor16f_(ss);
            const float sc_ = rsq_(ss * (1.f / 128.f) + EPS) * (1.f - lam_init);
            *(u32x2*)(mr + 4 * idx) = pk4(o * sc_ * sg4); }
#pragma unroll
        for (int i = 0; i < 3; ++i) { const int idx = lane + 64 * i; const int c = 4 * idx, h = idx >> 4;
            if (idx < 160) {
                const f32x4 y = ry0[i] + ry1[i]; const float mean = sum16((y.x + y.y) + (y.z + y.w)) * (1.f / 64.f); const f32x4 yc = y - mean;
                const float var = sum16((yc.x * yc.x + yc.y * yc.y) + (yc.z * yc.z + yc.w * yc.w)) * (1.f / 64.f);
                const f32x4 yn = yc * (rsq_(var + LN_X_EPS));
                const f32x4 out = (yn * lng4[i] + lnb4[i] + bon[i] * rv[i]) * rg[i];
                *(u32x2*)(mr + 768 + c) = pk4(out); } }
        f32x4 yg[3]; float s0 = 0.f, s1 = 0.f;
#pragma unroll
        for (int i = 0; i < 3; ++i) { const int idx = lane + 64 * i; const int h = idx >> 4;
            if (idx < 160) { const float dd = dd3[i]; f32x4 y = sy[i] + dd * sx[i];
#pragma unroll
                for (int e = 0; e < 4; ++e) y[e] *= siluf_(sz[i][e]);
                yg[i] = y; const float p = (y.x * y.x + y.y * y.y) + (y.z * y.z + y.w * y.w); if (idx < 80) s0 += p; else s1 += p; } else yg[i] = z4; }
        s0 = wave_sum(s0); s1 = wave_sum(s1);
        const float r0 = rsq_(s0 * (1.f / 320.f) + EPS), r1 = rsq_(s1 * (1.f / 320.f) + EPS);
#pragma unroll
        for (int i = 0; i < 3; ++i) { const int idx = lane + 64 * i; if (idx < 160) *(u32x2*)(mr + 1408 + 4 * idx) = pk4(yg[i] * (idx < 80 ? r0 : r1) * sng4[i]); }
    }
}
namespace att {
using bf16x8 = __attribute__((ext_vector_type(8))) short;
using s16x4  = __attribute__((ext_vector_type(4))) short;
using f32x16 = __attribute__((ext_vector_type(16))) float;
using u32x4  = __attribute__((ext_vector_type(4))) unsigned;
constexpr int NW = 8, QBLK = 32, KVBLK = 64, LD = 768, LDO = 1536;
constexpr float SCALE = 0.125f, THR = 8.f;
constexpr size_t SHM_V = KVBLK * 128 * 2, SHM_K = KVBLK * 64 * 2, SHM_ATTN = 2 * SHM_V + 2 * SHM_K + NW * 64 * 4;
#define KSWZ64(row, colB) ((row) * 128 + ((colB) ^ ((((row) >> 1) & 7) << 4)))
#define SBAR() __builtin_amdgcn_sched_barrier(0)
__device__ __forceinline__ int crow(int r, int hi) { return (r & 3) + 8 * (r >> 2) + 4 * hi; }
__device__ __forceinline__ unsigned cvtpk(float lo, float hi) { unsigned r; asm volatile("v_cvt_pk_bf16_f32 %0, %1, %2" : "=v"(r) : "v"(lo), "v"(hi)); return r; }

__device__ __forceinline__ void partialSM(f32x16& p0, f32x16& p1, float& m_reg, float& mn, float& alpha) {
  constexpr float C = SCALE * 1.4426950408889634f;
  float pmax = p0[0];
#pragma unroll
  for (int r = 1; r < 16; ++r) pmax = fmaxf(pmax, p0[r]);
#pragma unroll
  for (int r = 0; r < 16; ++r) pmax = fmaxf(pmax, p1[r]);
  { auto rr = __builtin_amdgcn_permlane32_swap(__float_as_uint(pmax), __float_as_uint(pmax), false, false);
    pmax = fmaxf(__uint_as_float(rr[0]), __uint_as_float(rr[1])); }
  if (__builtin_expect(__all(pmax - m_reg <= THR / SCALE), 1)) { mn = m_reg; alpha = 1.f; }
  else { mn = fmaxf(m_reg, pmax); alpha = __builtin_amdgcn_exp2f((m_reg - mn) * C); m_reg = mn; }
  float mnC = -mn * C;
#pragma unroll
  for (int r = 0; r < 16; ++r) p0[r] = fmaf(p0[r], C, mnC);
#pragma unroll
  for (int r = 0; r < 16; ++r) p1[r] = fmaf(p1[r], C, mnC);
#pragma unroll
  for (int r = 0; r < 16; ++r) p0[r] = __builtin_amdgcn_exp2f(p0[r]);
}
__device__ __forceinline__ void finishSM(f32x16& p0, f32x16& p1, float alpha, float& l_reg, bf16x8& pa0, bf16x8& pa1, bf16x8& pa2, bf16x8& pa3) {
#pragma unroll
  for (int r = 0; r < 16; ++r) p1[r] = __builtin_amdgcn_exp2f(p1[r]);
  float ps = 0;
#pragma unroll
  for (int r = 0; r < 16; ++r) ps += p0[r];
#pragma unroll
  for (int r = 0; r < 16; ++r) ps += p1[r];
  { auto rr = __builtin_amdgcn_permlane32_swap(__float_as_uint(ps), __float_as_uint(ps), false, false);
    ps = __uint_as_float(rr[0]) + __uint_as_float(rr[1]); }
  l_reg = l_reg * alpha + ps;
#define PK4(P, BASE, OUT) do { unsigned a0 = cvtpk(P[BASE + 0], P[BASE + 1]), a1 = cvtpk(P[BASE + 2], P[BASE + 3]);   \
    unsigned b0 = cvtpk(P[BASE + 4], P[BASE + 5]), b1 = cvtpk(P[BASE + 6], P[BASE + 7]);                              \
    auto r0 = __builtin_amdgcn_permlane32_swap(a0, b0, false, false); auto r1 = __builtin_amdgcn_permlane32_swap(a1, b1, false, false); \
    u32x4 w = {r0[0], r1[0], r0[1], r1[1]}; OUT = *reinterpret_cast<bf16x8*>(&w); } while (0)
  PK4(p0, 0, pa0); PK4(p0, 8, pa1); PK4(p1, 0, pa2); PK4(p1, 8, pa3);
#undef PK4
}
__device__ __forceinline__ void qkt(f32x16& p0, f32x16& p1, const char* Ks, const bf16x8* qr, int r32, int hi) {
  p0 = f32x16{}; p1 = f32x16{};
#pragma unroll
  for (int d0 = 0; d0 < 4; ++d0) { const int cb = (d0 * 16 + hi * 8) * 2;
    bf16x8 b0 = *reinterpret_cast<const bf16x8*>(Ks + KSWZ64(r32, cb));
    bf16x8 b1 = *reinterpret_cast<const bf16x8*>(Ks + KSWZ64(32 + r32, cb));
    p0 = __builtin_amdgcn_mfma_f32_32x32x16_bf16(b0, qr[d0], p0, 0, 0, 0);
    p1 = __builtin_amdgcn_mfma_f32_32x32x16_bf16(b1, qr[d0], p1, 0, 0, 0); }
}
__device__ __forceinline__ int v_st(int k, int c) { const int kk = (k & ~0xC) | ((k & 4) << 1) | ((k & 8) >> 1); return ((kk >> 3) * 4 + (c >> 5)) * 512 + ((kk & 7) * 32 + (c & 31)) * 2; }
__device__ __forceinline__ int v_rd_base(int lane) { return ((lane & 3) << 3) | (((lane >> 2) & 3) << 6) | (((lane >> 4) & 1) << 5) | (((lane >> 5) & 1) << 8); }
constexpr int v_rd_off(int d0, int ks, int half) { return d0 * 512 + ks * 4096 + half * 2048; }
template <int OFF> __device__ __forceinline__ s16x4 tr_read(int vb) {
  s16x4 r; asm volatile("ds_read_b64_tr_b16 %0, %1 offset:%2" : "=&v"(r) : "v"(vb), "i"(OFF) : "memory"); return r;
}
template <int D0> __device__ __forceinline__ void pv_one(f32x16& od, int vb, bf16x8 pa0, bf16x8 pa1, bf16x8 pa2, bf16x8 pa3) {
  const s16x4 l0 = tr_read<v_rd_off(D0, 0, 0)>(vb), h0 = tr_read<v_rd_off(D0, 0, 1)>(vb), l1 = tr_read<v_rd_off(D0, 1, 0)>(vb), h1 = tr_read<v_rd_off(D0, 1, 1)>(vb);
  const s16x4 l2 = tr_read<v_rd_off(D0, 2, 0)>(vb), h2 = tr_read<v_rd_off(D0, 2, 1)>(vb), l3 = tr_read<v_rd_off(D0, 3, 0)>(vb), h3 = tr_read<v_rd_off(D0, 3, 1)>(vb);
  asm volatile("s_waitcnt lgkmcnt(0)" ::: "memory"); SBAR();
#define PK(L, H) (bf16x8){L[0], L[1], L[2], L[3], H[0], H[1], H[2], H[3]}
  od = __builtin_amdgcn_mfma_f32_32x32x16_bf16(pa0, PK(l0, h0), od, 0, 0, 0);
  od = __builtin_amdgcn_mfma_f32_32x32x16_bf16(pa1, PK(l1, h1), od, 0, 0, 0);
  od = __builtin_amdgcn_mfma_f32_32x32x16_bf16(pa2, PK(l2, h2), od, 0, 0, 0);
  od = __builtin_amdgcn_mfma_f32_32x32x16_bf16(pa3, PK(l3, h3), od, 0, 0, 0);
#undef PK
}
__device__ __forceinline__ void pv_d0(f32x16* o, int vb, bf16x8 pa0, bf16x8 pa1, bf16x8 pa2, bf16x8 pa3) {
  pv_one<0>(o[0], vb, pa0, pa1, pa2, pa3); pv_one<1>(o[1], vb, pa0, pa1, pa2, pa3); pv_one<2>(o[2], vb, pa0, pa1, pa2, pa3); pv_one<3>(o[3], vb, pa0, pa1, pa2, pa3);
}
__device__ __forceinline__ void attn_unit(const unsigned short* Qb, const unsigned short* Kh, const unsigned short* Vh, float* Ob, int seq, char* lds, int wave_s) {
  int tid_l = wave_s * 64 + lane_id_(); asm volatile("" : "+v"(tid_l));
  const int tid = tid_l, wid = tid >> 6, lane = tid & 63, r32 = lane & 31, hi = lane >> 5;
  char* V_lds = lds; char* K_lds = lds + 2 * SHM_V;
  float* wsf = (float*)(lds + 2 * SHM_V + 2 * SHM_K) + wid * 64; float* li_l = wsf; float* al_l = wsf + 32;
  float m_reg = -1e30f, l_reg = 0; f32x16 o[4] = {}; bf16x8 qr[4];
  const unsigned short* Qw = Qb + (long)(wid * QBLK + r32) * LD + hi * 8;
#pragma unroll
  for (int d0 = 0; d0 < 4; ++d0) qr[d0] = *reinterpret_cast<const bf16x8*>(Qw + d0 * 16);
  const int sr = tid >> 4, sc = (tid & 15) * 8, vst0 = v_st(sr, sc), vst1 = v_st(32 + sr, sc);
  const int kr = tid >> 3, kc = (tid & 7) * 8, kst = KSWZ64(kr, kc * 2);
  const int vb0 = (int)(uintptr_t)V_lds + v_rd_base(lane);
  struct { bf16x8 vs0, vs1, ks0; } sr_[2];
#define SLOAD(i, k0) do { sr_[i].vs0 = *reinterpret_cast<const bf16x8*>(&Vh[(long)((k0) + sr) * LD + sc]); sr_[i].vs1 = *reinterpret_cast<const bf16x8*>(&Vh[(long)((k0) + 32 + sr) * LD + sc]); \
    sr_[i].ks0 = *reinterpret_cast<const bf16x8*>(&Kh[(long)((k0) + kr) * LD + kc]); } while (0)
#define SWRITE(b, i) do { *(bf16x8*)(V_lds + (b) * SHM_V + vst0) = sr_[i].vs0; *(bf16x8*)(V_lds + (b) * SHM_V + vst1) = sr_[i].vs1; \
    *(bf16x8*)(K_lds + (b) * SHM_K + kst) = sr_[i].ks0; } while (0)
#define SWAIT() asm volatile("s_waitcnt vmcnt(3)" ::: "memory")
#define RESC(a) do { if (__any((a) < 1.f)) { if (hi == 0) al_l[r32] = (a); asm volatile("s_waitcnt lgkmcnt(0)" ::: "memory"); \
    _Pragma("unroll") for (int d = 0; d < 4; ++d) _Pragma("unroll") for (int r = 0; r < 16; ++r) o[d][r] *= al_l[crow(r, hi)]; } } while (0)
  f32x16 pA0, pA1, pB0, pB1; float mnA, mnB, alA, alB; bf16x8 pa0, pa1, pa2, pa3; const int NT = seq / KVBLK;
  constexpr int SE = 0, SO = 1;
  SLOAD(SE, 0); SLOAD(SO, KVBLK); asm volatile("s_waitcnt vmcnt(3)" ::: "memory"); SWRITE(0, SE); __syncthreads();
  qkt(pA0, pA1, K_lds, qr, r32, hi); partialSM(pA0, pA1, m_reg, mnA, alA);
  if (2 < NT) { SLOAD(SE, 2 * KVBLK); SWAIT(); } else asm volatile("s_waitcnt vmcnt(0)" ::: "memory");
  SWRITE(1, SO); __syncthreads();
  for (int j = 1; j + 1 < NT; j += 2) {
    SBAR(); qkt(pB0, pB1, K_lds + SHM_K, qr, r32, hi);
    finishSM(pA0, pA1, alA, l_reg, pa0, pa1, pa2, pa3); SBAR();
    SLOAD(SO, (j + 2) * KVBLK); SBAR();
    pv_d0(o, vb0, pa0, pa1, pa2, pa3); partialSM(pB0, pB1, m_reg, mnB, alB);
    __syncthreads(); SWAIT(); SWRITE(0, SE);
    RESC(alB); __syncthreads();
    SBAR(); qkt(pA0, pA1, K_lds, qr, r32, hi);
    finishSM(pB0, pB1, alB, l_reg, pa0, pa1, pa2, pa3); SBAR();
    if (j + 3 < NT) SLOAD(SE, (j + 3) * KVBLK); SBAR();
    pv_d0(o, vb0 + (int)SHM_V, pa0, pa1, pa2, pa3); partialSM(pA0, pA1, m_reg, mnA, alA);
    __syncthreads(); SWAIT(); SWRITE(1, SO);
    RESC(alA); __syncthreads();
  }
  SBAR(); qkt(pB0, pB1, K_lds + SHM_K, qr, r32, hi);
  finishSM(pA0, pA1, alA, l_reg, pa0, pa1, pa2, pa3); SBAR();
  pv_d0(o, vb0, pa0, pa1, pa2, pa3); partialSM(pB0, pB1, m_reg, mnB, alB);
  __syncthreads(); RESC(alB);
  finishSM(pB0, pB1, alB, l_reg, pa0, pa1, pa2, pa3); SBAR();
  pv_d0(o, vb0 + (int)SHM_V, pa0, pa1, pa2, pa3);
  if (hi == 0) li_l[r32] = l_reg; asm volatile("s_waitcnt lgkmcnt(0)" ::: "memory");
  float rli[16];
#pragma unroll
  for (int r = 0; r < 16; ++r) rli[r] = __builtin_amdgcn_rcpf(li_l[crow(r, hi)]);
  float* Ow = Ob + (long)(wid * QBLK) * LDO;
  __syncthreads();
  { float* st = (float*)(lds + wid * 17408);
#pragma unroll
    for (int r = 0; r < 16; ++r) { const int orow = crow(r, hi);
#pragma unroll
      for (int d0 = 0; d0 < 4; ++d0) st[orow * 136 + d0 * 32 + r32] = o[d0][r] * rli[r]; }
    asm volatile("s_waitcnt lgkmcnt(0)" ::: "memory");
#pragma unroll
    for (int j = 0; j < 16; ++j) { const int row = 2 * j + hi; const f32x4 v = *(const f32x4*)(st + row * 136 + 4 * r32); *(f32x4*)(Ow + (long)row * LDO + 4 * r32) = v; } }
#undef SLOAD
#undef SWRITE
#undef SWAIT
#undef RESC
}
#undef SBAR
}

__device__ __forceinline__ void ssd_a_unit(const Args& a, int l, int rb, int h, LAS unsigned char* lds, int wave_s) {
    int tid = wave_s * 64 + lane_id_(); asm volatile("" : "+v"(tid)); const int lane = tid & 63, wave = wave_s;
    GAS unsigned char* wsg_ = (GAS unsigned char*)a.ws; asm volatile("" : "+s"(wsg_)); unsigned char* ws = (unsigned char*)wsg_;
    const float* SX = (const float*)(ws + WS_SX); const float* SDT = (const float*)(ws + WS_SDT);
    const bf16* Bb = (const bf16*)(ws + WS2_SBB); const bf16* Cb = (const bf16*)(ws + WS2_SCB);
    float* SAF = (float*)(ws + WS2_SAF); float* SS = (float*)(ws + WS2_SS); float* SDEC = (float*)(ws + WS2_SDEC);
    float* YL = (float*)(ws + WS_SY);
    const int grp = h / 5, row0 = rb * 128;
    const float Af = -__expf(a.in[LIDX(I_ALOG)][l * 20 + h]), Ab = -__expf(a.in[LIDX(I_ALOG)][l * 20 + 10 + h]);
    constexpr int PB = 136;
    LAS bf16* BT = (LAS bf16*)lds;
    LAS bf16* xT = BT + 128 * PB;
    LAS bf16* xfT = xT + 64 * PB; LAS bf16* xbT = xfT + 64 * PB;
    LAS float* vec = (LAS float*)(xbT + 64 * PB);
    LAS bf16* Bn = (LAS bf16*)(vec + 512);
    asm volatile("" : "+v"(BT), "+v"(xT), "+v"(xfT), "+v"(xbT), "+v"(vec), "+v"(Bn));
    LAS float* af = vec; LAS float* ab = vec + 128; LAS float* dtf = vec + 256; LAS float* dtb = vec + 384;
    __syncthreads();
    sc::bf16x8 bv[4]; f32x4 xv[4]; float dt0 = 0.f, dt1 = 0.f;
    { const int j = (tid & 127); const bf16* bsrc = Bb + (size_t)(row0 + j) * 256 + grp * 128 + (tid >> 7) * 32;
      const int dr = tid < 128 ? tid : 0; dt0 = SDT[(size_t)(row0 + dr) * 32 + h]; dt1 = SDT[(size_t)(row0 + dr) * 32 + 16 + h];
#pragma unroll
      for (int i = 0; i < 4; ++i) bv[i] = *(const sc::bf16x8*)(bsrc + 8 * i); }
    if (tid < 128) { dtf[tid] = dt0; dtb[tid] = dt1; }
    __syncthreads();
    { const float* xsrc = SX + (size_t)(row0 + ((tid & 127))) * 640 + h * 64 + (tid >> 7) * 16;
#pragma unroll
      for (int i = 0; i < 4; ++i) xv[i] = *(const f32x4*)(xsrc + 4 * i); }
    if (wave < 2) { const bool bw = wave == 1; const LAS float* dsrc = bw ? dtb : dtf; const float A = bw ? Ab : Af;
        const int i0 = bw ? 127 - 2 * lane : 2 * lane, i1 = bw ? i0 - 1 : i0 + 1;
        const float v0 = dsrc[i0] * A, v1 = dsrc[i1] * A; float run = v0 + v1;
        run = wave_scan_(run);
        LAS float* dst = bw ? ab : af; dst[i1] = run; dst[i0] = run - v1; }
    { const int j = (tid & 127), n0 = (tid >> 7) * 32;
#pragma unroll
      for (int i = 0; i < 4; ++i) { *(LAS sc::bf16x8*)(Bn + j * PB + n0 + 8 * i) = bv[i];
#pragma unroll
          for (int e = 0; e < 8; ++e) BT[(n0 + 8 * i + e) * PB + j] = (bf16)bv[i][e]; } }
    __syncthreads();
    { const int j = (tid & 127), p0 = (tid >> 7) * 16;
      const float wf = dtf[j] * __expf(af[127] - af[j]), wb = dtb[j] * __expf(ab[0] - ab[j]);
#pragma unroll
      for (int i = 0; i < 4; ++i) { const f32x4 v = xv[i];
#pragma unroll
          for (int e = 0; e < 4; ++e) { const int p = p0 + 4 * i + e; xT[p * PB + j] = (bf16)f2bf(v[e]); xfT[p * PB + j] = (bf16)f2bf(v[e] * wf); xbT[p * PB + j] = (bf16)f2bf(v[e] * wb); } } }
    if (tid < 128) { f32x2 w2 = {af[tid], ab[tid]}; *(f32x2*)(SAF + ((size_t)h * MT + row0 + tid) * 2) = w2; }
    if (tid == 0) { SDEC[((0 * 10 + h) * SSD_NB + rb) * 32] = __expf(af[127]); SDEC[((1 * 10 + h) * SSD_NB + rb) * 32] = __expf(ab[0]); }
    __syncthreads();
    const int fr = lane & 15, fq = lane >> 4;
    const int i_loc = 16 * wave + fr;
    const bf16* crow = Cb + (size_t)(row0 + i_loc) * 256 + grp * 128;
    sc::bf16x8 ccv[4];
#pragma unroll
    for (int ks = 0; ks < 4; ++ks) ccv[ks] = *(const sc::bf16x8*)(crow + 32 * ks + 8 * fq);
    const float afi = af[i_loc], abi = ab[i_loc];
    f32x4 yacc[4];
#pragma unroll
    for (int tp = 0; tp < 4; ++tp) yacc[tp] = (f32x4){0.f, 0.f, 0.f, 0.f};
#pragma unroll 2
    for (int s = 0; s < 4; ++s) {
        unsigned lw[4];
#pragma unroll
        for (int hh = 0; hh < 2; ++hh) { const int tj = 2 * s + hh;
            const LAS bf16* brow = Bn + (16 * tj + fr) * PB;
            f32x4 acc = {0.f, 0.f, 0.f, 0.f};
#pragma unroll
            for (int k0 = 0; k0 < 128; k0 += 32) { const sc::bf16x8 bb = *(const LAS sc::bf16x8*)(brow + k0 + 8 * fq); const sc::bf16x8 cc = ccv[k0 >> 5];
                acc = __builtin_amdgcn_mfma_f32_16x16x32_bf16(bb, cc, acc, 0, 0, 0); }
            float Lv[4];
#pragma unroll
            for (int r = 0; r < 4; ++r) { const int j = 16 * tj + 4 * fq + r;
                float f = 0.f; if (j <= i_loc) f += __expf(afi - af[j]) * dtf[j]; if (j >= i_loc) f += __expf(abi - ab[j]) * dtb[j];
                Lv[r] = acc[r] * f; }
            lw[2 * hh] = sc::cvtpk(Lv[0], Lv[1]); lw[2 * hh + 1] = sc::cvtpk(Lv[2], Lv[3]); }
        const v4u lw4 = {lw[0], lw[1], lw[2], lw[3]}; const sc::bf16x8 Lop = __builtin_bit_cast(sc::bf16x8, lw4);
#pragma unroll
        for (int tp = 0; tp < 4; ++tp) { const LAS bf16* xr = xT + (16 * tp + fr) * PB;
            const sc::bf16x4 lo = *(const LAS sc::bf16x4*)(xr + 32 * s + 4 * fq), hi = *(const LAS sc::bf16x4*)(xr + 32 * s + 16 + 4 * fq);
            const sc::bf16x8 xb = {lo[0], lo[1], lo[2], lo[3], hi[0], hi[1], hi[2], hi[3]};
            yacc[tp] = __builtin_amdgcn_mfma_f32_16x16x32_bf16(xb, Lop, yacc[tp], 0, 0, 0); }
    }
#pragma unroll
    for (int tp = 0; tp < 4; ++tp) *(f32x4*)(YL + (size_t)(row0 + i_loc) * 640 + h * 64 + 16 * tp + 4 * fq) = yacc[tp];
#pragma unroll 1
    for (int t = wave; t < 64; t += 8) { const int d = t >> 5, tp = (t >> 3) & 3, tn = t & 7;
        const LAS bf16* ar = (d ? xbT : xfT) + (16 * tp + fr) * PB; const LAS bf16* br = BT + (16 * tn + fr) * PB;
        f32x4 acc = {0.f, 0.f, 0.f, 0.f};
        acc = sc::tile_nt<128>(acc, ar, br, fq);
        *(f32x4*)(SS + ((size_t)((d * 10 + h) * SSD_NB + rb)) * 8192 + (16 * tp + fr) * 128 + 16 * tn + 4 * fq) = acc; }
}
__device__ __forceinline__ void ssd_b_phase(const Args& a, int bid, int G, int tid) {
    GAS unsigned char* wsg_ = (GAS unsigned char*)a.ws; asm volatile("" : "+s"(wsg_)); unsigned char* ws = (unsigned char*)wsg_;
    const float* SS = (const float*)(ws + WS2_SS); const float* SDEC = (const float*)(ws + WS2_SDEC); bf16* HIN = (bf16*)(ws + WS2_SHIN);
    for (int it = bid * NTHR + tid; it < 20 * 4096; it += G * NTHR) {
        const int dh = it / 4096, e2 = (it % 4096) * 2, d = dh / 10;
        float z_; asm volatile("v_mov_b32 %0, 0" : "=v"(z_));
        f32x2 H = {z_, z_};
        static_assert(SSD_NB % 33 == 0, "batches of 33 chunks");
#pragma unroll 1
        for (int s0 = 0; s0 < SSD_NB; s0 += 33) {
            f32x2 Sv[33]; float dv[33];
#pragma unroll
            for (int j = 0; j < 33; ++j) { const int s = s0 + j; const int rb = d == 0 ? s : (s < 2 ? 1 - s : SSD_NB + 1 - s);
                Sv[j] = *(const f32x2*)(SS + ((size_t)dh * SSD_NB + rb) * 8192 + e2); dv[j] = SDEC[(dh * SSD_NB + rb) * 32]; }
#pragma unroll
            for (int j = 0; j < 33; ++j) { const int s = s0 + j; const int rb = d == 0 ? s : (s < 2 ? 1 - s : SSD_NB + 1 - s);
                *(unsigned*)(HIN + ((size_t)dh * SSD_NB + rb) * 8192 + e2) = pk2(H.x, H.y); H = H * dv[j] + Sv[j]; }
        }
    }
}
__device__ __forceinline__ void ssd_c_unit(const Args& a, int rb, int h, int wave_s, float pscale = 1.f) {
    int tid_ = wave_s * 64 + lane_id_(); asm volatile("" : "+v"(tid_)); const int lane = tid_ & 63, wave = wave_s;
    GAS unsigned char* wsg_ = (GAS unsigned char*)a.ws; asm volatile("" : "+s"(wsg_)); unsigned char* ws = (unsigned char*)wsg_;
    const bf16* Cb = (const bf16*)(ws + WS2_SCB); const bf16* HIN = (const bf16*)(ws + WS2_SHIN); const float* SAF = (const float*)(ws + WS2_SAF);
    float* YL = (float*)(ws + WS_SY);
    const int fr = lane & 15, fq = lane >> 4, grp = h / 5, row = rb * 128 + 16 * wave + fr;
    const bf16* crow = Cb + (size_t)row * 256 + grp * 128;
    const f32x2 afb = *(const f32x2*)(SAF + ((size_t)h * MT + row) * 2); const float ef = __expf(afb.x), eb = __expf(afb.y);
    sc::bf16x8 cf[4];
#pragma unroll
    for (int ks = 0; ks < 4; ++ks) cf[ks] = *(const sc::bf16x8*)(crow + 32 * ks + 8 * fq);
#pragma unroll 1
    for (int tp0 = 0; tp0 < 4; tp0 += 2) {
        sc::bf16x8 hfv[2][4], hbv[2][4]; f32x4 yo[2]; float* yp[2];
#pragma unroll
        for (int j = 0; j < 2; ++j) { const int tp = tp0 + j;
            const bf16* hf = HIN + ((size_t)(0 * 10 + h) * SSD_NB + rb) * 8192 + (16 * tp + fr) * 128;
            const bf16* hb = HIN + ((size_t)(1 * 10 + h) * SSD_NB + rb) * 8192 + (16 * tp + fr) * 128;
#pragma unroll
            for (int ks = 0; ks < 4; ++ks) { hfv[j][ks] = *(const sc::bf16x8*)(hf + 32 * ks + 8 * fq); hbv[j][ks] = *(const sc::bf16x8*)(hb + 32 * ks + 8 * fq); }
            yp[j] = YL + (size_t)row * 640 + h * 64 + 16 * tp + 4 * fq; yo[j] = *(const f32x4*)yp[j]; }
#pragma unroll
        for (int j = 0; j < 2; ++j) { f32x4 yf = {0.f, 0.f, 0.f, 0.f}, yb = {0.f, 0.f, 0.f, 0.f};
#pragma unroll
            for (int ks = 0; ks < 4; ++ks) { yf = __builtin_amdgcn_mfma_f32_16x16x32_bf16(hfv[j][ks], cf[ks], yf, 0, 0, 0); yb = __builtin_amdgcn_mfma_f32_16x16x32_bf16(hbv[j][ks], cf[ks], yb, 0, 0, 0); }
            yo[j] += (yf * ef + yb * eb) * pscale; }
#pragma unroll
        for (int j = 0; j < 2; ++j) *(f32x4*)yp[j] = yo[j];
    }
}

__device__ __forceinline__ void rwkv_a_unit(const Args& a, int h, int dir, int c, LAS unsigned char* lds, int wave_s) {
    int tid = wave_s * 64 + lane_id_(); asm volatile("" : "+v"(tid)); const int lane = tid & 63, wave = wave_s;
    GAS unsigned char* wsg_ = (GAS unsigned char*)a.ws; asm volatile("" : "+s"(wsg_)); unsigned char* ws = (unsigned char*)wsg_; constexpr size_t S = (size_t)MT * 640;
    const float* RW = (const float*)(ws + WS_RW);
    float* Y = (float*)(ws + RWKV_YBUF) + dir * S;
    bf16* RQ = (bf16*)(ws + WS2_RQ) + (size_t)dir * S; bf16* TCT = (bf16*)(ws + WS2_TCT) + ((size_t)(dir * 10 + h) * RW_NC + c) * 4096; float* DC = (float*)(ws + WS2_DC) + ((size_t)(dir * 10 + h) * RW_NC + c) * 4096;
    constexpr int P = 72;
    constexpr int MB = 64 * P * 2;
    LAS bf16* mKKd = (LAS bf16*)(lds + 0 * MB);  LAS bf16* mBd = (LAS bf16*)(lds + 1 * MB);  LAS bf16* mRd = (LAS bf16*)(lds + 2 * MB);
    LAS bf16* mBeT = (LAS bf16*)(lds + 3 * MB);  LAS bf16* mKeT = (LAS bf16*)(lds + 4 * MB); LAS bf16* mVT = (LAS bf16*)(lds + 5 * MB);
    LAS bf16* mArk = (LAS bf16*)(lds + 6 * MB);  LAS bf16* mArb = (LAS bf16*)(lds + 7 * MB);
    LAS bf16* mKd = (LAS bf16*)(lds + 8 * MB);   LAS bf16* mRT = (LAS bf16*)(lds + 9 * MB);
    LAS bf16* mAkk = (LAS bf16*)(lds + 11 * MB); LAS bf16* mLoT = (LAS bf16*)(lds + 12 * MB); LAS bf16* mD = (LAS bf16*)(lds + 13 * MB); LAS bf16* mM = (LAS bf16*)(lds + 14 * MB);
    LAS float* fDg = (LAS float*)(lds + 15 * MB);
    LAS float* fWc = (LAS float*)(lds + 15 * MB + 5120);
    LAS float* fcs = (LAS float*)(lds + 11 * MB);
    asm volatile("" : "+v"(mKKd), "+v"(mBd), "+v"(mKd), "+v"(mRd), "+v"(mBeT), "+v"(mKeT), "+v"(mVT), "+v"(mAkk), "+v"(mArk), "+v"(mArb));
    asm volatile("" : "+v"(mRT), "+v"(mLoT), "+v"(mD), "+v"(mM), "+v"(fDg), "+v"(fWc), "+v"(fcs));
    LAS bf16* mXT = mKKd;
    LAS bf16* mnWmT = mKKd; LAS bf16* mnU0T = mBd;
    const int p0 = 64 * c;
    __syncthreads();
    const float* LW = RW + (3 + dir) * S;
    f32x4 gl[2][6];
    sc::bf16x8 gicl, gv, gkk, gk, gr;
    { const int t = tid >> 3, k8 = (tid & 7) * 8; const int row = seq_row(p0 + t, dir); const size_t o = (size_t)row * 640 + h * 64 + k8;
#pragma unroll
      for (int e = 0; e < 2; ++e) gl[e][0] = *(const f32x4*)(LW + o + 4 * e);
      gkk = *(const sc::bf16x8*)((const bf16*)(RW + 2 * S) + o); gk = *(const sc::bf16x8*)((const bf16*)(RW + (5 + dir) * S) + o); gr = *(const sc::bf16x8*)((const bf16*)(RW + 0 * S) + o);
      gicl = *(const sc::bf16x8*)((const bf16*)(RW + (7 + dir) * S) + o); gv = *(const sc::bf16x8*)((const bf16*)(RW + 1 * S) + o);
      *(LAS f32x4*)(fcs + t * 68 + k8) = gl[0][0]; *(LAS f32x4*)(fcs + t * 68 + k8 + 4) = gl[1][0]; }
    __syncthreads();
    { const int kc = tid & 63, tb = tid >> 6; float loc[8]; float run = 0.f;
#pragma unroll
      for (int j = 0; j < 8; ++j) { run += fcs[(8 * tb + j) * 68 + kc]; loc[j] = run; }
      fWc[64 + tid] = run;
      __syncthreads();
      float off = 0.f;
#pragma unroll
      for (int b = 0; b < 7; ++b) if (b < tb) off += fWc[64 + b * 64 + kc];
#pragma unroll
      for (int j = 0; j < 8; ++j) fcs[(8 * tb + j) * 68 + kc] = loc[j] + off;
      if (tb == 7) fWc[kc] = __expf(loc[7] + off); }
    __syncthreads();
    { const int t = tid >> 3, k8 = (tid & 7) * 8;
      float cs[8], lw[8], csC[8], kk[8], bb[8], kx[8], rr[8], vv[8], kkd[8];
#pragma unroll
      for (int e = 0; e < 8; ++e) { cs[e] = fcs[t * 68 + k8 + e]; csC[e] = fcs[63 * 68 + k8 + e]; }
#pragma unroll
      for (int e = 0; e < 8; e += 4) { const f32x4 x0 = gl[e >> 2][0];
#pragma unroll
          for (int i = 0; i < 4; ++i) { lw[e + i] = x0[i]; kk[e + i] = sc::bf2f((unsigned short)gkk[e + i]); bb[e + i] = kk[e + i] * sc::bf2f((unsigned short)gicl[e + i]); kx[e + i] = sc::bf2f((unsigned short)gk[e + i]);
              rr[e + i] = sc::bf2f((unsigned short)gr[e + i]); vv[e + i] = sc::bf2f((unsigned short)gv[e + i]); } }
      unsigned wkkd[4], wbd[4], wkd[4], wrd[4];
      float be[8], ke[8];
#pragma unroll
      for (int e = 0; e < 8; ++e) { const float ei = __expf(-cs[e]); kkd[e] = kk[e] * __expf(cs[e] - lw[e]);
          const float bd = bb[e] * ei, kd = kx[e] * ei, rd = rr[e] * __expf(cs[e]); const float ec = __expf(csC[e] - cs[e]); be[e] = bb[e] * ec; ke[e] = kx[e] * ec;
          if (e & 1) { wkkd[e >> 1] = sc::cvtpk(kkd[e - 1], kkd[e]); }
          cs[e] = bd; lw[e] = kd; csC[e] = rd; }
#pragma unroll
      for (int e = 0; e < 4; ++e) { wbd[e] = sc::cvtpk(cs[2 * e], cs[2 * e + 1]); wkd[e] = sc::cvtpk(lw[2 * e], lw[2 * e + 1]); wrd[e] = sc::cvtpk(csC[2 * e], csC[2 * e + 1]); }
      __syncthreads();
      *(LAS v4u*)(mKKd + t * P + k8) = (v4u){wkkd[0], wkkd[1], wkkd[2], wkkd[3]}; *(LAS v4u*)(mBd + t * P + k8) = (v4u){wbd[0], wbd[1], wbd[2], wbd[3]};
      *(LAS v4u*)(mKd + t * P + k8) = (v4u){wkd[0], wkd[1], wkd[2], wkd[3]};    *(LAS v4u*)(mRd + t * P + k8) = (v4u){wrd[0], wrd[1], wrd[2], wrd[3]};
      { const bool todd = (t & 1) != 0; const unsigned sel = todd ? 0x03020706u : 0x05040100u; const int rb = k8 + (todd ? 4 : 0), cb = t & ~1;
#define TW4(M, V) do { _Pragma("unroll") for (int i = 0; i < 4; ++i) { const unsigned own = sc::cvtpk(V[i], V[i + 4]); const unsigned oth = (unsigned)__builtin_amdgcn_update_dpp(0, (int)own, 0x128, 0xF, 0xF, true); \
              *(LAS unsigned*)(M + (rb + i) * P + cb) = __builtin_amdgcn_perm(oth, own, sel); } } while (0)
        TW4(mBeT, be); TW4(mKeT, ke); TW4(mVT, vv); TW4(mRT, kkd);
#undef TW4
      }
      for (int i = tid; i < 2 * MB / 16; i += NTHR) *(LAS v4u*)((LAS unsigned char*)mD + i * 16) = (v4u){0u, 0u, 0u, 0u};
    }
    __syncthreads();
    const int fr = lane & 15, fq = lane >> 4;
#pragma unroll
    for (int i8 = 0; i8 < 8; ++i8) { const int tt = wave + 8 * i8; const int m = i8 >> 1, ti = (tt >> 2) & 3, tj = tt & 3;
        f32x4 acc = {0.f, 0.f, 0.f, 0.f};
        if (m == 0) {
            u32x2 w = {0u, 0u};
            if (ti > tj) { acc = sc::tile_nt<64>(acc, mBd + (16 * tj + fr) * P, mKKd + (16 * ti + fr) * P, fq);
                w.x = sc::cvtpk(acc[0], acc[1]); w.y = sc::cvtpk(acc[2], acc[3]); }
            else if (ti == tj) { acc = sc::tile_nt<64>(acc, mKKd + (16 * ti + fr) * P, mBd + (16 * tj + fr) * P, fq);
#pragma unroll
                for (int r = 0; r < 4; ++r) if (!(4 * fq + r < fr)) acc[r] = 0.f;
                *(LAS f32x4*)(fDg + ti * 320 + fr * 20 + 4 * fq) = acc; }
            *(LAS u32x2*)(mLoT + (16 * tj + fr) * P + 16 * ti + 4 * fq) = w;
        } else {
            const LAS bf16* A = (m == 1 ? mKKd : mRd) + (16 * ti + fr) * P; const LAS bf16* Bt = (m == 3 ? mBd : mKd) + (16 * tj + fr) * P;
            if (tj <= ti) acc = sc::tile_nt<64>(acc, A, Bt, fq);
            const int t = 16 * ti + fr;
#pragma unroll
            for (int r = 0; r < 4; ++r) { const int s = 16 * tj + 4 * fq + r; const bool keep = (m == 1) ? (s < t) : (s <= t); if (!keep) acc[r] = 0.f; }
            LAS bf16* Dm = (m == 1 ? mAkk : (m == 2 ? mArk : mArb)); u32x2 w; w.x = sc::cvtpk(acc[0], acc[1]); w.y = sc::cvtpk(acc[2], acc[3]); *(LAS u32x2*)(Dm + t * P + 16 * tj + 4 * fq) = w; }
    }
    __syncthreads();
    for (int i = tid; i < 2 * MB / 16; i += NTHR) *(LAS v4u*)((LAS unsigned char*)mXT + i * 16) = (v4u){0u, 0u, 0u, 0u};
    if (wave == 0) { const int bi = lane >> 4, cI = lane & 15; const LAS float* L = fDg + bi * 320; float y[16];
#pragma unroll
        for (int r = 0; r < 16; ++r) { float va = (r == cI) ? 1.f : 0.f, vb = 0.f;
#pragma unroll
            for (int r2 = 0; r2 < r; ++r2) { if (r2 & 1) vb -= L[r * 20 + r2] * y[r2]; else va -= L[r * 20 + r2] * y[r2]; }
            y[r] = va + vb; }
#pragma unroll
        for (int r = 0; r < 16; ++r) mD[(16 * bi + r) * P + 16 * bi + cI] = (bf16)f2bf(y[r]);
    } else {
#pragma unroll 1
        for (int tt = wave - 1; tt < 16; tt += 7) { const int tv = tt >> 2, ti = tt & 3;
            f32x4 acc = {0.f, 0.f, 0.f, 0.f};
            acc = sc::tile_nt<64>(acc, mVT + (16 * tv + fr) * P, mAkk + (16 * ti + fr) * P, fq);
            u32x2 w; w.x = sc::cvtpk(acc[0], acc[1]); w.y = sc::cvtpk(acc[2], acc[3]); *(LAS u32x2*)(mRT + (64 + 16 * tv + fr) * P + 16 * ti + 4 * fq) = w; }
    }
    __syncthreads();
    f32x4 g[4];
#pragma unroll
    for (int I = 0; I < 4; ++I) { f32x4 z = {0.f, 0.f, 0.f, 0.f}; g[I] = sc::tile_nt<64>(z, mD + (16 * I + fr) * P, mRT + (16 * wave + fr) * P, fq); }
    if (wave < 6) { const int ti = wave < 1 ? 1 : (wave < 3 ? 2 : 3), tj = wave < 1 ? 0 : (wave < 3 ? wave - 1 : wave - 3);
        f32x4 z = {0.f, 0.f, 0.f, 0.f}; const f32x4 acc = sc::tile_nt<64>(z, mD + (16 * ti + fr) * P, mLoT + (16 * tj + fr) * P, fq);
        u32x2 w; w.x = sc::cvtpk(acc[0], acc[1]); w.y = sc::cvtpk(acc[2], acc[3]); *(LAS u32x2*)(mM + (16 * ti + fr) * P + 16 * tj + 4 * fq) = w; }
    __syncthreads();
#pragma unroll
    for (int I = 0; I < 4; ++I) { f32x4 acc = g[I];
        if (I > 0) acc = sc::tile_nt<64>(acc, mM + (16 * I + fr) * P, mXT + (16 * wave + fr) * P, fq);
#pragma unroll
        for (int r = 0; r < 4; ++r) mXT[(16 * wave + 4 * fq + r) * P + 16 * I + fr] = (bf16)f2bf(-acc[r]);
        asm volatile("s_waitcnt lgkmcnt(0)" ::: "memory"); }
    __syncthreads();
    constexpr int PY = 68, PR = 72;
    LAS float* oY = (LAS float*)mKd;
    LAS float* oD = oY + 64 * PY;
    LAS bf16* oR = (LAS bf16*)(oD + 64 * PY);
    LAS bf16* oT = oR + 64 * PR;
#pragma unroll
    for (int i8 = 0; i8 < 8; ++i8) { const int tt = wave + 8 * i8; const int m = i8 >> 1, ti = (tt >> 2) & 3, tj = tt & 3; const int rI = 16 * ti + fr, c4 = 16 * tj + 4 * fq;
        f32x4 acc = {0.f, 0.f, 0.f, 0.f};
        if (m == 0) {
            acc = sc::tile_nt<64>(acc, mArk + rI * P, mVT + (16 * tj + fr) * P, fq); acc = sc::tile_nt<64>(acc, mArb + rI * P, mnU0T + (16 * tj + fr) * P, fq);
            *(LAS f32x4*)(oY + rI * PY + c4) = acc;
        } else if (m == 1) {
            const LAS bf16* rp = mRd + rI * P + c4;
#pragma unroll
            for (int r = 0; r < 4; ++r) acc[r] = sc::bf2f(rp[r]);
            acc = sc::tile_nt<64>(acc, mArb + rI * P, mnWmT + (16 * tj + fr) * P, fq);
            u32x2 w; w.x = sc::cvtpk(acc[0], acc[1]); w.y = sc::cvtpk(acc[2], acc[3]); *(LAS u32x2*)(oR + rI * PR + c4) = w;
        } else if (m == 2) {
            acc = sc::tile_nt<64>(acc, mBeT + rI * P, mnWmT + (16 * tj + fr) * P, fq);
#pragma unroll
            for (int r = 0; r < 4; ++r) if (c4 + r == rI) acc[r] += fWc[rI];
            u32x2 w; w.x = sc::cvtpk(acc[0], acc[1]); w.y = sc::cvtpk(acc[2], acc[3]); *(LAS u32x2*)(oT + rI * PR + c4) = w;
        } else {
            acc = sc::tile_nt<64>(acc, mVT + rI * P, mKeT + (16 * tj + fr) * P, fq); acc = sc::tile_nt<64>(acc, mnU0T + rI * P, mBeT + (16 * tj + fr) * P, fq);
            *(LAS f32x4*)(oD + rI * PY + c4) = acc;
        }
    }
    __syncthreads();
    { const int r8 = tid >> 3, q8 = tid & 7;
      const size_t yrow = (size_t)seq_row(p0 + r8, dir) * 640 + h * 64;
      *(f32x4*)(Y + yrow + 4 * q8) = *(const LAS f32x4*)(oY + r8 * PY + 4 * q8); *(f32x4*)(Y + yrow + 32 + 4 * q8) = *(const LAS f32x4*)(oY + r8 * PY + 32 + 4 * q8);
      *(v4u*)(RQ + (size_t)(p0 + r8) * 640 + h * 64 + 8 * q8) = *(const LAS v4u*)(oR + r8 * PR + 8 * q8);
      *(v4u*)(TCT + tid * 8) = *(const LAS v4u*)(oT + r8 * PR + 8 * q8);
      *(f32x4*)(DC + tid * 4) = *(const LAS f32x4*)(oD + (tid >> 4) * PY + (tid & 15) * 4); *(f32x4*)(DC + 2048 + tid * 4) = *(const LAS f32x4*)(oD + ((tid >> 4) + 32) * PY + (tid & 15) * 4); }
}
__device__ __forceinline__ void rwkv_b_task(const Args& a, int h, int dir, LAS unsigned char* lds, int tid, int lane, int wave) {
    GAS unsigned char* wsg_ = (GAS unsigned char*)a.ws; asm volatile("" : "+s"(wsg_)); unsigned char* ws = (unsigned char*)wsg_;
    const bf16* TCT = (const bf16*)(ws + WS2_TCT) + (size_t)(dir * 10 + h) * RW_NC * 4096; const float* DC = (const float*)(ws + WS2_DC) + (size_t)(dir * 10 + h) * RW_NC * 4096;
    bf16* SIN = (bf16*)(ws + WS2_SIN) + (size_t)(dir * 10 + h) * RW_NC * 4096;
    constexpr int P = 72;
    LAS bf16* Sb0 = (LAS bf16*)lds; LAS bf16* Sb1 = Sb0 + 64 * P;
    const int fr = lane & 15, fq = lane >> 4;
    __syncthreads();
    for (int i = tid; i < 64 * P; i += NTHR) Sb0[i] = 0;
    __syncthreads();
    const int tv = wave >> 1, tk0 = 2 * (wave & 1); const int v = 16 * tv + fr;
    sc::bf16x8 tq0[2][2], tq1[2][2], tq2[2][2], tq3[2][2], tq4[2][2], tq5[2][2]; f32x4 dq0[2], dq1[2], dq2[2], dq3[2], dq4[2], dq5[2];
#define RWB_LOAD(tq, dq, c_) do { const int cc_ = (c_) < RW_NC ? (c_) : RW_NC - 1; const bf16* tct_ = TCT + (size_t)cc_ * 4096; const float* dc_ = DC + (size_t)cc_ * 4096; \
        _Pragma("unroll") for (int q = 0; q < 2; ++q) { const int tk = tk0 + q; dq[q] = *(const f32x4*)(dc_ + v * 64 + 16 * tk + 4 * fq); \
            _Pragma("unroll") for (int ks = 0; ks < 2; ++ks) tq[q][ks] = *(const sc::bf16x8*)(tct_ + (16 * tk + fr) * 64 + 32 * ks + 8 * fq); } } while (0)
#define RWB_STEP(tq, dq, c_, Sc, Sn) do { \
        { const v4u sin_ = *(const LAS v4u*)(Sc + (tid >> 3) * P + (tid & 7) * 8); *(v4u*)(SIN + (size_t)(c_) * 4096 + (tid >> 3) * 64 + (tid & 7) * 8) = sin_; }     \
        _Pragma("unroll") for (int q = 0; q < 2; ++q) { const int tk = tk0 + q; const int k4 = 16 * tk + 4 * fq; \
            f32x4 acc = dq[q]; \
            _Pragma("unroll") for (int ks = 0; ks < 2; ++ks) { const sc::bf16x8 sa = *(const LAS sc::bf16x8*)(Sc + v * P + 32 * ks + 8 * fq); acc = __builtin_amdgcn_mfma_f32_16x16x32_bf16(tq[q][ks], sa, acc, 0, 0, 0); } \
            u32x2 w; w.x = sc::cvtpk(acc[0], acc[1]); w.y = sc::cvtpk(acc[2], acc[3]); *(LAS u32x2*)(Sn + v * P + k4) = w; } \
        asm volatile("s_waitcnt lgkmcnt(0)" ::: "memory"); __builtin_amdgcn_s_barrier(); asm volatile("" ::: "memory"); } while (0)
    RWB_LOAD(tq0, dq0, 0); RWB_LOAD(tq1, dq1, 1); RWB_LOAD(tq2, dq2, 2); RWB_LOAD(tq3, dq3, 3); RWB_LOAD(tq4, dq4, 4);
    static_assert(RW_NC % 6 == 0, "ring of 6");
    for (int c = 0; c < RW_NC; c += 6) {
        RWB_LOAD(tq5, dq5, c + 5); RWB_STEP(tq0, dq0, c, Sb0, Sb1);
        RWB_LOAD(tq0, dq0, c + 6); RWB_STEP(tq1, dq1, c + 1, Sb1, Sb0);
        RWB_LOAD(tq1, dq1, c + 7); RWB_STEP(tq2, dq2, c + 2, Sb0, Sb1);
        RWB_LOAD(tq2, dq2, c + 8); RWB_STEP(tq3, dq3, c + 3, Sb1, Sb0);
        RWB_LOAD(tq3, dq3, c + 9); RWB_STEP(tq4, dq4, c + 4, Sb0, Sb1);
        RWB_LOAD(tq4, dq4, c + 10); RWB_STEP(tq5, dq5, c + 5, Sb1, Sb0);
    }
    asm volatile("s_waitcnt vmcnt(0)" ::: "memory");
    __syncthreads();
#undef RWB_LOAD
#undef RWB_STEP
}
__device__ __forceinline__ void rwkv_c_unit(const Args& a, int dir, int c, int wave_s, float pscale = 1.f) {
    int tid_ = wave_s * 64 + lane_id_(); asm volatile("" : "+v"(tid_)); const int lane = tid_ & 63, wave = wave_s;
    GAS unsigned char* wsg_ = (GAS unsigned char*)a.ws; asm volatile("" : "+s"(wsg_)); unsigned char* ws = (unsigned char*)wsg_; constexpr size_t S = (size_t)MT * 640;
    const bf16* RQ = (const bf16*)(ws + WS2_RQ) + (size_t)dir * S; float* Y = (float*)(ws + RWKV_YBUF) + dir * S;
    const int fr = lane & 15, fq = lane >> 4, p0 = 64 * c;
#pragma unroll 1
    for (int t0 = wave; t0 < 160; t0 += 40) {
        sc::bf16x8 af[5][2], bfv[5][2]; f32x4 yo[5]; float* yp[5];
#pragma unroll
        for (int j = 0; j < 5; ++j) { const int tt = t0 + 8 * j; const int h = tt >> 4, ti = (tt >> 2) & 3, tv = tt & 3;
            const bf16* sin = (const bf16*)(ws + WS2_SIN) + ((size_t)(dir * 10 + h) * RW_NC + c) * 4096 + (16 * tv + fr) * 64;
            const bf16* rq = RQ + (size_t)(p0 + 16 * ti + fr) * 640 + h * 64;
            af[j][0] = *(const sc::bf16x8*)(rq + 8 * fq); af[j][1] = *(const sc::bf16x8*)(rq + 32 + 8 * fq); bfv[j][0] = *(const sc::bf16x8*)(sin + 8 * fq); bfv[j][1] = *(const sc::bf16x8*)(sin + 32 + 8 * fq);
            yp[j] = Y + (size_t)seq_row(p0 + 16 * ti + fr, dir) * 640 + h * 64 + 16 * tv + 4 * fq; yo[j] = *(const f32x4*)yp[j]; }
#pragma unroll
        for (int j = 0; j < 5; ++j) { f32x4 acc = {0.f, 0.f, 0.f, 0.f};
            acc = __builtin_amdgcn_mfma_f32_16x16x32_bf16(bfv[j][0], af[j][0], acc, 0, 0, 0); acc = __builtin_amdgcn_mfma_f32_16x16x32_bf16(bfv[j][1], af[j][1], acc, 0, 0, 0);
            yo[j] += acc * pscale; }
#pragma unroll
        for (int j = 0; j < 5; ++j) *(f32x4*)yp[j] = yo[j];
    }
}
__device__ __forceinline__ void rwkv_scan_task(const Args& a, int h, int dir, LAS unsigned char* lds, int tid, int lane, int wave) {
    unsigned char* ws = a.ws; constexpr size_t S = (size_t)MT * 640;
    const float* RW = (const float*)(ws + WS_RW);
    const float* arr[6] = { RW + 2 * S  , RW + (7 + dir) * S  , RW + (3 + dir) * S  , RW + (5 + dir) * S  , RW + 0 * S  , RW + 1 * S   };
    float* Y = (float*)(ws + WS_RY) + dir * S;
    LAS float* tile = (LAS float*)lds;
    const int rr = lane >> 2, kq = lane & 3, vrow = wave * 16 + rr;
    float st[16];
#pragma unroll
    for (int j = 0; j < 16; ++j) st[j] = 0.f;
    for (int p0 = 0; p0 < MT; p0 += 32) {
        __syncthreads();
        { const int s = tid >> 4, q4 = tid & 15; const int row = seq_row(p0 + s, dir);
#pragma unroll
          for (int i = 0; i < 6; ++i) { f32x4 vv_ = *(const f32x4*)(arr[i] + (size_t)row * 640 + h * 64 + 4 * q4); if (i == 2) { vv_.x = expf(vv_.x); vv_.y = expf(vv_.y); vv_.z = expf(vv_.z); vv_.w = expf(vv_.w); } *(LAS f32x4*)(tile + (i * 32 + s) * 64 + 4 * q4) = vv_; } }
        __syncthreads();
        if (wave < 4) {
            for (int s = 0; s < 32; ++s) {
                const LAS float* tk = tile + (0 * 32 + s) * 64 + 16 * kq; const LAS float* tb = tile + (1 * 32 + s) * 64 + 16 * kq; const LAS float* tw = tile + (2 * 32 + s) * 64 + 16 * kq;
                const LAS float* tkk = tile + (3 * 32 + s) * 64 + 16 * kq; const LAS float* tr = tile + (4 * 32 + s) * 64 + 16 * kq;
                const float vv = tile[(5 * 32 + s) * 64 + vrow];
                float sa = 0.f;
#pragma unroll
                for (int j = 0; j < 16; ++j) sa += st[j] * tk[j];
                sa = quad_sum(sa);
                float y = 0.f;
#pragma unroll
                for (int j = 0; j < 16; ++j) { st[j] = st[j] * tw[j] - sa * tb[j] + vv * tkk[j]; y += st[j] * tr[j]; }
                y = quad_sum(y);
                if (kq == 0) Y[(size_t)seq_row(p0 + s, dir) * 640 + h * 64 + vrow] = y;
            }
        }
    }
    __syncthreads();
}
__device__ __forceinline__ void ssd_scan_task(const Args& a, int l, int h, int dir, LAS unsigned char* lds, int tid, int lane, int wave) {
    unsigned char* ws = a.ws; constexpr size_t S = (size_t)MT * 640;
    const float* SX = (const float*)(ws + WS_SX); const bf16* SBb = (const bf16*)(ws + WS2_SBB); const bf16* SCb = (const bf16*)(ws + WS2_SCB); const float* SDT = (const float*)(ws + WS_SDT);
    float* Y = (float*)(ws + WS_SY) + dir * S;
    const float A = -expf(a.in[I_ALOG][l * 20 + dir * 10 + h]);
    const int grp = h / 5;
    LAS float* tB = (LAS float*)lds;
    LAS float* tC = tB + 32 * 128;
    LAS float* tX = tC + 32 * 128;
    LAS float* tD = tX + 32 * 64;
    const int rr = lane >> 2, kq = lane & 3, prow = wave * 16 + rr;
    float st[32];
#pragma unroll
    for (int j = 0; j < 32; ++j) st[j] = 0.f;
    for (int p0 = 0; p0 < MT; p0 += 32) {
        __syncthreads();
#pragma unroll
        for (int i = 0; i < 2; ++i) { const int idx = tid + 512 * i, s = idx >> 5, q4 = idx & 31; const int row = seq_row(p0 + s, dir);
            const sc::bf16x4 b4 = *(const sc::bf16x4*)(SBb + (size_t)row * 256 + grp * 128 + 4 * q4), c4 = *(const sc::bf16x4*)(SCb + (size_t)row * 256 + grp * 128 + 4 * q4);
            *(LAS f32x4*)(tB + s * 128 + 4 * q4) = (f32x4){sc::bf2f(b4[0]), sc::bf2f(b4[1]), sc::bf2f(b4[2]), sc::bf2f(b4[3])};
            *(LAS f32x4*)(tC + s * 128 + 4 * q4) = (f32x4){sc::bf2f(c4[0]), sc::bf2f(c4[1]), sc::bf2f(c4[2]), sc::bf2f(c4[3])}; }
        { const int s = tid >> 4, q4 = tid & 15; const int row = seq_row(p0 + s, dir);
          *(LAS f32x4*)(tX + s * 64 + 4 * q4) = *(const f32x4*)(SX + (size_t)row * 640 + h * 64 + 4 * q4); }
        if (tid < 32) tD[tid] = SDT[(size_t)seq_row(p0 + tid, dir) * 32 + dir * 16 + h];
        __syncthreads();
        if (wave < 4) {
            for (int s = 0; s < 32; ++s) {
                const float dt = tD[s]; const float dA = expf(dt * A); const float cf = dt * tX[s * 64 + prow];
                const LAS float* pb = tB + s * 128 + 32 * kq; const LAS float* pc = tC + s * 128 + 32 * kq;
                float y = 0.f;
#pragma unroll
                for (int j = 0; j < 32; ++j) { st[j] = st[j] * dA + cf * pb[j]; y += st[j] * pc[j]; }
                y = quad_sum(y);
                if (kq == 0) Y[(size_t)seq_row(p0 + s, dir) * 640 + h * 64 + prow] = y;
            }
        }
    }
    __syncthreads();
}

#ifndef MK_SINGLE
#ifdef RWKV_DEBUG
#define MK_SINGLE 0
#else
#define MK_SINGLE 1
#endif
#endif
enum Phase { PH_PRE = 0, PH_NORM1, PH_INPROJ, PH_PREP, PH_SCAN_A, PH_ATTN, PH_SCAN_B  , PH_SCAN_C, PH_MIXFIN, PH_OUTPROJ, PH_NORM2, PH_FFN1, PH_FFN2, PH_COUNT };

constexpr unsigned KM_ALL = 0xFFFFu, KM_GEMM = (1u << PH_INPROJ) | (1u << PH_OUTPROJ) | (1u << PH_FFN1) | (1u << PH_FFN2), KM_REST = KM_ALL & ~KM_GEMM;
__device__ __forceinline__ bool run_here(int single, int layer, int phase, int l, int k) { asm volatile("" : "+s"(single), "+s"(layer), "+s"(phase)); return single || (layer == l && phase == k); }
template <unsigned PHM> __global__ void __launch_bounds__(NTHR, 2) fwd_kernel(Args a) {
    extern __shared__ __attribute__((aligned(16))) unsigned char lds_raw[];
    LAS unsigned char* lds = (LAS unsigned char*)lds_raw;
    int G = gridDim.x, bid = blockIdx.x, NGW = G * NWAVES;
    const int wave_s = __builtin_amdgcn_readfirstlane((int)threadIdx.x >> 6);
    int tid = wave_s * 64 + lane_id_(), lane = tid & 63, wave = wave_s, gw = bid * NWAVES + wave;
#define FRESH() do { tid = wave_s * 64 + lane_id_(); asm volatile("" : "+v"(tid)); lane = tid & 63; wave = wave_s; bid = blockIdx.x; G = gridDim.x; asm volatile("" : "+s"(bid), "+s"(G)); NGW = G * NWAVES; gw = bid * NWAVES + wave; { GAS unsigned char* wsg_ = (GAS unsigned char*)a.ws; asm volatile("" : "+s"(wsg_)); ws = (unsigned char*)wsg_; } } while (0)
    unsigned char* ws = a.ws;
    volatile LAS unsigned* MISC = (volatile LAS unsigned*)(lds + MISC_OFF);
    if (tid < 64) MISC[tid] = 0u;
    __syncthreads();
    XcdBarrier bar; bar.bar = (unsigned*)(ws + WS_CTL) + CW_BAR; bar.x = 0; bar.st = nullptr;
    if (a.single) bar = xcd_barrier_post((unsigned*)(ws + WS_CTL) + CW_BAR, MISC + 8, tid == 0);
#define RUN(l_, k_) (((PHM >> (k_)) & 1u) && run_here(a.single, a.layer, a.phase, (l_), (k_)))
#ifndef DUPMASK
#define DUPMASK 0u
#endif
#define NREP(k_) (((DUPMASK >> (k_)) & 1u) ? 2 : 1)
#ifndef NSEAM
#define NSEAM 1
#endif
#define SEAM() do { int sg_ = a.single; asm volatile("" : "+s"(sg_)); if (sg_) { for (int sr_ = 0; sr_ < NSEAM; ++sr_) xcd_barrier(bar, (wave_s * 64 + lane_id_()) == 0); } } while (0)

    if (RUN(0, PH_PRE)) for (int rep_ = 0; rep_ < NREP(PH_PRE); ++rep_) { FRESH(); pre_phase(a, lds, tid, lane, wave, bid, G); SEAM(); }

    const int l_lo = a.single ? 0 : a.layer, l_hi = a.single ? DEPTH : a.layer + 1;
    for (int l = l_lo; l < l_hi; ++l) {
#define xl_in ((l == 0) ? a.in[LIDX(I_X)] : (const float*)a.out)
#define xc_in ((l == 0) ? a.in[LIDX(I_CTX)] : (const float*)(ws + WS_XC))
#define xl_out (a.out)
#define xc_out ((float*)(ws + WS_XC))
#define modl ((const float*)(ws + WS_MOD) + (size_t)l * 2 * 12288)
#define H ((bf16*)(ws + WS_H))

        if (RUN(l, PH_NORM1)) for (int rep_ = 0; rep_ < NREP(PH_NORM1); ++rep_) { FRESH();
            if (l == 0) { mod_reduce(a, 0, 32, bid, G, tid); SEAM(); FRESH(); }
            norm_phase(xl_in, xc_in, a.in[LIDX(I_N1G)] + l * DM, modl, 0, H, gw, NGW, lane, l > 0 ? KS_F2 : 0, (const float*)(ws + WS3_SLAB), modl - 2 * 12288 + 12288 + 5 * DM, xc_out, lds, wave, bid, G); SEAM(); }

        if (RUN(l, PH_INPROJ)) for (int rep_ = 0; rep_ < NREP(PH_INPROJ); ++rep_) {
            FRESH();
            pg8::Gemm g{(const pg8::bf16_t*)H, (const pg8::bf16_t*)(ws + WS_WIN + l * SZ_WIN), MT, INP, DM}; pg8::StaticOrder S; S.init(MT, INP, G, bid);
            EpiStoreBf16 E{(bf16*)(ws + WS_U), INP};
            pg8::gemm_phase<EpiStoreBf16, pg8::StaticOrder, true, true>(lds, g, S, E, wave_s);
            if (l + 1 < DEPTH) {
                const int nun_ = (MT / 256) * (INP / 256), rounds_ = (nun_ + G - 1) / G; int first_idle = nun_ - (rounds_ - 1) * G; if (first_idle >= G) first_idle = 0;
                if (bid >= first_idle) convert_items(a, l + 1, (LAS float*)(lds + wave * 17408), lane, (bid - first_idle) * NWAVES + wave, (G - first_idle) * NWAVES); }
            SEAM();
        }

        if (RUN(l, PH_PREP)) for (int rep_ = 0; rep_ < NREP(PH_PREP); ++rep_) { FRESH(); { const int nrw = (MT / PREP_RI < G - 64) ? MT / PREP_RI : G / 2;
              if (bid < nrw) { prep_rwkv(a, l, lds, tid, lane, wave, bid, nrw);
#ifdef PROBE_PRW2
                  prep_rwkv(a, l, lds, tid, lane, wave, bid, nrw);
#endif
              } else { prep_rows(a, l, (bid - nrw) * NWAVES + wave, (G - nrw) * NWAVES, lane);
#ifdef PROBE_PRR2
                  prep_rows(a, l, (bid - nrw) * NWAVES + wave, (G - nrw) * NWAVES, lane);
#endif
              } } SEAM(); }

#ifndef NATT_A
#define NATT_A 148
#endif
#define ATTN_UNIT(u_) do { const int u__ = (u_); __syncthreads(); \
            if (u__ < 384) { const int vh = u__ >> 5, qb = u__ & 31; \
                att::attn_unit(Qb + (size_t)(CTX + 256 * qb) * 768 + vh * 64, Kb + vh * 64, Vb + (vh >> 1) * 128, AO + (size_t)(CTX + 256 * qb) * 1536 + vh * 128, MT, (char*)lds_raw, wave_s); \
            } else { const int vh = u__ - 384; \
                att::attn_unit(Qb + vh * 64, Kb + vh * 64, Vb + (vh >> 1) * 128, AO + vh * 128, CTX, (char*)lds_raw, wave_s); } } while (0)
        if (RUN(l, PH_SCAN_A)) {
            FRESH();
            const unsigned short* Qb = (const unsigned short*)(ws + WS_Q); const unsigned short* Kb = (const unsigned short*)(ws + WS_K); const unsigned short* Vb = (const unsigned short*)(ws + WS_V);
            float* AO = (float*)(ws + WS_AO);
            for (int u = bid; u < NATT_A + 12; u += G) { if (u < NATT_A) ATTN_UNIT(u); else if (l < DEPTH - 1) ATTN_UNIT(384 + (u - NATT_A)); }
            unsigned* qctr = (unsigned*)(ws + WS_CTL) + CW_QUEUE + 64 * l;
            unsigned qnext = 0u; if (tid == 0) qnext = __hip_atomic_fetch_add(qctr, 1u, __ATOMIC_RELAXED, __HIP_MEMORY_SCOPE_AGENT);
            for (;;) {
                __syncthreads();
                if (tid == 0) MISC[16] = qnext;
                __syncthreads();
                const int u = (int)MISC[16];
                if (u >= 2640 + 660) break;
                if (tid == 0) qnext = __hip_atomic_fetch_add(qctr, 1u, __ATOMIC_RELAXED, __HIP_MEMORY_SCOPE_AGENT);
                if (u < 2640) { const int c = u / 20, hd = u % 20; rwkv_a_unit(a, hd >> 1, hd & 1, c, lds, wave_s); }
                else { const int v = u - 2640; ssd_a_unit(a, l, v / 10, v % 10, lds, wave_s); }
            }
            __syncthreads();
            SEAM();
        }

        if (RUN(l, PH_ATTN)) {
            FRESH();
            if (G >= 236) { if (bid < 20) rwkv_b_task(a, bid >> 1, bid & 1, lds, tid, lane, wave); else if (bid < 236) ssd_b_phase(a, bid - 20, 216, tid); }
            else { for (int t = bid; t < 20; t += G) rwkv_b_task(a, t >> 1, t & 1, lds, tid, lane, wave); ssd_b_phase(a, bid, G, tid); }
            const unsigned short* Qb = (const unsigned short*)(ws + WS_Q); const unsigned short* Kb = (const unsigned short*)(ws + WS_K); const unsigned short* Vb = (const unsigned short*)(ws + WS_V);
            float* AO = (float*)(ws + WS_AO);
#ifndef PROBE_AT
#define PROBE_AT 1
#endif
            if (G > 20) { for (int u = NATT_A + (bid - 20); bid >= 20 && u < 384; u += (G - 20)) { for (int pr_ = 0; pr_ < PROBE_AT; ++pr_) ATTN_UNIT(u); } } else { for (int u = NATT_A + bid; u < 384; u += G) ATTN_UNIT(u); }
            __syncthreads();
            SEAM();
        }
#undef ATTN_UNIT

        if (RUN(l, PH_SCAN_C)) for (int rep_ = 0; rep_ < NREP(PH_SCAN_C); ++rep_) {
            FRESH();
            const float psc = rep_ ? 0.f : 1.f;
            for (int u = bid; u < 264 + 660; u += G) {
                if (u < 264) rwkv_c_unit(a, u & 1, u >> 1, wave_s, psc);
                else { const int v = u - 264; ssd_c_unit(a, v / 10, v % 10, wave_s, psc); }
            }
            SEAM();
        }

        if (RUN(l, PH_MIXFIN)) for (int rep_ = 0; rep_ < NREP(PH_MIXFIN); ++rep_) { FRESH();
#ifdef RWKV_DEBUG
            { const float* R0 = (const float*)(ws + WS_RY); const float* R1 = (const float*)(ws + WS3_RYALT); unsigned* flag = (unsigned*)(ws + WS_CTL) + CW_DBG;
              for (int row = gw; row < 2 * MT; row += NGW) { const int dirr = row / MT, rr_ = row % MT;
                  if (!(DBG_ROW_OK(dirr, rr_))) continue;
                  float mr = 0.f, md = 0.f; bool bad = false;
                  for (int i = 0; i < 10; ++i) { const size_t o = (size_t)row * 640 + i * 64 + lane; const float x0 = R0[o], x1 = R1[o]; mr = fmaxf(mr, fabsf(x0)); md = fmaxf(md, fabsf(x0 - x1)); if (!(fabsf(x1) < 1e30f)) bad = true; }
                  for (int o = 1; o < 64; o <<= 1) { mr = fmaxf(mr, __shfl_xor(mr, o)); md = fmaxf(md, __shfl_xor(md, o)); }
                  if (__any(bad)) { if (lane == 0) atomicOr(flag, 2u); }
                  else if (md > DBG_TOL * (mr + 1e-3f)) { if (lane == 0) atomicOr(flag, dirr == 1 ? 8u : (rr_ < 64 ? 1u : 4u)); } } }
#endif
            mixfin_phase(a, l, gw, NGW, lane); SEAM(); }

        if (RUN(l, PH_OUTPROJ)) {
            FRESH();
            if (l == DEPTH - 1) {
                pg8::Gemm g{(const pg8::bf16_t*)(ws + WS_MIX) + (size_t)CTX * DM, (const pg8::bf16_t*)(ws + WS_WOUT + l * SZ_WOUT), SEQ, DM, DM}; pg8::StaticOrder S; S.init(SEQ, DM, G, bid);
                EpiResid E{xl_in, xc_in, xl_out, xc_out, modl + 2 * DM, modl + 12288 + 2 * DM, 1, nullptr};
                pg8::gemm_phase<EpiResid, pg8::StaticOrder, true, true>(lds, g, S, E, wave_s);
            } else {
                pg8::Gemm g{(const pg8::bf16_t*)(ws + WS_MIX), (const pg8::bf16_t*)(ws + WS_WOUT + l * SZ_WOUT), MT, DM, DM}; SplitOrder S; S.init(SEQ, DM, G, bid, KS_OUT, (DM / 64) / KS_OUT);
                EpiResid E{xl_in, xc_in, xl_out, xc_out, modl + 2 * DM, modl + 12288 + 2 * DM, 0, (float*)(ws + WS3_SLAB)};
                pg8::gemm_phase<EpiResid, SplitOrder, true, true>(lds, g, S, E, wave_s);
            }
            SEAM();
        }

        if (RUN(l, PH_NORM2)) for (int rep_ = 0; rep_ < NREP(PH_NORM2); ++rep_) { FRESH(); norm_phase(xl_out, xc_in, a.in[LIDX(I_N2G)] + l * DM, modl, 3, H, gw, NGW, lane, l < DEPTH - 1 ? KS_OUT : -1, (const float*)(ws + WS3_SLAB), modl + 12288 + 2 * DM, xc_out, lds, wave, bid, G); SEAM(); }

        if (RUN(l, PH_FFN1)) for (int rep_ = 0; rep_ < NREP(PH_FFN1); ++rep_) {
            FRESH();
            const int skip = (l == DEPTH - 1) ? 1 : 0;
            pg8::Gemm g{(const pg8::bf16_t*)H + (size_t)skip * CTX * DM, (const pg8::bf16_t*)(ws + WS_WF1 + l * SZ_WF1), MT - skip * CTX, 2 * DFF, DM}; pg8::StaticOrder S; S.init(MT - skip * CTX, 2 * DFF, G, bid);
            EpiSwiglu E{(bf16*)(ws + WS_G) + (size_t)skip * CTX * DFF};
            pg8::gemm_phase<EpiSwiglu, pg8::StaticOrder, true, true>(lds, g, S, E, wave_s);
            if (l + 1 < DEPTH) {
                const int nun_ = (MT / 256) * (2 * DFF / 256), rounds_ = (nun_ + G - 1) / G; int first_idle = nun_ - (rounds_ - 1) * G; if (first_idle >= G) first_idle = 0;
                if (bid >= first_idle) mod_tasks(a, l + 1, 13, (bid - first_idle) * NWAVES + wave, (G - first_idle) * NWAVES, lane); }
            SEAM();
        }

        if (RUN(l, PH_FFN2)) {
            FRESH();
            if (l + 1 < DEPTH) { mod_reduce(a, l + 1, 13, bid, G, tid); FRESH(); }
            if (l == DEPTH - 1) {
                pg8::Gemm g{(const pg8::bf16_t*)(ws + WS_G) + (size_t)CTX * DFF, (const pg8::bf16_t*)(ws + WS_WF2 + l * SZ_WF2), SEQ, DM, DFF}; pg8::StaticOrder S; S.init(SEQ, DM, G, bid);
                EpiResid E{xl_out, xc_out, xl_out, xc_out, modl + 5 * DM, modl + 12288 + 5 * DM, 1, nullptr};
                pg8::gemm_phase<EpiResid, pg8::StaticOrder, true, true>(lds, g, S, E, wave_s);
            } else {
                pg8::Gemm g{(const pg8::bf16_t*)(ws + WS_G), (const pg8::bf16_t*)(ws + WS_WF2 + l * SZ_WF2), MT, DM, DFF}; SplitOrder S; S.init(SEQ, DM, G, bid, KS_F2, (DFF / 64) / KS_F2);
                EpiResid E{xl_out, xc_out, xl_out, xc_out, modl + 5 * DM, modl + 12288 + 5 * DM, 0, (float*)(ws + WS3_SLAB)};
                pg8::gemm_phase<EpiResid, SplitOrder, true, true>(lds, g, S, E, wave_s);
            }
            SEAM();
        }
    }
#ifdef RWKV_DEBUG
    if (a.phase == 99) { FRESH(); const unsigned f = __hip_atomic_load((unsigned*)(ws + WS_CTL) + CW_DBG, __ATOMIC_RELAXED, __HIP_MEMORY_SCOPE_AGENT);
      if (f & DBG_POISON_MASK) { for (size_t i = (size_t)bid * NTHR + tid; i < (size_t)SEQ * DM; i += (size_t)G * NTHR) a.out[i] = 1e30f * (float)(1u + f); } }
#endif
#undef RUN
#undef SEAM
#undef xl_in
#undef xc_in
#undef xl_out
#undef xc_out
#undef modl
#undef H
}

#ifdef RWKV_DEBUG
__global__ void __launch_bounds__(NTHR, 2) dbg_naive_kernel(Args a) {
    extern __shared__ __attribute__((aligned(16))) unsigned char lds_raw[];
    LAS unsigned char* lds = (LAS unsigned char*)lds_raw;
    const int tid = threadIdx.x, lane = tid & 63, wave = __builtin_amdgcn_readfirstlane(tid >> 6), bid = blockIdx.x;
    if (bid < 20) rwkv_scan_task(a, bid >> 1, bid & 1, lds, tid, lane, wave);
}
#endif
extern "C" void kernel_launch(void* const* d_in, const int* in_sizes, int n_in, void* d_out, int out_size, void* d_ws, size_t ws_size, hipStream_t stream) {
    static int grid = 0;
    if (grid == 0) {
        if (n_in != 33 || out_size != SEQ * DM || ws_size < WS3_RYALT) { fprintf(stderr, "kernel_launch: unexpected shapes: n_in %d out %d ws %zu (need %zu)\n", n_in, out_size, ws_size, (size_t)WS3_RYALT); grid = -1; return; }
        int dev = 0, cus = 0, per_cu = 0;
        if (hipGetDevice(&dev) != hipSuccess || hipDeviceGetAttribute(&cus, hipDeviceAttributeMultiprocessorCount, dev) != hipSuccess) { grid = -1; return; }
#ifdef RWKV_DEBUG
        (void)hipFuncSetAttribute((const void*)dbg_naive_kernel, hipFuncAttributeMaxDynamicSharedMemorySize, LDS_BYTES);
#endif
#if MK_SINGLE
        if (hipFuncSetAttribute((const void*)fwd_kernel<KM_ALL>, hipFuncAttributeMaxDynamicSharedMemorySize, LDS_BYTES) != hipSuccess) { fprintf(stderr, "kernel_launch: hipFuncSetAttribute failed\n"); grid = -1; return; }
        if (hipOccupancyMaxActiveBlocksPerMultiprocessor(&per_cu, (const void*)fwd_kernel<KM_ALL>, NTHR, LDS_BYTES) != hipSuccess || per_cu < 1) { fprintf(stderr, "kernel_launch: occupancy query says %d\n", per_cu); }
#else
        (void)hipFuncSetAttribute((const void*)fwd_kernel<KM_GEMM>, hipFuncAttributeMaxDynamicSharedMemorySize, LDS_BYTES); (void)hipFuncSetAttribute((const void*)fwd_kernel<KM_REST>, hipFuncAttributeMaxDynamicSharedMemorySize, LDS_BYTES); (void)per_cu;
#endif
        (void)hipGetLastError();
        grid = cus;
    }
    if (grid < 0) return;
    (void)hipMemsetAsync((char*)d_ws + WS_CTL, 0, CTL_ZERO_BYTES, stream);
    Args a{};
    for (int i = 0; i < 33; ++i) a.in[i] = (const float*)d_in[i];
    a.out = (float*)d_out; a.ws = (unsigned char*)d_ws;
#if MK_SINGLE
    a.single = 1; a.layer = 0; a.phase = 0;
    hipLaunchKernelGGL(fwd_kernel<KM_ALL>, dim3(grid), dim3(NTHR), LDS_BYTES, stream, a);
#else
    a.single = 0;
    a.layer = 0; a.phase = PH_PRE; hipLaunchKernelGGL(fwd_kernel<KM_REST>, dim3(grid), dim3(NTHR), LDS_BYTES, stream, a);
    for (int l = 0; l < DEPTH; ++l)
        for (int k = PH_NORM1; k < PH_COUNT; ++k) { a.layer = l; a.phase = k; if ((KM_GEMM >> k) & 1u) hipLaunchKernelGGL(fwd_kernel<KM_GEMM>, dim3(grid), dim3(NTHR), LDS_BYTES, stream, a); else hipLaunchKernelGGL(fwd_kernel<KM_REST>, dim3(grid), dim3(NTHR), LDS_BYTES, stream, a);
#ifdef RWKV_DEBUG
            if (k == PH_SCAN_B) hipLaunchKernelGGL(dbg_naive_kernel, dim3(20), dim3(NTHR), LDS_BYTES, stream, a);
#endif
        }
#ifdef RWKV_DEBUG
    a.layer = 99; a.phase = 99; hipLaunchKernelGGL(fwd_kernel<KM_REST>, dim3(grid), dim3(NTHR), LDS_BYTES, stream, a);
#endif
#endif
    const hipError_t le = hipPeekAtLastError();
    if (le != hipSuccess) fprintf(stderr, "kernel_launch: launch failed: %s\n", hipGetErrorName(le));
}
```
